# Optimizing an MI355X kernel written in HIP

```python
import jax
import jax.numpy as jnp
from jax import lax
import numpy as np

D_MODEL = 1024
BATCH = 16
SEQ = 2048
DEPTH = 2

CHUNK = 64
CONV_WIDTH = 4
EPS = 1e-6

MLSTM_HEADS = 4
MLSTM_DQK = 128
MLSTM_DV = 256
MLSTM_QK_W = MLSTM_HEADS * MLSTM_DQK
MLSTM_V_W = MLSTM_HEADS * MLSTM_DV
GDN_HEADS = 8
GDN_DK = 128
GDN_DV = 128
GDN_QK_W = GDN_HEADS * GDN_DK
GDN_V_W = GDN_HEADS * GDN_DV
GDN_QKV_W = 2 * GDN_QK_W + GDN_V_W
ATT_HEADS = 16
ATT_DH = 64
ATT_W = ATT_HEADS * ATT_DH
ATT_LEFT_CHUNKS = 8
REL_MAX_PAST = 256
REL_TABLE = CHUNK + REL_MAX_PAST
SSD_HEADS = 32
SSD_DH = 64
SSD_STATE = 128
SSD_GROUPS = 4
SSD_HEADS_PER_GROUP = SSD_HEADS // SSD_GROUPS
SSD_INNER = SSD_HEADS * SSD_DH
SSD_BC_W = SSD_GROUPS * SSD_STATE
SSD_CONV_W = SSD_INNER + 2 * SSD_BC_W
MOE_GROUPS = 4
MOE_EXPERTS_PER_GROUP = 8
MOE_TOP_K = 2
N_EXPERTS = MOE_GROUPS * MOE_EXPERTS_PER_GROUP
D_EXPERT = 256

EVEN_SIZES = (MLSTM_QK_W, MLSTM_QK_W, MLSTM_V_W, MLSTM_V_W, MLSTM_HEADS, MLSTM_HEADS,
              GDN_QKV_W, GDN_V_W, GDN_HEADS, GDN_HEADS)
EVEN_IN = sum(EVEN_SIZES)
EVEN_OUT = MLSTM_V_W + GDN_V_W
ODD_SIZES = (ATT_W, ATT_W, ATT_W, SSD_INNER, SSD_CONV_W, SSD_HEADS)
ODD_IN = sum(ODD_SIZES)
ODD_OUT = ATT_W + SSD_INNER

kernel_name = "hybrid_chunk_causal_mlstm_gdn_attn_ssd_hmoe"


def _split(x, sizes):
    outs, start = [], 0
    for size in sizes:
        outs.append(x[..., start:start + size])
        start += size
    return outs


def rms_normalize(x):
    xf = x.astype(jnp.float32)
    return xf * lax.rsqrt(jnp.mean(xf * xf, axis=-1, keepdims=True) + EPS)


def rms_norm(x, gain):
    return (rms_normalize(x) * gain).astype(x.dtype)


def l2_normalize(x):
    return x * lax.rsqrt(jnp.sum(x * x, axis=-1, keepdims=True) + EPS)


def causal_depthwise_conv(x, w):
    seq = x.shape[1]
    xp = jnp.pad(x, ((0, 0), (CONV_WIDTH - 1, 0), (0, 0)))
    y = xp[:, 0:seq] * w[0]
    for j in range(1, CONV_WIDTH):
        y = y + xp[:, j:j + seq] * w[j]
    return y


def _chunks_head_major(t, n_chunks):
    b, _, h = t.shape[:3]
    t = t.reshape((b, n_chunks, CHUNK, h) + t.shape[3:])
    return jnp.swapaxes(t, 2, 3)


def _causal_mask(offset=0):
    return jnp.tril(jnp.ones((CHUNK, CHUNK), dtype=bool), offset)


def mlstm_chunkwise(q, k, v, i_pre, f_pre):
    b_, s_, h_, dk = q.shape
    dv = v.shape[-1]
    nc = s_ // CHUNK
    q, k, v, li, fp = [_chunks_head_major(t, nc) for t in (q, k, v, i_pre, f_pre)]
    q = q * dk ** -0.5
    bcum = jnp.cumsum(jax.nn.log_sigmoid(fp), axis=-1)
    b_end = bcum[..., -1]
    g_end = b_end[..., None] - bcum + li
    m_loc = jnp.max(g_end, axis=-1)
    w_end = jnp.exp(g_end - m_loc[..., None])
    upd_c = jnp.einsum('bchs,bchsk,bchsv->bchkv', w_end, k, v)
    upd_n = jnp.einsum('bchs,bchsk->bchk', w_end, k)

    def step(carry, xs):
        c_st, n_st, m_st = carry
        a, ml, uc, un = xs
        m_new = jnp.maximum(a + m_st, ml)
        s_old = jnp.exp(a + m_st - m_new)
        s_upd = jnp.exp(ml - m_new)
        c_new = s_old[..., None, None] * c_st + s_upd[..., None, None] * uc
        n_new = s_old[..., None] * n_st + s_upd[..., None] * un
        return (c_new, n_new, m_new), (c_st, n_st, m_st)

    init = (jnp.zeros((b_, h_, dk, dv), q.dtype), jnp.zeros((b_, h_, dk), q.dtype),
            jnp.zeros((b_, h_), q.dtype))
    xs = tuple(jnp.moveaxis(t, 1, 0) for t in (b_end, m_loc, upd_c, upd_n))
    _, (c_prev, n_prev, m_prev) = lax.scan(step, init, xs)
    c_prev, n_prev, m_prev = [jnp.moveaxis(t, 0, 1) for t in (c_prev, n_prev, m_prev)]

    log_d = jnp.where(_causal_mask(), bcum[..., :, None] - bcum[..., None, :] + li[..., None, :], -jnp.inf)
    inter_log = bcum + m_prev[..., None]
    m_t = jnp.maximum(inter_log, jnp.max(log_d, axis=-1))
    w_intra = jnp.exp(log_d - m_t[..., None])
    w_inter = jnp.exp(inter_log - m_t)
    scores = jnp.einsum('bchtk,bchsk->bchts', q, k) * w_intra
    num = (jnp.einsum('bchts,bchsv->bchtv', scores, v)
           + w_inter[..., None] * jnp.einsum('bchtk,bchkv->bchtv', q, c_prev))
    den = jnp.sum(scores, axis=-1) + w_inter * jnp.einsum('bchtk,bchk->bcht', q, n_prev)
    h = num / jnp.maximum(jnp.abs(den), jnp.exp(-m_t))[..., None]
    return jnp.swapaxes(h, 2, 3).reshape(b_, s_, h_, dv)


def gated_delta_chunkwise(q, k, v, g, beta):
    b_, s_, h_, dk = q.shape
    dv = v.shape[-1]
    nc = s_ // CHUNK
    q, k, v, g, beta = [_chunks_head_major(t, nc) for t in (q, k, v, g, beta)]
    gcum = jnp.cumsum(g, axis=-1)
    decay = jnp.exp(jnp.where(_causal_mask(), gcum[..., :, None] - gcum[..., None, :], -jnp.inf))
    kk = jnp.einsum('bchtk,bchsk->bchts', k, k)
    a_mat = jnp.where(_causal_mask(-1), beta[..., :, None] * kk * decay, 0.0)
    rhs = jnp.concatenate([beta[..., None] * v, (beta * jnp.exp(gcum))[..., None] * k], axis=-1)
    sol = lax.linalg.triangular_solve(a_mat + jnp.eye(CHUNK, dtype=a_mat.dtype), rhs,
                                      left_side=True, lower=True, unit_diagonal=True)
    u, w = sol[..., :dv], sol[..., dv:]
    qk = jnp.einsum('bchtk,bchsk->bchts', q, k) * decay
    q_dec = q * jnp.exp(gcum)[..., None]
    k_dec = k * jnp.exp(gcum[..., -1:] - gcum)[..., None]
    g_tot = jnp.exp(gcum[..., -1])

    def step(s_st, xs):
        u_c, w_c, qk_c, qd_c, kd_c, gt_c = xs
        v_new = u_c - jnp.einsum('bhlk,bhkv->bhlv', w_c, s_st)
        o = jnp.einsum('bhlk,bhkv->bhlv', qd_c, s_st) + jnp.einsum('bhts,bhsv->bhtv', qk_c, v_new)
        s_new = gt_c[..., None, None] * s_st + jnp.einsum('bhlk,bhlv->bhkv', kd_c, v_new)
        return s_new, o

    xs = tuple(jnp.moveaxis(t, 1, 0) for t in (u, w, qk, q_dec, k_dec, g_tot))
    _, o = lax.scan(step, jnp.zeros((b_, h_, dk, dv), q.dtype), xs)
    o = jnp.moveaxis(o, 0, 1)
    return jnp.swapaxes(o, 2, 3).reshape(b_, s_, h_, dv)


def chunked_band_attention(q, k, v, rel_bias):
    b_, s_, h_, dh = q.shape
    nc = s_ // CHUNK
    pad = ATT_LEFT_CHUNKS * CHUNK
    band = pad + CHUNK
    k_pad = jnp.pad(k, ((0, 0), (pad, 0), (0, 0), (0, 0)))
    v_pad = jnp.pad(v, ((0, 0), (pad, 0), (0, 0), (0, 0)))
    rel = jnp.arange(CHUNK)[:, None] + pad - jnp.arange(band)[None, :]
    rel_idx = jnp.clip(rel, -(CHUNK - 1), REL_MAX_PAST) + (CHUNK - 1)
    bias = rel_bias.astype(jnp.float32)[:, rel_idx]
    q_chunks = jnp.moveaxis(q.reshape(b_, nc, CHUNK, h_, dh), 1, 0)

    def one_chunk(args):
        qc, c = args
        kc = lax.dynamic_slice_in_dim(k_pad, c * CHUNK, band, axis=1)
        vc = lax.dynamic_slice_in_dim(v_pad, c * CHUNK, band, axis=1)
        s = jnp.einsum('blhd,bjhd->bhlj', qc, kc).astype(jnp.float32) + bias
        valid = (c * CHUNK - pad + jnp.arange(band)) >= 0
        p = jax.nn.softmax(jnp.where(valid, s, -jnp.inf), axis=-1).astype(vc.dtype)
        return jnp.einsum('bhlj,bjhd->blhd', p, vc)

    out = lax.map(one_chunk, (q_chunks, jnp.arange(nc)))
    return jnp.moveaxis(out, 0, 1).reshape(b_, s_, h_, dh)


def ssd_chunkwise(x, dt, a_head, bm, cm):
    b_, s_, g_, j_, p_ = x.shape
    n_ = bm.shape[-1]
    nc = s_ // CHUNK
    xd = (x * dt[..., None]).reshape(b_, nc, CHUNK, g_, j_, p_)
    acum = jnp.cumsum((dt * a_head).reshape(b_, nc, CHUNK, g_, j_), axis=2)
    bc = bm.reshape(b_, nc, CHUNK, g_, n_)
    cc = cm.reshape(b_, nc, CHUNK, g_, n_)
    seg = acum[:, :, :, None] - acum[:, :, None, :]
    decay = jnp.exp(jnp.where(_causal_mask()[:, :, None, None], seg, -jnp.inf))
    cb = jnp.einsum('bctgn,bcsgn->bctsg', cc, bc)
    y_diag = jnp.einsum('bctsgj,bcsgjp->bctgjp', cb[..., None] * decay, xd)
    decay_end = jnp.exp(acum[:, :, -1:] - acum)
    states = jnp.einsum('bclgn,bclgjp->bcgjpn', bc, decay_end[..., None] * xd)
    chunk_decay = jnp.exp(acum[:, :, -1])

    def step(s_st, xs):
        st, dec = xs
        return dec[..., None, None] * s_st + st, s_st

    _, prev = lax.scan(step, jnp.zeros((b_, g_, j_, p_, n_), xd.dtype),
                       (jnp.moveaxis(states, 1, 0), jnp.moveaxis(chunk_decay, 1, 0)))
    prev = jnp.moveaxis(prev, 0, 1)
    y_off = jnp.einsum('bctgn,bcgjpn->bctgjp', cc, prev) * jnp.exp(acum)[..., None]
    return (y_diag + y_off).reshape(b_, s_, g_, j_, p_)


def even_mixer(h, w_in, i_bias, f_bias, m_norm, conv_w, a_log, dt_bias, g_norm, w_out):
    b_, s_, _ = h.shape
    proj = jnp.einsum('bsd,de->bse', h, w_in).astype(jnp.float32)
    mq, mk, mv, mo, mi, mf, qkv, gz, ga, gb = _split(proj, EVEN_SIZES)
    hm = mlstm_chunkwise(mq.reshape(b_, s_, MLSTM_HEADS, MLSTM_DQK),
                         mk.reshape(b_, s_, MLSTM_HEADS, MLSTM_DQK),
                         mv.reshape(b_, s_, MLSTM_HEADS, MLSTM_DV),
                         mi + i_bias, mf + f_bias)
    hm = (rms_normalize(hm) * m_norm.reshape(MLSTM_HEADS, MLSTM_DV)).reshape(b_, s_, MLSTM_V_W)
    hm = hm * jax.nn.sigmoid(mo)
    qkv = jax.nn.silu(causal_depthwise_conv(qkv, conv_w))
    gq, gk, gv = _split(qkv, (GDN_QK_W, GDN_QK_W, GDN_V_W))
    gq = l2_normalize(gq.reshape(b_, s_, GDN_HEADS, GDN_DK)) * GDN_DK ** -0.5
    gk = l2_normalize(gk.reshape(b_, s_, GDN_HEADS, GDN_DK))
    log_decay = -jnp.exp(a_log) * jax.nn.softplus(ga + dt_bias)
    o = gated_delta_chunkwise(gq, gk, gv.reshape(b_, s_, GDN_HEADS, GDN_DV), log_decay, jax.nn.sigmoid(gb))
    o = (rms_normalize(o) * g_norm).reshape(b_, s_, GDN_V_W) * jax.nn.silu(gz)
    return jnp.einsum('bse,ed->bsd', jnp.concatenate([hm, o], axis=-1), w_out)


def odd_mixer(h, w_in, q_gain, k_gain, rel_bias, conv_w, conv_b, a_log, dt_bias, d_skip, s_norm, w_out):
    b_, s_, _ = h.shape
    proj = jnp.einsum('bsd,de->bse', h, w_in).astype(jnp.float32)
    aq, ak, av, z, xbc, dt_pre = _split(proj, ODD_SIZES)
    q = rms_normalize(aq.reshape(b_, s_, ATT_HEADS, ATT_DH)) * q_gain * ATT_DH ** -0.5
    k = rms_normalize(ak.reshape(b_, s_, ATT_HEADS, ATT_DH)) * k_gain
    attn = chunked_band_attention(q, k, av.reshape(b_, s_, ATT_HEADS, ATT_DH), rel_bias)
    attn = attn.reshape(b_, s_, ATT_W)
    xbc = jax.nn.silu(causal_depthwise_conv(xbc, conv_w) + conv_b)
    xs, bm, cm = _split(xbc, (SSD_INNER, SSD_BC_W, SSD_BC_W))
    dt = jax.nn.softplus(dt_pre + dt_bias).reshape(b_, s_, SSD_GROUPS, SSD_HEADS_PER_GROUP)
    a_head = (-jnp.exp(a_log)).reshape(SSD_GROUPS, SSD_HEADS_PER_GROUP)
    xh = xs.reshape(b_, s_, SSD_GROUPS, SSD_HEADS_PER_GROUP, SSD_DH)
    y = ssd_chunkwise(xh, dt, a_head, bm.reshape(b_, s_, SSD_GROUPS, SSD_STATE),
                      cm.reshape(b_, s_, SSD_GROUPS, SSD_STATE))
    y = y + d_skip.reshape(SSD_GROUPS, SSD_HEADS_PER_GROUP)[..., None] * xh
    y = y.reshape(b_, s_, SSD_INNER) * jax.nn.silu(z)
    y = rms_normalize(y.reshape(b_, s_, SSD_GROUPS, SSD_INNER // SSD_GROUPS)).reshape(b_, s_, SSD_INNER) * s_norm
    return jnp.einsum('bse,ed->bsd', jnp.concatenate([attn, y], axis=-1), w_out)


def hierarchical_moe(h, wg, bg, we, be, w_gate, w_up, w_down):
    b_, s_, _ = h.shape
    hf = h.astype(jnp.float32)
    grp_logits = jnp.einsum('bsd,dg->bsg', hf, wg.astype(jnp.float32)) + bg.astype(jnp.float32)
    grp_prob = jax.nn.softmax(grp_logits, axis=-1)
    grp_idx = jnp.argmax(grp_logits, axis=-1)
    grp_w = jnp.take_along_axis(grp_prob, grp_idx[..., None], axis=-1)
    exp_logits = (jnp.einsum('bsd,de->bse', hf, we.astype(jnp.float32)) + be.astype(jnp.float32))
    exp_logits = exp_logits.reshape(b_, s_, MOE_GROUPS, MOE_EXPERTS_PER_GROUP)
    in_grp = jnp.take_along_axis(exp_logits, grp_idx[:, :, None, None], axis=2)[:, :, 0]
    top_val, top_idx = lax.top_k(in_grp, MOE_TOP_K)
    top_w = jax.nn.softmax(top_val, axis=-1)
    within = jnp.sum(jax.nn.one_hot(top_idx, MOE_EXPERTS_PER_GROUP, dtype=jnp.float32) * top_w[..., None], axis=-2)
    combine = (jax.nn.one_hot(grp_idx, MOE_GROUPS, dtype=jnp.float32)[..., None]
               * (grp_w * within)[:, :, None, :])
    out = jnp.zeros(h.shape, jnp.float32)
    for g in range(MOE_GROUPS):
        a = jnp.einsum('bsd,edh->bseh', h, w_gate[g])
        u = jnp.einsum('bsd,edh->bseh', h, w_up[g])
        act = jax.nn.silu(a) * u * combine[:, :, g, :, None]
        out = out + jnp.einsum('bseh,ehd->bsd', act, w_down[g])
    return out


def setup_inputs(seed: int = 0) -> dict:
    key = jax.random.key(seed)
    ks = jax.random.split(key, 32)
    f32 = jnp.float32
    n_even = (DEPTH + 1) // 2
    n_odd = DEPTH // 2

    def nrm(k, shape, scale):
        return jax.random.normal(k, shape, f32) * scale

    def gain(k, shape):
        return 1.0 + 0.02 * jax.random.normal(k, shape, f32)

    def a_log_init(k, shape):
        return jnp.log(jax.random.uniform(k, shape, f32, 1.0, 16.0))

    def dt_bias_init(k, shape):
        dt = jnp.exp(jax.random.uniform(k, shape, f32, float(np.log(1e-3)), float(np.log(1e-1))))
        return dt + jnp.log(-jnp.expm1(-dt))

    return {
        "x": nrm(ks[0], (BATCH, SEQ, D_MODEL), 1.0),
        "norm_mix": gain(ks[1], (DEPTH, D_MODEL)),
        "norm_ffn": gain(ks[2], (DEPTH, D_MODEL)),
        "even_w_in": nrm(ks[3], (n_even, D_MODEL, EVEN_IN), D_MODEL ** -0.5),
        "mlstm_i_bias": nrm(ks[4], (n_even, MLSTM_HEADS), 0.1),
        "mlstm_f_bias": jnp.linspace(3.0, 6.0, MLSTM_HEADS, dtype=f32)[None] + nrm(ks[5], (n_even, MLSTM_HEADS), 0.1),
        "mlstm_norm": gain(ks[6], (n_even, MLSTM_V_W)),
        "gdn_conv": nrm(ks[7], (n_even, CONV_WIDTH, GDN_QKV_W), CONV_WIDTH ** -0.5),
        "gdn_A_log": a_log_init(ks[8], (n_even, GDN_HEADS)),
        "gdn_dt_bias": dt_bias_init(ks[9], (n_even, GDN_HEADS)),
        "gdn_norm": gain(ks[10], (n_even, GDN_DV)),
        "even_w_out": nrm(ks[11], (n_even, EVEN_OUT, D_MODEL), EVEN_OUT ** -0.5),
        "odd_w_in": nrm(ks[12], (n_odd, D_MODEL, ODD_IN), D_MODEL ** -0.5),
        "att_q_norm": gain(ks[13], (n_odd, ATT_DH)),
        "att_k_norm": gain(ks[14], (n_odd, ATT_DH)),
        "att_rel_bias": nrm(ks[15], (n_odd, ATT_HEADS, REL_TABLE), 0.1),
        "ssd_conv": nrm(ks[16], (n_odd, CONV_WIDTH, SSD_CONV_W), CONV_WIDTH ** -0.5),
        "ssd_conv_bias": nrm(ks[17], (n_odd, SSD_CONV_W), 0.02),
        "ssd_A_log": a_log_init(ks[18], (n_odd, SSD_HEADS)),
        "ssd_dt_bias": dt_bias_init(ks[19], (n_odd, SSD_HEADS)),
        "ssd_D": gain(ks[20], (n_odd, SSD_HEADS)),
        "ssd_norm": gain(ks[21], (n_odd, SSD_INNER)),
        "odd_w_out": nrm(ks[22], (n_odd, ODD_OUT, D_MODEL), ODD_OUT ** -0.5),
        "router_group_w": nrm(ks[23], (DEPTH, D_MODEL, MOE_GROUPS), D_MODEL ** -0.5),
        "router_group_b": nrm(ks[24], (DEPTH, MOE_GROUPS), 0.01),
        "router_expert_w": nrm(ks[25], (DEPTH, D_MODEL, N_EXPERTS), D_MODEL ** -0.5),
        "router_expert_b": nrm(ks[26], (DEPTH, N_EXPERTS), 0.01),
        "moe_w_gate": nrm(ks[27], (DEPTH, MOE_GROUPS, MOE_EXPERTS_PER_GROUP, D_MODEL, D_EXPERT), D_MODEL ** -0.5),
        "moe_w_up": nrm(ks[28], (DEPTH, MOE_GROUPS, MOE_EXPERTS_PER_GROUP, D_MODEL, D_EXPERT), D_MODEL ** -0.5),
        "moe_w_down": nrm(ks[29], (DEPTH, MOE_GROUPS, MOE_EXPERTS_PER_GROUP, D_EXPERT, D_MODEL), D_EXPERT ** -0.5),
    }


def reference(x, norm_mix, norm_ffn, even_w_in, mlstm_i_bias, mlstm_f_bias, mlstm_norm,
              gdn_conv, gdn_A_log, gdn_dt_bias, gdn_norm, even_w_out,
              odd_w_in, att_q_norm, att_k_norm, att_rel_bias, ssd_conv, ssd_conv_bias,
              ssd_A_log, ssd_dt_bias, ssd_D, ssd_norm, odd_w_out,
              router_group_w, router_group_b, router_expert_w, router_expert_b,
              moe_w_gate, moe_w_up, moe_w_down):
    for layer in range(DEPTH):
        h = rms_norm(x, norm_mix[layer])
        i = layer // 2
        if layer % 2 == 0:
            mix = even_mixer(h, even_w_in[i], mlstm_i_bias[i], mlstm_f_bias[i], mlstm_norm[i],
                             gdn_conv[i], gdn_A_log[i], gdn_dt_bias[i], gdn_norm[i], even_w_out[i])
        else:
            mix = odd_mixer(h, odd_w_in[i], att_q_norm[i], att_k_norm[i], att_rel_bias[i],
                            ssd_conv[i], ssd_conv_bias[i], ssd_A_log[i], ssd_dt_bias[i], ssd_D[i],
                            ssd_norm[i], odd_w_out[i])
        x = x + mix.astype(x.dtype)
        h = rms_norm(x, norm_ffn[layer])
        x = x + hierarchical_moe(h, router_group_w[layer], router_group_b[layer],
                                 router_expert_w[layer], router_expert_b[layer],
                                 moe_w_gate[layer], moe_w_up[layer], moe_w_down[layer]).astype(x.dtype)
    return x
```

```cpp
#include <hip/hip_runtime.h>
#include <cstdio>
#include <cstdint>
#define XB_TMO      128
#define XB_XCNT(j)  (256  + 64 * (j))
#define XB_XSUB(j)  (1280 + 64 * (j))
#define XB_XGEN(j)  (2304 + 64 * (j))
#define XB_TOP      3328
#define XB_TOPGEN   3392
#define XCD_BAR_WORDS 3456
#define XB_SPIN_CAP (1u << 22)
#define LAS __attribute__((address_space(3)))

__device__ __forceinline__ unsigned xb_ld(unsigned* p)              { return __hip_atomic_load(p, __ATOMIC_RELAXED, __HIP_MEMORY_SCOPE_AGENT); }
__device__ __forceinline__ unsigned xb_add(unsigned* p, unsigned v) { return __hip_atomic_fetch_add(p, v, __ATOMIC_RELAXED, __HIP_MEMORY_SCOPE_AGENT); }
__device__ __forceinline__ unsigned xb_xcc_id() { return (unsigned)__builtin_amdgcn_s_getreg((3 << 11) | 20) & 0xFu; }
#define XB_SPIN(cond, bar) do { unsigned _sp = 0; while (cond) { __builtin_amdgcn_s_sleep(1); \
    if ((++_sp & 255u) == 0u) { if (xb_ld(&(bar)[XB_TMO])) break; if (_sp > XB_SPIN_CAP) { atomicAdd(&(bar)[XB_TMO], 1u); break; } } } } while (0)

struct XcdBarrier {
    unsigned* bar; unsigned x;
    volatile LAS unsigned* st;
};

__device__ __forceinline__ XcdBarrier xcd_barrier_post(unsigned* bar, volatile LAS unsigned* st) {
    XcdBarrier b; b.bar = bar; b.x = xb_xcc_id(); b.st = st;
    if (threadIdx.x == 0) (void)xb_add(&bar[XB_XCNT(b.x)], 1u);
    return b;
}
__device__ __forceinline__ void xcd_barrier_complete(unsigned* bar, unsigned x, unsigned& nloc, unsigned& nx) {
    const unsigned G = gridDim.x * gridDim.y * gridDim.z;
    unsigned sum, cnt, mine, sp = 0u;
    for (;;) {
        sum = 0u; cnt = 0u; mine = 0u;
#pragma unroll
        for (unsigned j = 0; j < 16; ++j) { const unsigned c = xb_ld(&bar[XB_XCNT(j)]); sum += c; cnt += (c > 0u) ? 1u : 0u; mine = (j == x) ? c : mine; }
        if (sum == G) break;
        __builtin_amdgcn_s_sleep(1);
        if ((++sp & 255u) == 0u) { if (xb_ld(&bar[XB_TMO])) break; if (sp > XB_SPIN_CAP) { atomicAdd(&bar[XB_TMO], 1u); break; } }
    }
    nloc = mine > 0u ? mine : 1u; nx = cnt > 0u ? cnt : 1u;
}

__device__ __forceinline__ void xcd_barrier(const XcdBarrier& b) {
    asm volatile("s_waitcnt vmcnt(0)" ::: "memory");
    __syncthreads();
    if (threadIdx.x == 0) {
        unsigned* bar = b.bar;
        __builtin_amdgcn_s_waitcnt(0);
        unsigned nloc = b.st[0], nx = b.st[1];
        if (nloc == 0u) { xcd_barrier_complete(bar, b.x, nloc, nx); b.st[0] = nloc; b.st[1] = nx; }
        const unsigned old = xb_add(&bar[XB_XSUB(b.x)], 1u);
        const unsigned gen = old / nloc;
        if (old + 1u == (gen + 1u) * nloc) {
            __builtin_amdgcn_fence(__ATOMIC_RELEASE, "agent");
            asm volatile("s_waitcnt vmcnt(0)" ::: "memory");
            const unsigned og = xb_add(&bar[XB_TOP], 1u);
            const unsigned tg = og / nx;
            if (og + 1u == (tg + 1u) * nx) xb_add(&bar[XB_TOPGEN], 1u);
            else XB_SPIN(xb_ld(&bar[XB_TOPGEN]) == tg, bar);
            __builtin_amdgcn_fence(__ATOMIC_ACQUIRE, "agent");
            xb_add(&bar[XB_XGEN(b.x)], 1u);
            asm volatile("s_waitcnt vmcnt(0)" ::: "memory");
        } else {
            XB_SPIN(xb_ld(&bar[XB_XGEN(b.x)]) == gen, bar);
            __builtin_amdgcn_fence(__ATOMIC_ACQUIRE, "agent");
            asm volatile("s_waitcnt vmcnt(0)" ::: "memory");
        }
    }
    __syncthreads();
}
namespace pg8 {
#define PG8_LAS __attribute__((address_space(3)))
typedef unsigned short bf16_t;
typedef short bf16x8 __attribute__((ext_vector_type(8)));
typedef float f32x4 __attribute__((ext_vector_type(4)));
typedef unsigned u32x4 __attribute__((ext_vector_type(4)));
constexpr int BM = 256, BK = 64, HALF = 128, HTB = HALF * BK * 2  , STAGE_BYTES = 8 * HTB, NXCD = 8, WGM = 8;

__host__ __device__ __forceinline__ int lds_byte(int r, int c) { const int st = (r >> 4) * 2 + (c >> 5), rr = r & 15, cc = c & 31, ob = rr * 64 + cc * 2; return st * 1024 + (ob ^ (((ob >> 9) & 1) << 5)); }
__host__ __device__ __forceinline__ void stage_rc(int b, int& R, int& C) { const int st = b / 1024, sb = b % 1024, swz = sb ^ (((sb >> 9) & 1) << 5); R = (st >> 1) * 16 + swz / 64; C = (st & 1) * 32 + (swz % 64) / 2; }
__host__ __device__ __forceinline__ int perm32(int rho) { const int n = rho >> 4, i = rho & 15; return 8 * (i >> 2) + 4 * n + (i & 3); }

struct Unit { int pm, pn; };
struct Gemm { const bf16_t* A; const bf16_t* Bt; int M, N, K; };

struct StaticOrder {
    int nM, nN, nwg, G, c;
    __host__ __device__ void init(int M, int N, int G_, int c_) { nM = M / BM; nN = N / BM; nwg = nM * nN; G = G_; c = c_; }
    __host__ __device__ bool next(int i, Unit& u) const {
        const long L = (long)i * G + c; if (L >= nwg) return false;
        int wgid = (int)L; { const int q = nwg / NXCD, r = nwg % NXCD, xcd = wgid % NXCD, off = wgid / NXCD; wgid = (xcd < r ? xcd * (q + 1) : r * (q + 1) + (xcd - r) * q) + off; }
        const int nig = WGM * nN, gid = wgid / nig, fm = gid * WGM, gsz = (nM - fm) < WGM ? (nM - fm) : WGM;
        u.pm = fm + ((wgid % nig) % gsz); u.pn = (wgid % nig) / gsz; return true;
    }
    __device__ __forceinline__ void a_ready(const Unit&) const {}
    __device__ __forceinline__ void done(const Unit&) const {}
};

__device__ __forceinline__ unsigned cvt_pk_bf16(float lo, float hi) { unsigned r; asm volatile("v_cvt_pk_bf16_f32 %0, %1, %2" : "=v"(r) : "v"(lo), "v"(hi)); return r; }
typedef float f32x2 __attribute__((ext_vector_type(2)));
template <class Epi, class Sched, bool STAMP = false>
__device__ __forceinline__ void gemm_phase(PG8_LAS unsigned char* lds, const Gemm g, const Sched& S, const Epi& E, unsigned long long* stamps) {
    int tid_l = threadIdx.x; asm volatile("" : "+v"(tid_l)); const int tid = tid_l, wid = __builtin_amdgcn_readfirstlane(tid >> 6), lane = tid & 63, wr = wid >> 2, wc = wid & 3, fr = lane & 15, fq = lane >> 4;
    const int K = g.K, nt = K / BK;
    int ts_lo = 0, ts_hi = 0, nts = 0; const unsigned long long rt_entry = STAMP ? (unsigned long long)wall_clock64() : 0ull;
#define PG8_STAMP() do { if (STAMP && wid == 0 && nts < 64) { const unsigned long long _c = (unsigned long long)clock64(); \
        ts_lo = (lane == nts) ? (int)(unsigned)_c : ts_lo; ts_hi = (lane == nts) ? (int)(unsigned)(_c >> 32) : ts_hi; ++nts; } } while (0)
    PG8_STAMP();
    unsigned voffA[2], voffB[2];
#pragma unroll
    for (int i = 0; i < 2; ++i) { int R, C; stage_rc(tid * 16 + i * 8192, R, C); const int Rb = Epi::PERM ? ((R & ~31) + perm32(R & 31)) : R;
        voffA[i] = (unsigned)(R * K + C) * 2u; voffB[i] = (unsigned)(Rb * K + C) * 2u; }
    const size_t kstep = (size_t)(BK * 2);
    const size_t hstep = (size_t)HALF * K * 2;
    const size_t tstep = 2 * hstep;
    const unsigned ldsw = (unsigned)wid * 1024u;
    const int aoff = lds_byte(wr * 64 + fr, fq * 8), boff = lds_byte(wc * 32 + fr, fq * 8);
#define PG8_SA(b, h) (((b) * 2 + (h)) * HTB)
#define PG8_SB(b, h) ((4 + (b) * 2 + (h)) * HTB)
#define PG8_STAGE(bufoff, gbase, voff) do { _Pragma("unroll") for (int _i = 0; _i < 2; ++_i) \
        __builtin_amdgcn_global_load_lds((const unsigned*)((const char*)(gbase) + (voff)[_i]), (PG8_LAS unsigned*)(lds + (bufoff) + ldsw + _i * 8192), 16, 0, 0); } while (0)
#define PG8_LDA(dst, b, h) do { _Pragma("unroll") for (int m = 0; m < 4; ++m) _Pragma("unroll") for (int k = 0; k < 2; ++k) dst[m][k] = *(const PG8_LAS bf16x8*)(lds + PG8_SA(b, h) + aoff + m * 2048 + k * 1024); } while (0)
#define PG8_LDB(dst, b, h) do { _Pragma("unroll") for (int n = 0; n < 2; ++n) _Pragma("unroll") for (int k = 0; k < 2; ++k) dst[n][k] = *(const PG8_LAS bf16x8*)(lds + PG8_SB(b, h) + boff + n * 2048 + k * 1024); } while (0)
#define PG8_MMA(ai, bj, At, Bt) do { __builtin_amdgcn_s_setprio(1); _Pragma("unroll") for (int m = 0; m < 4; ++m) _Pragma("unroll") for (int n = 0; n < 2; ++n) _Pragma("unroll") for (int k = 0; k < 2; ++k) \
        acc[ai][bj][m][n] = __builtin_amdgcn_mfma_f32_16x16x32_bf16(Bt[n][k], At[m][k], acc[ai][bj][m][n], 0, 0, 0); __builtin_amdgcn_s_setprio(0); } while (0)
#define PG8_WAIT_V(n) asm volatile("s_waitcnt vmcnt(" #n ")" ::: "memory")
#define PG8_WAIT_L(n) asm volatile("s_waitcnt lgkmcnt(" #n ")" ::: "memory")
#define PG8_BAR __builtin_amdgcn_s_barrier()
#define PG8_SCHED __builtin_amdgcn_sched_barrier(0)
    Unit cur, nxt; int ui = 0;
    if (!S.next(0, cur)) return;
    f32x4 acc[2][2][4][2];
#pragma unroll
    for (int a = 0; a < 2; ++a)
#pragma unroll
        for (int b = 0; b < 2; ++b)
#pragma unroll
            for (int m = 0; m < 4; ++m)
#pragma unroll
                for (int n = 0; n < 2; ++n) acc[a][b][m][n] = (f32x4){0.f, 0.f, 0.f, 0.f};
    bf16x8 At[4][2], B0[2][2], B1[2][2];
    const char* cA = (const char*)g.A + (size_t)cur.pm * tstep; const char* cB = (const char*)g.Bt + (size_t)cur.pn * tstep;
    S.a_ready(cur);
    PG8_STAGE(PG8_SB(0, 0), cB, voffB); PG8_STAGE(PG8_SA(0, 0), cA, voffA); PG8_STAGE(PG8_SB(0, 1), cB + hstep, voffB); PG8_STAGE(PG8_SA(0, 1), cA + hstep, voffA);
    if (wr == 1) PG8_BAR;
    PG8_WAIT_V(4); PG8_BAR;
    PG8_STAGE(PG8_SB(1, 0), cB + kstep, voffB); PG8_STAGE(PG8_SA(1, 0), cA + kstep, voffA); PG8_STAGE(PG8_SB(1, 1), cB + hstep + kstep, voffB);
    PG8_WAIT_V(6); PG8_BAR;
    PG8_STAMP();
    for (;;) {
        const bool has_next = S.next(ui + 1, nxt);
        const char* nA = has_next ? (const char*)g.A + (size_t)nxt.pm * tstep : cA; const char* nB = has_next ? (const char*)g.Bt + (size_t)nxt.pn * tstep : cB;
        for (int t = 0; t < nt; t += 2) {
            const bool last = (t == nt - 2);
            const char* a1 = cA + (size_t)(t + 1) * kstep;
            const char* a2 = last ? nA : cA + (size_t)(t + 2) * kstep; const char* b2 = last ? nB : cB + (size_t)(t + 2) * kstep;
            const char* a3 = a2 + kstep; const char* b3 = b2 + kstep;
            if (last && has_next) S.a_ready(nxt);
            PG8_LDB(B0, 0, 0); PG8_SCHED; PG8_LDA(At, 0, 0); PG8_STAGE(PG8_SA(1, 1), a1 + hstep, voffA);
            PG8_WAIT_L(8); PG8_BAR; PG8_WAIT_L(0); PG8_MMA(0, 0, At, B0); PG8_BAR; PG8_SCHED;
            PG8_LDB(B1, 0, 1); PG8_STAGE(PG8_SB(0, 0), b2, voffB);
            PG8_BAR; PG8_WAIT_L(0); PG8_MMA(0, 1, At, B1); PG8_BAR;
            PG8_LDA(At, 0, 1); PG8_STAGE(PG8_SA(0, 0), a2, voffA);
            PG8_BAR; PG8_WAIT_L(0); PG8_MMA(1, 0, At, B0); PG8_BAR; PG8_SCHED;
            PG8_STAGE(PG8_SB(0, 1), b2 + hstep, voffB);
            PG8_WAIT_V(6); PG8_BAR; PG8_MMA(1, 1, At, B1); PG8_BAR;
            PG8_LDB(B0, 1, 0); PG8_SCHED; PG8_LDA(At, 1, 0); PG8_STAGE(PG8_SA(0, 1), a2 + hstep, voffA);
            PG8_WAIT_L(8); PG8_BAR; PG8_WAIT_L(0); PG8_MMA(0, 0, At, B0); PG8_BAR; PG8_SCHED;
            PG8_LDB(B1, 1, 1); PG8_STAGE(PG8_SB(1, 0), b3, voffB);
            PG8_BAR; PG8_WAIT_L(0); PG8_MMA(0, 1, At, B1); PG8_BAR;
            PG8_LDA(At, 1, 1); PG8_STAGE(PG8_SA(1, 0), a3, voffA);
            PG8_BAR; PG8_WAIT_L(0); PG8_MMA(1, 0, At, B0); PG8_BAR; PG8_SCHED;
            PG8_STAGE(PG8_SB(1, 1), b3 + hstep, voffB);
            PG8_WAIT_V(6); PG8_BAR; PG8_MMA(1, 1, At, B1); PG8_BAR;
        }
        PG8_STAMP();
        if constexpr (!Epi::AFTER_DRAIN) { E(acc, cur, wr, wc, fr, fq); S.done(cur); }
        PG8_STAMP();
        if (!has_next) break;
#pragma unroll
        for (int a = 0; a < 2; ++a)
#pragma unroll
            for (int b = 0; b < 2; ++b)
#pragma unroll
                for (int m = 0; m < 4; ++m)
#pragma unroll
                    for (int n = 0; n < 2; ++n) acc[a][b][m][n] = (f32x4){0.f, 0.f, 0.f, 0.f};
        cur = nxt; cA = nA; cB = nB; ++ui;
    }
    PG8_WAIT_V(0);
    if (wr == 0) PG8_BAR;
    PG8_BAR;
    if constexpr (Epi::AFTER_DRAIN) { E.fused(acc, cur, wr, wc, fr, fq, lds, wid, lane); S.done(cur); }
    PG8_STAMP();
    if (STAMP && wid == 0) { stamps[lane] = lane < nts ? (((unsigned long long)(unsigned)ts_hi << 32) | (unsigned)ts_lo) : 0ull;
        if (lane == 62) stamps[62] = rt_entry; if (lane == 63) stamps[63] = (unsigned long long)wall_clock64(); }
#undef PG8_STAMP
#undef PG8_SA
#undef PG8_SB
#undef PG8_STAGE
#undef PG8_LDA
#undef PG8_LDB
#undef PG8_MMA
#undef PG8_WAIT_V
#undef PG8_WAIT_L
#undef PG8_BAR
#undef PG8_SCHED
}
}
typedef pg8::bf16_t bf16_t;
typedef pg8::f32x4 f32x4;
typedef pg8::u32x4 u32x4;
typedef unsigned u32x2 __attribute__((ext_vector_type(2)));

constexpr int D = 1024, NBATCH = 16, SEQ = 2048, NTOK = NBATCH * SEQ, NGRP = 2, GBATCH = NBATCH / NGRP, GTOK = GBATCH * SEQ, NCHUNK = SEQ / 64;
constexpr int NP0 = 7424, NP1 = 8448, KO0 = 2048, KO1 = 3072;
constexpr float EPS = 1e-6f;
constexpr int C_MQ = 0, C_MK = 512, C_MV = 1024, C_MO = 2048, C_GQ = 3072, C_GZ = 6144, C_SM0 = 7168;
constexpr int C_AQ = 0, C_AK = 1024, C_AV = 2048, C_Z = 3072, C_XBC = 5120, C_DT = 8192;
constexpr int MOE_MAXROWS = 73728;

constexpr size_t MiB = 1ull << 20;
constexpr size_t WS_BAR = 0;
constexpr size_t WS_CNT = 128 * 1024;
constexpr size_t WS_PANEL = 132 * 1024;
constexpr size_t WS_ZERO_BYTES = 160 * 1024;
constexpr size_t WS_ROUTE_E = 1 * MiB, WS_ROUTE_W = WS_ROUTE_E + 256 * 1024, WS_POS = WS_ROUTE_W + 256 * 1024, WS_WROW = 2 * MiB;
constexpr size_t WS_WIN = 4 * MiB, WS_WOUT = 21 * MiB, WS_W1 = 27 * MiB, WS_W2 = 59 * MiB;
constexpr size_t WS_HN = 76 * MiB, WS_AOUT = 108 * MiB, WS_PROJ = 204 * MiB;
constexpr size_t WS_H2P = 76 * MiB, WS_ACT = 220 * MiB, WS_YP = 256 * MiB;
constexpr size_t WS_END = 512 * MiB;
constexpr int LDS_BYTES = 163840, LDS_BAR_OFF = LDS_BYTES - 16;

struct Args { const float* in[30]; float* out; unsigned char* ws; int ph_lo, ph_hi, li, pad; };

struct Ctx {
    const float* const* in; float* out; unsigned char* ws; LAS unsigned char* lds;
    int tid, lane, wave, G, bid;
};

__device__ __forceinline__ float bf2f(bf16_t b) { return __uint_as_float(((unsigned)b) << 16); }
__device__ __forceinline__ bf16_t f2bf(float f) { unsigned u = __float_as_uint(f); u += 0x7fffu + ((u >> 16) & 1u); return (bf16_t)(u >> 16); }
__device__ __forceinline__ unsigned pk2(float lo, float hi) { return (unsigned)f2bf(lo) | ((unsigned)f2bf(hi) << 16); }
__device__ __forceinline__ float wave_sum(float v) {
#pragma unroll
    for (int o = 1; o < 64; o <<= 1) v += __shfl_xor(v, o);
    return v;
}
__device__ __forceinline__ float half_sum(float v) {
#pragma unroll
    for (int o = 1; o < 32; o <<= 1) v += __shfl_xor(v, o);
    return v;
}
__device__ __forceinline__ float sigmoidf_(float x) { return 1.f / (1.f + expf(-x)); }
__device__ __forceinline__ float siluf_(float x) { return x / (1.f + expf(-x)); }
__device__ __forceinline__ float softplusf_(float x) { return x > 20.f ? x : log1pf(expf(x)); }
__device__ __forceinline__ int lds_inc(LAS int* p) { return __hip_atomic_fetch_add(p, 1, __ATOMIC_RELAXED, __HIP_MEMORY_SCOPE_WORKGROUP); }
#define LDS_WAIT() asm volatile("s_waitcnt lgkmcnt(0)" ::: "memory")

namespace pg8 {
struct EpiBf16P {
    static constexpr bool PERM = true, AFTER_DRAIN = false;
    bf16_t* O; int ldc; int pn_mask;
    __device__ __forceinline__ void operator()(const f32x4 (&acc)[2][2][4][2], const Unit& u, int wr, int wc, int fr, int fq) const {
        const int row0 = u.pm * BM + wr * 64 + fr; const int col0 = (u.pn & pn_mask) * BM + wc * 32 + 8 * fq;
#pragma unroll
        for (int ai = 0; ai < 2; ++ai)
#pragma unroll
            for (int m = 0; m < 4; ++m) { bf16_t* rowp = O + (size_t)(row0 + ai * HALF + m * 16) * ldc + col0;
#pragma unroll
                for (int bj = 0; bj < 2; ++bj) { const f32x4 v0 = acc[ai][bj][m][0], v1 = acc[ai][bj][m][1];
                    u32x4 w; w.x = cvt_pk_bf16(v0[0], v0[1]); w.y = cvt_pk_bf16(v0[2], v0[3]); w.z = cvt_pk_bf16(v1[0], v1[1]); w.w = cvt_pk_bf16(v1[2], v1[3]);
                    *(u32x4*)(rowp + bj * HALF) = w; } }
    }
};
struct EpiResid {
    static constexpr bool PERM = false, AFTER_DRAIN = false;
    const float* xin; float* out; int ldc;
    __device__ __forceinline__ void operator()(const f32x4 (&acc)[2][2][4][2], const Unit& u, int wr, int wc, int fr, int fq) const {
        const int row0 = u.pm * BM + wr * 64 + fr, col0 = u.pn * BM + wc * 32 + 4 * fq;
#pragma unroll
        for (int ai = 0; ai < 2; ++ai)
#pragma unroll
            for (int m = 0; m < 4; ++m) { const size_t ro = (size_t)(row0 + ai * HALF + m * 16) * ldc + col0;
#pragma unroll
                for (int bj = 0; bj < 2; ++bj)
#pragma unroll
                    for (int n = 0; n < 2; ++n) { const f32x4 r = *(const f32x4*)(xin + ro + bj * HALF + n * 16); *(f32x4*)(out + ro + bj * HALF + n * 16) = r + acc[ai][bj][m][n]; } }
    }
};
struct EpiSwiGLU {
    static constexpr bool PERM = true, AFTER_DRAIN = false;
    bf16_t* O; const float* wrow;
    __device__ __forceinline__ void operator()(const f32x4 (&acc)[2][2][4][2], const Unit& u, int wr, int wc, int fr, int fq) const {
        const int row0 = u.pm * BM + wr * 64 + fr; const int col0 = (u.pn & 1) * HALF + wc * 32 + 8 * fq;
#pragma unroll
        for (int ai = 0; ai < 2; ++ai)
#pragma unroll
            for (int m = 0; m < 4; ++m) { const int row = row0 + ai * HALF + m * 16; const float w = wrow[row];
                float o[8];
#pragma unroll
                for (int n = 0; n < 2; ++n)
#pragma unroll
                    for (int e = 0; e < 4; ++e) { const float g = acc[ai][0][m][n][e], up = acc[ai][1][m][n][e]; o[4 * n + e] = g / (1.f + __expf(-g)) * up * w; }
                u32x4 pk; pk.x = cvt_pk_bf16(o[0], o[1]); pk.y = cvt_pk_bf16(o[2], o[3]); pk.z = cvt_pk_bf16(o[4], o[5]); pk.w = cvt_pk_bf16(o[6], o[7]);
                *(u32x4*)(O + (size_t)row * 256 + col0) = pk; }
    }
};
struct MoeOrder {
    const int* panel_expert; int nunits, G, c, shift;
    __device__ __forceinline__ bool next(int i, Unit& u) const {
        const long L = (long)i * G + c; if (L >= nunits) return false;
        const int p = (int)(L >> shift); const int e = panel_expert[p]; u.pm = p; u.pn = (e << shift) + (int)(L & ((1 << shift) - 1)); return true;
    }
    __device__ __forceinline__ void a_ready(const Unit&) const {}
    __device__ __forceinline__ void done(const Unit&) const {}
};
}

__device__ __forceinline__ void tr_item(const float* __restrict__ W, int ldw, int col0, int K, bf16_t* WT, int drow0, LAS float* scr, int kb, int nb, int lane) {
    const int k0 = 64 * kb, n0 = col0 + 32 * nb;
#pragma unroll 8
    for (int i = 0; i < 32; ++i) { const int kk = 2 * i + (lane >> 5); scr[kk * 33 + (lane & 31)] = W[(size_t)(k0 + kk) * ldw + n0 + (lane & 31)]; }
    LDS_WAIT();
    const int c = lane & 7;
#pragma unroll
    for (int j = 0; j < 4; ++j) { const int n = (lane >> 3) + 8 * j; const LAS float* s = scr + (8 * c) * 33 + n;
        u32x4 o; o.x = pk2(s[0 * 33], s[1 * 33]); o.y = pk2(s[2 * 33], s[3 * 33]); o.z = pk2(s[4 * 33], s[5 * 33]); o.w = pk2(s[6 * 33], s[7 * 33]);
        *(u32x4*)(WT + (size_t)(drow0 + n) * K + k0 + 8 * c) = o; }
    LDS_WAIT();
}
__device__ __forceinline__ bool tr_seg(int& r, const float* W, int ldw, int col0, int ncols, int K, bf16_t* WT, int drow0, LAS float* scr, int lane) {
    const int nblk = ncols / 32, items = (K / 64) * nblk;
    if (r < items) { const int kb = r / nblk, nb = r % nblk; tr_item(W, ldw, col0, K, WT, drow0 + 32 * nb, scr, kb, nb, lane); return true; }
    r -= items; return false;
}
__device__ __forceinline__ void phase_convert(const Ctx& C, int layer) {
    LAS float* scr = (LAS float*)(C.lds + C.wave * 8448);
    const int gw = C.bid * 8 + C.wave, NGW = C.G * 8;
    bf16_t* Win = (bf16_t*)(C.ws + WS_WIN); bf16_t* Wout = (bf16_t*)(C.ws + WS_WOUT); bf16_t* W1 = (bf16_t*)(C.ws + WS_W1); bf16_t* W2 = (bf16_t*)(C.ws + WS_W2);
    const float* wg = C.in[27] + (size_t)layer * 32 * 1024 * 256; const float* wu = C.in[28] + (size_t)layer * 32 * 1024 * 256; const float* wd = C.in[29] + (size_t)layer * 32 * 256 * 1024;
    const int IT_IN = (layer == 0) ? (16 * 96 + 16 * 128) : (16 * 256);
    const int IT_OUT = (layer == 0) ? (32 * 32) : (48 * 32);
    const int IT_MOE = 32 * 128;
    const int NITEMS = IT_IN + IT_OUT + 3 * IT_MOE;
    for (int it = gw; it < NITEMS; it += NGW) {
        int r = it;
        if (layer == 0) {
            if (tr_seg(r, C.in[3], 7192, 0, 3072, 1024, Win, 0, scr, C.lane)) continue;
            if (tr_seg(r, C.in[3], 7192, 3080, 4096, 1024, Win, 3072, scr, C.lane)) continue;
            if (tr_seg(r, C.in[11], 1024, 0, 1024, 2048, Wout, 0, scr, C.lane)) continue;
        } else {
            if (tr_seg(r, C.in[12], 8224, 0, 8192, 1024, Win, 0, scr, C.lane)) continue;
            if (tr_seg(r, C.in[22], 1024, 0, 1024, 3072, Wout, 0, scr, C.lane)) continue;
        }
        if (r < IT_MOE) { const int e = r >> 7, q = r & 127, kb = q >> 3, nb = q & 7;
            tr_item(wg + (size_t)e * 1024 * 256, 256, 0, 1024, W1, e * 512 + (nb < 4 ? 32 * nb : 256 + 32 * (nb - 4)), scr, kb, nb, C.lane); continue; }
        r -= IT_MOE;
        if (r < IT_MOE) { const int e = r >> 7, q = r & 127, kb = q >> 3, nb = q & 7;
            tr_item(wu + (size_t)e * 1024 * 256, 256, 0, 1024, W1, e * 512 + (nb < 4 ? 128 + 32 * nb : 384 + 32 * (nb - 4)), scr, kb, nb, C.lane); continue; }
        r -= IT_MOE;
        { const int e = r >> 7, q = r & 127, kb = q >> 5, nb = q & 31;
            tr_item(wd + (size_t)e * 256 * 1024, 1024, 0, 256, W2, e * 1024 + 32 * nb, scr, kb, nb, C.lane); }
    }
    const int base_row = (layer == 0) ? 7168 : 8192;
    const size_t gt = (size_t)C.bid * 512 + C.tid, GT = (size_t)C.G * 512;
    for (size_t idx = gt; idx < 256 * 1024; idx += GT) {
        const int rr = (int)(idx >> 10), k = (int)(idx & 1023); float v = 0.f;
        if (layer == 0) { const int sc = rr < 8 ? 3072 + rr : (rr < 24 ? 7176 + (rr - 8) : -1); if (sc >= 0) v = C.in[3][(size_t)k * 7192 + sc]; }
        else { if (rr < 32) v = C.in[12][(size_t)k * 8224 + 8192 + rr]; }
        Win[(size_t)(base_row + rr) * 1024 + k] = f2bf(v);
    }
}

__device__ __forceinline__ void phase_norm(const Ctx& C, const float* x, const float* gain, bf16_t* out, int nrows) {
    const int gw = C.bid * 8 + C.wave, NGW = C.G * 8;
    f32x4 g[4];
#pragma unroll
    for (int j = 0; j < 4; ++j) g[j] = *(const f32x4*)(gain + 4 * C.lane + 256 * j);
    for (int r = gw; r < nrows; r += NGW) {
        const float* xr = x + (size_t)r * D; f32x4 v[4]; float ss = 0.f;
#pragma unroll
        for (int j = 0; j < 4; ++j) { v[j] = *(const f32x4*)(xr + 4 * C.lane + 256 * j); ss += v[j][0] * v[j][0] + v[j][1] * v[j][1] + v[j][2] * v[j][2] + v[j][3] * v[j][3]; }
        const float rstd = rsqrtf(wave_sum(ss) * (1.f / D) + EPS);
#pragma unroll
        for (int j = 0; j < 4; ++j) { u32x2 o; o.x = pk2(v[j][0] * rstd * g[j][0], v[j][1] * rstd * g[j][1]); o.y = pk2(v[j][2] * rstd * g[j][2], v[j][3] * rstd * g[j][3]);
            *(u32x2*)(out + (size_t)r * D + 4 * C.lane + 256 * j) = o; }
    }
}

__device__ __forceinline__ void naive_mlstm_unit(const Ctx& C, const bf16_t* P, bf16_t* AO, int unit) {
    const int vs = unit & 3, h = (unit >> 2) & 3, bl = unit >> 4;
    LAS float* q = (LAS float*)C.lds; LAS float* k = q + 64 * 128; LAS float* v = k + 64 * 128; LAS float* fi = v + 64 * 64; LAS float* red = fi + 128;
    const int vcol = C.tid & 63, kg = C.tid >> 6;
    const float ib = C.in[4][h], fb = C.in[5][h]; const float scale = 0.08838834764831845f;
    float Cs[16], ns[16];
#pragma unroll
    for (int i = 0; i < 16; ++i) { Cs[i] = 0.f; ns[i] = 0.f; }
    for (int c = 0; c < NCHUNK; ++c) {
        const size_t r0 = (size_t)bl * SEQ + (size_t)c * 64;
        __syncthreads();
        for (int idx = C.tid; idx < 64 * 128; idx += 512) { const int t = idx >> 7, kk = idx & 127; const bf16_t* pr = P + (r0 + t) * NP0;
            q[idx] = bf2f(pr[C_MQ + h * 128 + kk]) * scale; k[idx] = bf2f(pr[C_MK + h * 128 + kk]); }
        for (int idx = C.tid; idx < 64 * 64; idx += 512) { const int t = idx >> 6, vv = idx & 63; v[idx] = bf2f(P[(r0 + t) * NP0 + C_MV + h * 256 + vs * 64 + vv]); }
        if (C.tid < 64) { const bf16_t* pr = P + (r0 + C.tid) * NP0 + C_SM0; fi[2 * C.tid] = sigmoidf_(bf2f(pr[4 + h]) + fb); fi[2 * C.tid + 1] = expf(bf2f(pr[h]) + ib); }
        __syncthreads();
        for (int t = 0; t < 64; ++t) {
            const float f = fi[2 * t], ig = fi[2 * t + 1], vv = v[t * 64 + vcol] * ig; float pn = 0.f, pd = 0.f;
#pragma unroll
            for (int i = 0; i < 16; ++i) { const float kx = k[t * 128 + 16 * kg + i], qx = q[t * 128 + 16 * kg + i];
                Cs[i] = f * Cs[i] + vv * kx; ns[i] = f * ns[i] + ig * kx; pn += Cs[i] * qx; pd += ns[i] * qx; }
            LAS float* rb = red + (t & 1) * 1024;
            rb[kg * 64 + vcol] = pn; rb[512 + kg * 64 + vcol] = pd;
            __syncthreads();
            if (kg == 0) { float num = 0.f, den = 0.f;
#pragma unroll
                for (int g = 0; g < 8; ++g) { num += rb[g * 64 + vcol]; den += rb[512 + g * 64 + vcol]; }
                AO[(r0 + t) * KO0 + h * 256 + vs * 64 + vcol] = f2bf(num / fmaxf(fabsf(den), 1.f)); }
        }
    }
}
__device__ __forceinline__ void naive_gdn_unit(const Ctx& C, const bf16_t* P, bf16_t* AO, int unit) {
    const int vs = unit & 1, h = (unit >> 1) & 7, bl = unit >> 4;
    LAS float* q = (LAS float*)C.lds; LAS float* k = q + 64 * 128; LAS float* v = k + 64 * 128; LAS float* gb = v + 64 * 64; LAS float* sc = gb + 128; LAS float* red1 = sc + 128; LAS float* red2 = red1 + 1024;
    const int vcol = C.tid & 63, kg = C.tid >> 6;
    const float* cw = C.in[7];
    const float na = -expf(C.in[8][h]), dtb = C.in[9][h];
    float S[16];
#pragma unroll
    for (int i = 0; i < 16; ++i) S[i] = 0.f;
    for (int c = 0; c < NCHUNK; ++c) {
        const size_t r0 = (size_t)bl * SEQ + (size_t)c * 64; const int ts0 = c * 64;
        __syncthreads();
        for (int idx = C.tid; idx < 64 * 128; idx += 512) { const int t = idx >> 7, kk = idx & 127; const int chq = h * 128 + kk, chk = 1024 + h * 128 + kk; float aq = 0.f, ak = 0.f;
#pragma unroll
            for (int j = 0; j < 4; ++j) { const int ts = ts0 + t - 3 + j; if (ts >= 0) { const bf16_t* pr = P + (r0 + t - 3 + j) * NP0 + C_GQ; aq += cw[j * 3072 + chq] * bf2f(pr[chq]); ak += cw[j * 3072 + chk] * bf2f(pr[chk]); } }
            q[idx] = siluf_(aq); k[idx] = siluf_(ak); }
        for (int idx = C.tid; idx < 64 * 64; idx += 512) { const int t = idx >> 6, vv = idx & 63; const int chv = 2048 + h * 128 + vs * 64 + vv; float av = 0.f;
#pragma unroll
            for (int j = 0; j < 4; ++j) { const int ts = ts0 + t - 3 + j; if (ts >= 0) av += cw[j * 3072 + chv] * bf2f(P[(r0 + t - 3 + j) * NP0 + C_GQ + chv]); }
            v[idx] = siluf_(av); }
        if (C.tid < 64) { const bf16_t* pr = P + (r0 + C.tid) * NP0 + C_SM0; const float g = na * softplusf_(bf2f(pr[8 + h]) + dtb); gb[2 * C.tid] = expf(g); gb[2 * C.tid + 1] = sigmoidf_(bf2f(pr[16 + h])); }
        __syncthreads();
        if (C.tid < 128) { const int t = C.tid & 63; LAS float* row = (C.tid < 64 ? q : k) + t * 128; float ss = 0.f; for (int i = 0; i < 128; ++i) ss += row[i] * row[i];
            sc[C.tid] = rsqrtf(ss + EPS) * (C.tid < 64 ? 0.08838834764831845f : 1.f); }
        __syncthreads();
        for (int idx = C.tid; idx < 64 * 128; idx += 512) { const int t = idx >> 7; q[idx] *= sc[t]; k[idx] *= sc[64 + t]; }
        __syncthreads();
        for (int t = 0; t < 64; ++t) {
            const float eg = gb[2 * t], beta = gb[2 * t + 1]; float pk = 0.f;
#pragma unroll
            for (int i = 0; i < 16; ++i) { S[i] *= eg; pk += k[t * 128 + 16 * kg + i] * S[i]; }
            LAS float* r1 = red1 + (t & 1) * 512; LAS float* r2 = red2 + (t & 1) * 512;
            r1[kg * 64 + vcol] = pk;
            __syncthreads();
            float kS = 0.f;
#pragma unroll
            for (int g = 0; g < 8; ++g) kS += r1[g * 64 + vcol];
            const float delta = beta * (v[t * 64 + vcol] - kS); float po = 0.f;
#pragma unroll
            for (int i = 0; i < 16; ++i) { S[i] += k[t * 128 + 16 * kg + i] * delta; po += q[t * 128 + 16 * kg + i] * S[i]; }
            r2[kg * 64 + vcol] = po;
            __syncthreads();
            if (kg == 0) { float o = 0.f;
#pragma unroll
                for (int g = 0; g < 8; ++g) o += r2[g * 64 + vcol];
                AO[(r0 + t) * KO0 + 1024 + h * 128 + vs * 64 + vcol] = f2bf(o); }
        }
    }
}
__device__ __forceinline__ void phase_gate0(const Ctx& C, const bf16_t* P, bf16_t* AO) {
    const int gw = C.bid * 8 + C.wave, NGW = C.G * 8; const float* mn = C.in[6]; const float* gn = C.in[10];
    for (int r = gw; r < GTOK; r += NGW) {
        bf16_t* ar = AO + (size_t)r * KO0; const bf16_t* pr = P + (size_t)r * NP0;
#pragma unroll
        for (int j = 0; j < 4; ++j) { const int c0 = 4 * C.lane + 256 * j; const u32x2 raw = *(const u32x2*)(ar + c0); const u32x2 gz = *(const u32x2*)(pr + C_MO + c0);
            float v[4] = {__uint_as_float(raw.x << 16), __uint_as_float(raw.x & 0xffff0000u), __uint_as_float(raw.y << 16), __uint_as_float(raw.y & 0xffff0000u)};
            float z[4] = {__uint_as_float(gz.x << 16), __uint_as_float(gz.x & 0xffff0000u), __uint_as_float(gz.y << 16), __uint_as_float(gz.y & 0xffff0000u)};
            const float ss = wave_sum(v[0] * v[0] + v[1] * v[1] + v[2] * v[2] + v[3] * v[3]); const float rstd = rsqrtf(ss * (1.f / 256.f) + EPS);
            float o[4];
#pragma unroll
            for (int e = 0; e < 4; ++e) o[e] = v[e] * rstd * mn[c0 + e] * sigmoidf_(z[e]);
            u32x2 w; w.x = pk2(o[0], o[1]); w.y = pk2(o[2], o[3]); *(u32x2*)(ar + c0) = w; }
#pragma unroll
        for (int j = 0; j < 4; ++j) { const int c0 = 4 * C.lane + 256 * j; const u32x2 raw = *(const u32x2*)(ar + 1024 + c0); const u32x2 gz = *(const u32x2*)(pr + C_GZ + c0);
            float v[4] = {__uint_as_float(raw.x << 16), __uint_as_float(raw.x & 0xffff0000u), __uint_as_float(raw.y << 16), __uint_as_float(raw.y & 0xffff0000u)};
            float z[4] = {__uint_as_float(gz.x << 16), __uint_as_float(gz.x & 0xffff0000u), __uint_as_float(gz.y << 16), __uint_as_float(gz.y & 0xffff0000u)};
            const float ss = half_sum(v[0] * v[0] + v[1] * v[1] + v[2] * v[2] + v[3] * v[3]); const float rstd = rsqrtf(ss * (1.f / 128.f) + EPS);
            float o[4];
#pragma unroll
            for (int e = 0; e < 4; ++e) o[e] = v[e] * rstd * gn[(c0 + e) & 127] * siluf_(z[e]);
            u32x2 w; w.x = pk2(o[0], o[1]); w.y = pk2(o[2], o[3]); *(u32x2*)(ar + 1024 + c0) = w; }
    }
}
__device__ __forceinline__ void naive_ssd_unit(const Ctx& C, const bf16_t* P, bf16_t* AO, int unit) {
    const int head = unit & 31, bl = unit >> 5, grp = head >> 3;
    LAS float* x = (LAS float*)C.lds; LAS float* Bm = x + 64 * 64; LAS float* Cm = Bm + 64 * 128; LAS float* dd = Cm + 64 * 128; LAS float* red = dd + 128;
    const int p = C.tid & 63, ng = C.tid >> 6;
    const float* cw = C.in[16]; const float* cb = C.in[17];
    const float A = -expf(C.in[18][head]), dtb = C.in[19][head], Dk = C.in[20][head];
    float hs[16];
#pragma unroll
    for (int i = 0; i < 16; ++i) hs[i] = 0.f;
    for (int c = 0; c < NCHUNK; ++c) {
        const size_t r0 = (size_t)bl * SEQ + (size_t)c * 64; const int ts0 = c * 64;
        __syncthreads();
        for (int idx = C.tid; idx < 64 * 64; idx += 512) { const int t = idx >> 6, pp = idx & 63; const int ch = head * 64 + pp; float a = cb[ch];
#pragma unroll
            for (int j = 0; j < 4; ++j) { const int ts = ts0 + t - 3 + j; if (ts >= 0) a += cw[j * 3072 + ch] * bf2f(P[(r0 + t - 3 + j) * NP1 + C_XBC + ch]); }
            x[idx] = siluf_(a); }
        for (int idx = C.tid; idx < 64 * 128; idx += 512) { const int t = idx >> 7, n = idx & 127; const int chb = 2048 + grp * 128 + n, chc = 2560 + grp * 128 + n; float ab = cb[chb], ac = cb[chc];
#pragma unroll
            for (int j = 0; j < 4; ++j) { const int ts = ts0 + t - 3 + j; if (ts >= 0) { const bf16_t* pr = P + (r0 + t - 3 + j) * NP1 + C_XBC; ab += cw[j * 3072 + chb] * bf2f(pr[chb]); ac += cw[j * 3072 + chc] * bf2f(pr[chc]); } }
            Bm[idx] = siluf_(ab); Cm[idx] = siluf_(ac); }
        if (C.tid < 64) { const float dt = softplusf_(bf2f(P[(r0 + C.tid) * NP1 + C_DT + head]) + dtb); dd[2 * C.tid] = dt; dd[2 * C.tid + 1] = expf(dt * A); }
        __syncthreads();
        for (int t = 0; t < 64; ++t) {
            const float dt = dd[2 * t], dA = dd[2 * t + 1], xv = x[t * 64 + p], dx = dt * xv; float py = 0.f;
#pragma unroll
            for (int i = 0; i < 16; ++i) { hs[i] = dA * hs[i] + dx * Bm[t * 128 + 16 * ng + i]; py += hs[i] * Cm[t * 128 + 16 * ng + i]; }
            LAS float* rb = red + (t & 1) * 512; rb[ng * 64 + p] = py;
            __syncthreads();
            if (ng == 0) { float y = 0.f;
#pragma unroll
                for (int g = 0; g < 8; ++g) y += rb[g * 64 + p];
                AO[(r0 + t) * KO1 + 1024 + head * 64 + p] = f2bf(y + Dk * xv); }
        }
    }
}
__device__ __forceinline__ void phase_gate1(const Ctx& C, const bf16_t* P, bf16_t* AO) {
    const int gw = C.bid * 8 + C.wave, NGW = C.G * 8; const float* sn = C.in[21];
    for (int r = gw; r < GTOK; r += NGW) {
        bf16_t* ar = AO + (size_t)r * KO1 + 1024; const bf16_t* pr = P + (size_t)r * NP1 + C_Z;
#pragma unroll
        for (int gq = 0; gq < 4; ++gq) { float y[8]; float ss = 0.f;
#pragma unroll
            for (int jj = 0; jj < 2; ++jj) { const int c0 = 4 * C.lane + 256 * (2 * gq + jj); const u32x2 raw = *(const u32x2*)(ar + c0); const u32x2 zz = *(const u32x2*)(pr + c0);
                const float v[4] = {__uint_as_float(raw.x << 16), __uint_as_float(raw.x & 0xffff0000u), __uint_as_float(raw.y << 16), __uint_as_float(raw.y & 0xffff0000u)};
                const float z[4] = {__uint_as_float(zz.x << 16), __uint_as_float(zz.x & 0xffff0000u), __uint_as_float(zz.y << 16), __uint_as_float(zz.y & 0xffff0000u)};
#pragma unroll
                for (int e = 0; e < 4; ++e) { y[4 * jj + e] = v[e] * siluf_(z[e]); ss += y[4 * jj + e] * y[4 * jj + e]; } }
            const float rstd = rsqrtf(wave_sum(ss) * (1.f / 512.f) + EPS);
#pragma unroll
            for (int jj = 0; jj < 2; ++jj) { const int c0 = 4 * C.lane + 256 * (2 * gq + jj); u32x2 w;
                w.x = pk2(y[4 * jj] * rstd * sn[c0], y[4 * jj + 1] * rstd * sn[c0 + 1]); w.y = pk2(y[4 * jj + 2] * rstd * sn[c0 + 2], y[4 * jj + 3] * rstd * sn[c0 + 3]); *(u32x2*)(ar + c0) = w; } }
    }
}
__device__ __forceinline__ void naive_attn_unit(const Ctx& C, const bf16_t* P, bf16_t* AO, int unit) {
    const int h = unit & 15, c = (unit >> 4) & 31, bl = unit >> 9;
    LAS float* Kb = (LAS float*)C.lds; LAS float* Vb = Kb + 64 * 64; LAS float* ks = Vb + 64 * 64; LAS float* ml = ks + 64; LAS float* ob = ml + 1024;
    const int t = C.tid & 63, kg = C.tid >> 6;
    const float* qg = C.in[13]; const float* kgn = C.in[14]; const float* rb = C.in[15] + h * 320;
    const size_t r0 = (size_t)bl * SEQ + (size_t)c * 64;
    float q[64], acc[64];
    { const bf16_t* pr = P + (r0 + t) * NP1 + C_AQ + h * 64; float ss = 0.f;
#pragma unroll
      for (int d = 0; d < 64; ++d) { q[d] = bf2f(pr[d]); ss += q[d] * q[d]; }
      const float rs = rsqrtf(ss * (1.f / 64.f) + EPS) * 0.125f;
#pragma unroll
      for (int d = 0; d < 64; ++d) { q[d] *= rs * qg[d] * kgn[d]; acc[d] = 0.f; } }
    float m = -1e30f, l = 0.f;
    const int cb0 = c - 8 < 0 ? 0 : c - 8;
    for (int cb = cb0; cb <= c; ++cb) {
        const size_t k0 = (size_t)bl * SEQ + (size_t)cb * 64;
        __syncthreads();
        for (int idx = C.tid; idx < 64 * 64; idx += 512) { const int j = idx >> 6, d = idx & 63; const bf16_t* pr = P + (k0 + j) * NP1; Kb[idx] = bf2f(pr[C_AK + h * 64 + d]); Vb[idx] = bf2f(pr[C_AV + h * 64 + d]); }
        __syncthreads();
        if (C.tid < 64) { float ss = 0.f; for (int d = 0; d < 64; ++d) ss += Kb[C.tid * 64 + d] * Kb[C.tid * 64 + d]; ks[C.tid] = rsqrtf(ss * (1.f / 64.f) + EPS); }
        __syncthreads();
        for (int i = 0; i < 8; ++i) { const int j = kg + 8 * i; float s = 0.f;
#pragma unroll
            for (int d = 0; d < 64; ++d) s += q[d] * Kb[j * 64 + d];
            int rel = (c - cb) * 64 + t - j; rel = rel < -63 ? -63 : (rel > 256 ? 256 : rel);
            s = s * ks[j] + rb[rel + 63];
            const float mn = fmaxf(m, s), sc = expf(m - mn), p = expf(s - mn); l = l * sc + p; m = mn;
#pragma unroll
            for (int d = 0; d < 64; ++d) acc[d] = acc[d] * sc + p * Vb[j * 64 + d]; }
    }
    __syncthreads();
    ml[kg * 64 + t] = m; ml[512 + kg * 64 + t] = l;
    __syncthreads();
    float M = -1e30f;
#pragma unroll
    for (int g = 0; g < 8; ++g) M = fmaxf(M, ml[g * 64 + t]);
    float L = 0.f;
#pragma unroll
    for (int g = 0; g < 8; ++g) L += ml[512 + g * 64 + t] * expf(ml[g * 64 + t] - M);
    const float fac = expf(m - M) / L;
    for (int g = 0; g < 8; ++g) {
        if (kg == g) {
#pragma unroll
            for (int d = 0; d < 64; ++d) { if (g == 0) ob[t * 65 + d] = acc[d] * fac; else ob[t * 65 + d] += acc[d] * fac; } }
        __syncthreads();
    }
    for (int idx = C.tid; idx < 64 * 64; idx += 512) { const int tt = idx >> 6, d = idx & 63; AO[(r0 + tt) * KO1 + h * 64 + d] = f2bf(ob[tt * 65 + d]); }
}

__device__ __forceinline__ void phase_r1(const Ctx& C, int layer) {
    LAS float* wr = (LAS float*)C.lds; LAS int* hist = (LAS int*)(C.lds + 36 * 1024 * 4);
    const float* wg = C.in[23] + (size_t)layer * 1024 * 4; const float* we = C.in[25] + (size_t)layer * 1024 * 32;
    const float* bg = C.in[24] + layer * 4; const float* be = C.in[26] + layer * 32; const float* gain = C.in[2] + layer * D;
    __syncthreads();
    for (int idx = C.tid; idx < 36 * 1024; idx += 512) { const int cc = idx >> 10, k = idx & 1023; wr[idx] = cc < 4 ? wg[k * 4 + cc] : we[k * 32 + (cc - 4)]; }
    if (C.tid < 32) hist[C.tid] = 0;
    __syncthreads();
    int* route_e = (int*)(C.ws + WS_ROUTE_E); float* route_w = (float*)(C.ws + WS_ROUTE_W);
    f32x4 g[4];
#pragma unroll
    for (int j = 0; j < 4; ++j) g[j] = *(const f32x4*)(gain + 4 * C.lane + 256 * j);
    const int gw = C.bid * 8 + C.wave, NGW = C.G * 8;
    for (int r = gw; r < NTOK; r += NGW) {
        const float* xr = C.out + (size_t)r * D; f32x4 v[4]; float ss = 0.f;
#pragma unroll
        for (int j = 0; j < 4; ++j) { v[j] = *(const f32x4*)(xr + 4 * C.lane + 256 * j); ss += v[j][0] * v[j][0] + v[j][1] * v[j][1] + v[j][2] * v[j][2] + v[j][3] * v[j][3]; }
        const float rstd = rsqrtf(wave_sum(ss) * (1.f / D) + EPS);
#pragma unroll
        for (int j = 0; j < 4; ++j) v[j] = v[j] * rstd * g[j];
        float gl[4];
#pragma unroll
        for (int cc = 0; cc < 4; ++cc) { float a = 0.f;
#pragma unroll
            for (int j = 0; j < 4; ++j) { const f32x4 w = *(const LAS f32x4*)(wr + cc * 1024 + 4 * C.lane + 256 * j); a += v[j][0] * w[0] + v[j][1] * w[1] + v[j][2] * w[2] + v[j][3] * w[3]; }
            gl[cc] = wave_sum(a) + bg[cc]; }
        int gi = 0; float gm = gl[0];
#pragma unroll
        for (int cc = 1; cc < 4; ++cc) if (gl[cc] > gm) { gm = gl[cc]; gi = cc; }
        float gsum = 0.f;
#pragma unroll
        for (int cc = 0; cc < 4; ++cc) gsum += expf(gl[cc] - gm);
        const float gwt = 1.f / gsum;
        float el[8];
#pragma unroll
        for (int i = 0; i < 8; ++i) { float a = 0.f; const LAS float* wrow = wr + (4 + gi * 8 + i) * 1024;
#pragma unroll
            for (int j = 0; j < 4; ++j) { const f32x4 w = *(const LAS f32x4*)(wrow + 4 * C.lane + 256 * j); a += v[j][0] * w[0] + v[j][1] * w[1] + v[j][2] * w[2] + v[j][3] * w[3]; }
            el[i] = wave_sum(a) + be[gi * 8 + i]; }
        int i0 = 0; float v0 = el[0];
#pragma unroll
        for (int i = 1; i < 8; ++i) if (el[i] > v0) { v0 = el[i]; i0 = i; }
        int i1 = -1; float v1 = -3.0e38f;
#pragma unroll
        for (int i = 0; i < 8; ++i) if (i != i0 && el[i] > v1) { v1 = el[i]; i1 = i; }
        const float e1 = expf(v1 - v0), w0 = 1.f / (1.f + e1), w1 = e1 / (1.f + e1);
        if (C.lane == 0) { const int ea = gi * 8 + i0, eb = gi * 8 + i1; route_e[2 * r] = ea; route_e[2 * r + 1] = eb; route_w[2 * r] = gwt * w0; route_w[2 * r + 1] = gwt * w1;
            lds_inc(&hist[ea]); lds_inc(&hist[eb]); }
    }
    __syncthreads();
    if (C.tid < 32 && hist[C.tid]) atomicAdd((int*)(C.ws + WS_CNT) + layer * 32 + C.tid, hist[C.tid]);
}
__device__ __forceinline__ void phase_r2(const Ctx& C, int layer) {
    LAS int* seg = (LAS int*)C.lds; LAS int* hist = seg + 40; LAS int* basee = hist + 32; LAS int* posl = basee + 32;
    const int* counts = (const int*)(C.ws + WS_CNT) + layer * 32; int* cursor = (int*)(C.ws + WS_CNT) + 64 + layer * 32; int* npan = (int*)(C.ws + WS_CNT) + 128 + layer;
    int* panel_expert = (int*)(C.ws + WS_PANEL) + layer * 320;
    const int* route_e = (const int*)(C.ws + WS_ROUTE_E); const float* route_w = (const float*)(C.ws + WS_ROUTE_W); int* POS = (int*)(C.ws + WS_POS); float* WROW = (float*)(C.ws + WS_WROW);
    bf16_t* H2P = (bf16_t*)(C.ws + WS_H2P); const float* gain = C.in[2] + layer * D;
    __syncthreads();
    if (C.tid == 0) { int run = 0; for (int e = 0; e < 32; ++e) { seg[e] = run; const int np = (counts[e] + 255) >> 8;
            if (C.bid == 0) for (int p = 0; p < np; ++p) panel_expert[(run >> 8) + p] = e;
            run += np << 8; }
        seg[32] = run; if (C.bid == 0) *npan = run >> 8; }
    f32x4 g[4];
#pragma unroll
    for (int j = 0; j < 4; ++j) g[j] = *(const f32x4*)(gain + 4 * C.lane + 256 * j);
    for (int base = C.bid * 128; base < NTOK; base += C.G * 128) {
        __syncthreads();
        if (C.tid < 32) hist[C.tid] = 0;
        __syncthreads();
        int e = 0, rank = 0;
        if (C.tid < 256) { e = route_e[2 * base + C.tid]; rank = lds_inc(&hist[e]); }
        __syncthreads();
        if (C.tid < 32) basee[C.tid] = hist[C.tid] ? atomicAdd(&cursor[C.tid], hist[C.tid]) : 0;
        __syncthreads();
        if (C.tid < 256) { const int pos = seg[e] + basee[e] + rank; POS[2 * base + C.tid] = pos; posl[C.tid] = pos; WROW[pos] = route_w[2 * base + C.tid]; }
        __syncthreads();
        for (int i = 0; i < 16; ++i) { const int row = C.wave * 16 + i; const int r = base + row;
            const float* xr = C.out + (size_t)r * D; f32x4 v[4]; float ss = 0.f;
#pragma unroll
            for (int j = 0; j < 4; ++j) { v[j] = *(const f32x4*)(xr + 4 * C.lane + 256 * j); ss += v[j][0] * v[j][0] + v[j][1] * v[j][1] + v[j][2] * v[j][2] + v[j][3] * v[j][3]; }
            const float rstd = rsqrtf(wave_sum(ss) * (1.f / D) + EPS);
            const int p0 = posl[2 * row], p1 = posl[2 * row + 1];
#pragma unroll
            for (int j = 0; j < 4; ++j) { u32x2 o; o.x = pk2(v[j][0] * rstd * g[j][0], v[j][1] * rstd * g[j][1]); o.y = pk2(v[j][2] * rstd * g[j][2], v[j][3] * rstd * g[j][3]);
                *(u32x2*)(H2P + (size_t)p0 * D + 4 * C.lane + 256 * j) = o; *(u32x2*)(H2P + (size_t)p1 * D + 4 * C.lane + 256 * j) = o; } }
    }
}
__device__ __forceinline__ void phase_combine(const Ctx& C) {
    const int* POS = (const int*)(C.ws + WS_POS); const bf16_t* YP = (const bf16_t*)(C.ws + WS_YP);
    const int gw = C.bid * 8 + C.wave, NGW = C.G * 8;
    for (int r = gw; r < NTOK; r += NGW) {
        const int p0 = POS[2 * r], p1 = POS[2 * r + 1]; float* xr = C.out + (size_t)r * D;
#pragma unroll
        for (int j = 0; j < 4; ++j) { const int c0 = 4 * C.lane + 256 * j; f32x4 v = *(const f32x4*)(xr + c0);
            const u32x2 a = *(const u32x2*)(YP + (size_t)p0 * D + c0), b = *(const u32x2*)(YP + (size_t)p1 * D + c0);
            v[0] += __uint_as_float(a.x << 16) + __uint_as_float(b.x << 16); v[1] += __uint_as_float(a.x & 0xffff0000u) + __uint_as_float(b.x & 0xffff0000u);
            v[2] += __uint_as_float(a.y << 16) + __uint_as_float(b.y << 16); v[3] += __uint_as_float(a.y & 0xffff0000u) + __uint_as_float(b.y & 0xffff0000u);
            *(f32x4*)(xr + c0) = v; }
    }
}
#define PH_BEGIN if (ph >= lo && ph < hi) { { int t_ = threadIdx.x; asm volatile("" : "+v"(t_)); C.tid = t_; C.lane = t_ & 63; C.wave = __builtin_amdgcn_readfirstlane(t_ >> 6); }
#define PH_END   if (ph + 1 < hi) xcd_barrier(bar); } ++ph;

__device__ __forceinline__ void moe_block(Ctx& C, const XcdBarrier& bar, int& ph, const int lo, const int hi, const int layer) {
    PH_BEGIN phase_r1(C, layer); PH_END
    PH_BEGIN phase_r2(C, layer); PH_END
    PH_BEGIN {
        const int npan = *((const int*)(C.ws + WS_CNT) + 128 + layer);
        pg8::Gemm g{(const bf16_t*)(C.ws + WS_H2P), (const bf16_t*)(C.ws + WS_W1), MOE_MAXROWS, 32 * 512, 1024};
        pg8::MoeOrder S{(const int*)(C.ws + WS_PANEL) + layer * 320, npan * 2, C.G, C.bid, 1};
        pg8::EpiSwiGLU E{(bf16_t*)(C.ws + WS_ACT), (const float*)(C.ws + WS_WROW)};
        pg8::gemm_phase<pg8::EpiSwiGLU, pg8::MoeOrder, false>(C.lds, g, S, E, nullptr);
    } PH_END
    PH_BEGIN {
        const int npan = *((const int*)(C.ws + WS_CNT) + 128 + layer);
        pg8::Gemm g{(const bf16_t*)(C.ws + WS_ACT), (const bf16_t*)(C.ws + WS_W2), MOE_MAXROWS, 32 * 1024, 256};
        pg8::MoeOrder S{(const int*)(C.ws + WS_PANEL) + layer * 320, npan * 4, C.G, C.bid, 2};
        pg8::EpiBf16P E{(bf16_t*)(C.ws + WS_YP), 1024, 3};
        pg8::gemm_phase<pg8::EpiBf16P, pg8::MoeOrder, false>(C.lds, g, S, E, nullptr);
    } PH_END
    PH_BEGIN phase_combine(C); if (layer == 0) { __syncthreads(); phase_convert(C, 1); } PH_END
}

__global__ void __launch_bounds__(512, 2) mega_fwd(Args args) {
    extern __shared__ __attribute__((aligned(16))) unsigned char lds_raw[];
    Ctx C; C.in = args.in; C.out = args.out; C.ws = args.ws; C.lds = (LAS unsigned char*)lds_raw;
    C.tid = threadIdx.x; C.lane = C.tid & 63; C.wave = __builtin_amdgcn_readfirstlane(C.tid >> 6); C.G = gridDim.x; C.bid = blockIdx.x;
    if (C.tid < 4) ((LAS unsigned*)(C.lds + LDS_BAR_OFF))[C.tid] = 0u;
    __syncthreads();
    XcdBarrier bar = xcd_barrier_post((unsigned*)(C.ws + WS_BAR) + args.li * XCD_BAR_WORDS, (volatile LAS unsigned*)(C.lds + LDS_BAR_OFF));
    const int lo = args.ph_lo, hi = args.ph_hi; int ph = 0;
    bf16_t* HN = (bf16_t*)(C.ws + WS_HN); bf16_t* AO = (bf16_t*)(C.ws + WS_AOUT); bf16_t* PJ = (bf16_t*)(C.ws + WS_PROJ);
    const bf16_t* Win = (const bf16_t*)(C.ws + WS_WIN); const bf16_t* Wout = (const bf16_t*)(C.ws + WS_WOUT);

    PH_BEGIN phase_convert(C, 0); PH_END
    _Pragma("unroll") for (int g = 0; g < NGRP; ++g) {
        const size_t grow = (size_t)g * GTOK;
        PH_BEGIN phase_norm(C, C.in[0] + grow * D, C.in[1], HN, GTOK); PH_END
        PH_BEGIN { pg8::Gemm gm{HN, Win, GTOK, NP0, D}; pg8::StaticOrder S; S.init(GTOK, NP0, C.G, C.bid); pg8::EpiBf16P E{PJ, NP0, 0xffff};
            pg8::gemm_phase<pg8::EpiBf16P, pg8::StaticOrder, false>(C.lds, gm, S, E, nullptr); } PH_END
        PH_BEGIN for (int u = C.bid; u < 256; u += C.G) { if (u < 128) naive_mlstm_unit(C, PJ, AO, u); else naive_gdn_unit(C, PJ, AO, u - 128); } PH_END
        PH_BEGIN phase_gate0(C, PJ, AO); PH_END
        PH_BEGIN { pg8::Gemm gm{AO, Wout, GTOK, D, KO0}; pg8::StaticOrder S; S.init(GTOK, D, C.G, C.bid); pg8::EpiResid E{C.in[0] + grow * D, C.out + grow * D, D};
            pg8::gemm_phase<pg8::EpiResid, pg8::StaticOrder, false>(C.lds, gm, S, E, nullptr); } PH_END
    }
    moe_block(C, bar, ph, lo, hi, 0);
    _Pragma("unroll") for (int g = 0; g < NGRP; ++g) {
        const size_t grow = (size_t)g * GTOK;
        PH_BEGIN phase_norm(C, C.out + grow * D, C.in[1] + D, HN, GTOK); PH_END
        PH_BEGIN { pg8::Gemm gm{HN, Win, GTOK, NP1, D}; pg8::StaticOrder S; S.init(GTOK, NP1, C.G, C.bid); pg8::EpiBf16P E{PJ, NP1, 0xffff};
            pg8::gemm_phase<pg8::EpiBf16P, pg8::StaticOrder, false>(C.lds, gm, S, E, nullptr); } PH_END
        PH_BEGIN for (int u = C.bid; u < 256 + 4096; u += C.G) { if (u < 256) naive_ssd_unit(C, PJ, AO, u); else naive_attn_unit(C, PJ, AO, u - 256); } PH_END
        PH_BEGIN phase_gate1(C, PJ, AO); PH_END
        PH_BEGIN { pg8::Gemm gm{AO, Wout, GTOK, D, KO1}; pg8::StaticOrder S; S.init(GTOK, D, C.G, C.bid); pg8::EpiResid E{C.out + grow * D, C.out + grow * D, D};
            pg8::gemm_phase<pg8::EpiResid, pg8::StaticOrder, false>(C.lds, gm, S, E, nullptr); } PH_END
    }
    moe_block(C, bar, ph, lo, hi, 1);
}
constexpr int N_PHASES = 1 + 2 * (5 * NGRP + 5);

#ifndef N_LAUNCHES
#define N_LAUNCHES 1
#endif
extern "C" void kernel_launch(void* const* d_in, const int* in_sizes, int n_in, void* d_out, int out_size, void* d_ws, size_t ws_size, hipStream_t stream) {
    static int grid = 0;
    if (grid == 0) {
        if (n_in != 30 || out_size != NTOK * D || ws_size < WS_END) { fprintf(stderr, "kernel_launch: unexpected shapes (n_in %d out %d ws %zu)\n", n_in, out_size, ws_size); grid = -1; return; }
        int dev = 0, cus = 0, per_cu = 0;
        if (hipGetDevice(&dev) != hipSuccess || hipDeviceGetAttribute(&cus, hipDeviceAttributeMultiprocessorCount, dev) != hipSuccess) { grid = -1; return; }
        if (hipFuncSetAttribute((const void*)mega_fwd, hipFuncAttributeMaxDynamicSharedMemorySize, LDS_BYTES) != hipSuccess) { fprintf(stderr, "kernel_launch: hipFuncSetAttribute failed\n"); grid = -1; return; }
        if (hipOccupancyMaxActiveBlocksPerMultiprocessor(&per_cu, (const void*)mega_fwd, 512, LDS_BYTES) != hipSuccess || per_cu < 1) fprintf(stderr, "kernel_launch: occupancy query says %d\n", per_cu);
        (void)hipGetLastError();
        grid = cus;
    }
    if (grid < 0) return;
    if (hipMemsetAsync(d_ws, 0, WS_ZERO_BYTES, stream) != hipSuccess) return;
    Args a{};
    for (int i = 0; i < 30; ++i) a.in[i] = (const float*)d_in[i];
    a.out = (float*)d_out; a.ws = (unsigned char*)d_ws; a.pad = 0;
    for (int li = 0; li < N_LAUNCHES; ++li) {
        a.ph_lo = (int)((long)N_PHASES * li / N_LAUNCHES); a.ph_hi = (int)((long)N_PHASES * (li + 1) / N_LAUNCHES); a.li = li;
        hipLaunchKernelGGL(mega_fwd, dim3(grid), dim3(512), LDS_BYTES, stream, a);
    }
}
```

```cpp
#include <hip/hip_runtime.h>
#include <cstdio>
#include <cstdint>
#define XB_TMO      128
#define XB_XCNT(j)  (256  + 64 * (j))
#define XB_XSUB(j)  (1280 + 64 * (j))
#define XB_XGEN(j)  (2304 + 64 * (j))
#define XB_TOP      3328
#define XB_TOPGEN   3392
#define XCD_BAR_WORDS 3456
#define XB_SPIN_CAP (1u << 22)
#define LAS __attribute__((address_space(3)))

__device__ __forceinline__ unsigned xb_ld(unsigned* p)              { return __hip_atomic_load(p, __ATOMIC_RELAXED, __HIP_MEMORY_SCOPE_AGENT); }
__device__ __forceinline__ unsigned xb_add(unsigned* p, unsigned v) { return __hip_atomic_fetch_add(p, v, __ATOMIC_RELAXED, __HIP_MEMORY_SCOPE_AGENT); }
__device__ __forceinline__ unsigned xb_xcc_id() { return (unsigned)__builtin_amdgcn_s_getreg((3 << 11) | 20) & 0xFu; }
#define XB_SPIN(cond, bar) do { unsigned _sp = 0; while (cond) { __builtin_amdgcn_s_sleep(1); \
    if ((++_sp & 255u) == 0u) { if (xb_ld(&(bar)[XB_TMO])) break; if (_sp > XB_SPIN_CAP) { atomicAdd(&(bar)[XB_TMO], 1u); break; } } } } while (0)

struct XcdBarrier {
    int w0;
    unsigned* bar; unsigned x;
    volatile LAS unsigned* st;
};

__device__ __forceinline__ int lane_id_() { int l; asm volatile("v_mbcnt_lo_u32_b32 %0, -1, 0\n\tv_mbcnt_hi_u32_b32 %0, -1, %0" : "=v"(l)); return l; }
__device__ __forceinline__ XcdBarrier xcd_barrier_post(unsigned* bar, volatile LAS unsigned* st, int w0) {
    XcdBarrier b; b.w0 = w0; b.bar = bar; b.x = xb_xcc_id(); b.st = st;
    if (w0 == 0 && lane_id_() == 0) (void)xb_add(&bar[XB_XCNT(b.x)], 1u);
    return b;
}
__device__ __forceinline__ void xcd_barrier_complete(unsigned* bar, unsigned x, unsigned& nloc, unsigned& nx) {
    const unsigned G = gridDim.x * gridDim.y * gridDim.z;
    unsigned sum, cnt, mine, sp = 0u;
    for (;;) {
        sum = 0u; cnt = 0u; mine = 0u;
#pragma unroll
        for (unsigned j = 0; j < 16; ++j) { const unsigned c = xb_ld(&bar[XB_XCNT(j)]); sum += c; cnt += (c > 0u) ? 1u : 0u; mine = (j == x) ? c : mine; }
        if (sum == G) break;
        __builtin_amdgcn_s_sleep(1);
        if ((++sp & 255u) == 0u) { if (xb_ld(&bar[XB_TMO])) break; if (sp > XB_SPIN_CAP) { atomicAdd(&bar[XB_TMO], 1u); break; } }
    }
    nloc = mine > 0u ? mine : 1u; nx = cnt > 0u ? cnt : 1u;
}

__device__ __forceinline__ void xcd_barrier(const XcdBarrier& b) {
    asm volatile("s_waitcnt vmcnt(0)" ::: "memory");
    __syncthreads();
    if (b.w0 == 0 && lane_id_() == 0) {
        unsigned* bar = b.bar;
        __builtin_amdgcn_s_waitcnt(0);
        unsigned nloc = b.st[0], nx = b.st[1];
        if (nloc == 0u) { xcd_barrier_complete(bar, b.x, nloc, nx); b.st[0] = nloc; b.st[1] = nx; }
        const unsigned old = xb_add(&bar[XB_XSUB(b.x)], 1u);
        const unsigned gen = old / nloc;
        if (old + 1u == (gen + 1u) * nloc) {
            __builtin_amdgcn_fence(__ATOMIC_RELEASE, "agent");
            asm volatile("s_waitcnt vmcnt(0)" ::: "memory");
            const unsigned og = xb_add(&bar[XB_TOP], 1u);
            const unsigned tg = og / nx;
            if (og + 1u == (tg + 1u) * nx) xb_add(&bar[XB_TOPGEN], 1u);
            else XB_SPIN(xb_ld(&bar[XB_TOPGEN]) == tg, bar);
            __builtin_amdgcn_fence(__ATOMIC_ACQUIRE, "agent");
            xb_add(&bar[XB_XGEN(b.x)], 1u);
            asm volatile("s_waitcnt vmcnt(0)" ::: "memory");
        } else {
            XB_SPIN(xb_ld(&bar[XB_XGEN(b.x)]) == gen, bar);
            __builtin_amdgcn_fence(__ATOMIC_ACQUIRE, "agent");
            asm volatile("s_waitcnt vmcnt(0)" ::: "memory");
        }
    }
    __syncthreads();
}
namespace pg8 {
#define PG8_LAS __attribute__((address_space(3)))
typedef unsigned short bf16_t;
typedef short bf16x8 __attribute__((ext_vector_type(8)));
typedef float f32x4 __attribute__((ext_vector_type(4)));
typedef unsigned u32x4 __attribute__((ext_vector_type(4)));
constexpr int BM = 256, BK = 64, HALF = 128, HTB = HALF * BK * 2  , STAGE_BYTES = 8 * HTB, NXCD = 8, WGM = 8;

__host__ __device__ __forceinline__ int lds_byte(int r, int c) { const int st = (r >> 4) * 2 + (c >> 5), rr = r & 15, cc = c & 31, ob = rr * 64 + cc * 2; return st * 1024 + (ob ^ (((ob >> 9) & 1) << 5)); }
__host__ __device__ __forceinline__ void stage_rc(int b, int& R, int& C) { const int st = b / 1024, sb = b % 1024, swz = sb ^ (((sb >> 9) & 1) << 5); R = (st >> 1) * 16 + swz / 64; C = (st & 1) * 32 + (swz % 64) / 2; }
__host__ __device__ __forceinline__ int perm32(int rho) { const int n = rho >> 4, i = rho & 15; return 8 * (i >> 2) + 4 * n + (i & 3); }

struct Unit { int pm, pn; };
struct Gemm { const bf16_t* A; const bf16_t* Bt; int M, N, K; };

struct StaticOrder {
    int nM, nN, nwg, G, c;
    __host__ __device__ void init(int M, int N, int G_, int c_) { nM = M / BM; nN = N / BM; nwg = nM * nN; G = G_; c = c_; }
    __host__ __device__ bool next(int i, Unit& u) const {
        const long L = (long)i * G + c; if (L >= nwg) return false;
        int wgid = (int)L; { const int q = nwg / NXCD, r = nwg % NXCD, xcd = wgid % NXCD, off = wgid / NXCD; wgid = (xcd < r ? xcd * (q + 1) : r * (q + 1) + (xcd - r) * q) + off; }
        const int nig = WGM * nN, gid = wgid / nig, fm = gid * WGM, gsz = (nM - fm) < WGM ? (nM - fm) : WGM;
        u.pm = fm + ((wgid % nig) % gsz); u.pn = (wgid % nig) / gsz; return true;
    }
    __device__ __forceinline__ void a_ready(const Unit&) const {}
    __device__ __forceinline__ void done(const Unit&) const {}
};

typedef float f32x2c __attribute__((ext_vector_type(2))); typedef __bf16 bf16x2c __attribute__((ext_vector_type(2)));
__device__ __forceinline__ unsigned cvt_pk_bf16(float lo, float hi) { const f32x2c v = {lo, hi}; return __builtin_bit_cast(unsigned, __builtin_convertvector(v, bf16x2c)); }
typedef float f32x2 __attribute__((ext_vector_type(2)));
template <class Epi, class Sched, bool STAMP = false>
__device__ __forceinline__ void gemm_phase(PG8_LAS unsigned char* lds, const Gemm g, const Sched& S, const Epi& E, unsigned long long* stamps, const int wave0) {
    int tid_l = wave0 * 64 + lane_id_(); asm volatile("" : "+v"(tid_l)); const int tid = tid_l, wid = __builtin_amdgcn_readfirstlane(tid >> 6), lane = tid & 63, wr = wid >> 2, wc = wid & 3, fr = lane & 15, fq = lane >> 4;
    const int K = g.K, nt = K / BK;
    int ts_lo = 0, ts_hi = 0, nts = 0; const unsigned long long rt_entry = STAMP ? (unsigned long long)wall_clock64() : 0ull;
#define PG8_STAMP() do { if (STAMP && wid == 0 && nts < 64) { const unsigned long long _c = (unsigned long long)clock64(); \
        ts_lo = (lane == nts) ? (int)(unsigned)_c : ts_lo; ts_hi = (lane == nts) ? (int)(unsigned)(_c >> 32) : ts_hi; ++nts; } } while (0)
    PG8_STAMP();
    unsigned voffA[2], voffB[2];
#pragma unroll
    for (int i = 0; i < 2; ++i) { int R, C; stage_rc(tid * 16 + i * 8192, R, C); const int Rb = Epi::PERM ? ((R & ~31) + perm32(R & 31)) : R;
        voffA[i] = (unsigned)(R * K + C) * 2u; voffB[i] = (unsigned)(Rb * K + C) * 2u; }
    const size_t kstep = (size_t)(BK * 2);
    const size_t hstep = (size_t)HALF * K * 2;
    const size_t tstep = 2 * hstep;
    const unsigned ldsw = (unsigned)wid * 1024u;
    const int aoff = lds_byte(wr * 64 + fr, fq * 8), boff = lds_byte(wc * 32 + fr, fq * 8);
#define PG8_SA(b, h) (((b) * 2 + (h)) * HTB)
#define PG8_SB(b, h) ((4 + (b) * 2 + (h)) * HTB)
#define PG8_STAGE(bufoff, gbase, voff) do { _Pragma("unroll") for (int _i = 0; _i < 2; ++_i) \
        __builtin_amdgcn_global_load_lds((const unsigned*)((const char*)(gbase) + (voff)[_i]), (PG8_LAS unsigned*)(lds + (bufoff) + ldsw + _i * 8192), 16, 0, 0); } while (0)
#define PG8_LDA(dst, b, h) do { _Pragma("unroll") for (int m = 0; m < 4; ++m) _Pragma("unroll") for (int k = 0; k < 2; ++k) dst[m][k] = *(const PG8_LAS bf16x8*)(lds + PG8_SA(b, h) + aoff + m * 2048 + k * 1024); } while (0)
#define PG8_LDB(dst, b, h) do { _Pragma("unroll") for (int n = 0; n < 2; ++n) _Pragma("unroll") for (int k = 0; k < 2; ++k) dst[n][k] = *(const PG8_LAS bf16x8*)(lds + PG8_SB(b, h) + boff + n * 2048 + k * 1024); } while (0)
#define PG8_MMA(ai, bj, At, Bt) do { __builtin_amdgcn_s_setprio(1); _Pragma("unroll") for (int m = 0; m < 4; ++m) _Pragma("unroll") for (int n = 0; n < 2; ++n) _Pragma("unroll") for (int k = 0; k < 2; ++k) \
        acc[ai][bj][m][n] = __builtin_amdgcn_mfma_f32_16x16x32_bf16(Bt[n][k], At[m][k], acc[ai][bj][m][n], 0, 0, 0); __builtin_amdgcn_s_setprio(0); } while (0)
#define PG8_WAIT_V(n) asm volatile("s_waitcnt vmcnt(" #n ")" ::: "memory")
#define PG8_WAIT_L(n) asm volatile("s_waitcnt lgkmcnt(" #n ")" ::: "memory")
#define PG8_BAR __builtin_amdgcn_s_barrier()
#define PG8_SCHED __builtin_amdgcn_sched_barrier(0)
    Unit cur, nxt; int ui = 0;
    if (!S.next(0, cur)) return;
    f32x4 acc[2][2][4][2];
#pragma unroll
    for (int a = 0; a < 2; ++a)
#pragma unroll
        for (int b = 0; b < 2; ++b)
#pragma unroll
            for (int m = 0; m < 4; ++m)
#pragma unroll
                for (int n = 0; n < 2; ++n) acc[a][b][m][n] = (f32x4){0.f, 0.f, 0.f, 0.f};
    bf16x8 At[4][2], B0[2][2], B1[2][2];
    const char* cA = (const char*)g.A + (size_t)cur.pm * tstep; const char* cB = (const char*)g.Bt + (size_t)cur.pn * tstep;
    S.a_ready(cur);
    PG8_STAGE(PG8_SB(0, 0), cB, voffB); PG8_STAGE(PG8_SA(0, 0), cA, voffA); PG8_STAGE(PG8_SB(0, 1), cB + hstep, voffB); PG8_STAGE(PG8_SA(0, 1), cA + hstep, voffA);
    if (wr == 1) PG8_BAR;
    PG8_WAIT_V(4); PG8_BAR;
    PG8_STAGE(PG8_SB(1, 0), cB + kstep, voffB); PG8_STAGE(PG8_SA(1, 0), cA + kstep, voffA); PG8_STAGE(PG8_SB(1, 1), cB + hstep + kstep, voffB);
    PG8_WAIT_V(6); PG8_BAR;
    PG8_STAMP();
    for (;;) {
        const bool has_next = S.next(ui + 1, nxt);
        const char* nA = has_next ? (const char*)g.A + (size_t)nxt.pm * tstep : cA; const char* nB = has_next ? (const char*)g.Bt + (size_t)nxt.pn * tstep : cB;
        for (int t = 0; t < nt; t += 2) {
            const bool last = (t == nt - 2);
            const char* a1 = cA + (size_t)(t + 1) * kstep;
            const char* a2 = last ? nA : cA + (size_t)(t + 2) * kstep; const char* b2 = last ? nB : cB + (size_t)(t + 2) * kstep;
            const char* a3 = a2 + kstep; const char* b3 = b2 + kstep;
            if (last && has_next) S.a_ready(nxt);
            PG8_LDB(B0, 0, 0); PG8_SCHED; PG8_LDA(At, 0, 0); PG8_STAGE(PG8_SA(1, 1), a1 + hstep, voffA);
            PG8_WAIT_L(8); PG8_BAR; PG8_WAIT_L(0); PG8_MMA(0, 0, At, B0); PG8_BAR; PG8_SCHED;
            PG8_LDB(B1, 0, 1); PG8_STAGE(PG8_SB(0, 0), b2, voffB);
            PG8_BAR; PG8_WAIT_L(0); PG8_MMA(0, 1, At, B1); PG8_BAR;
            PG8_LDA(At, 0, 1); PG8_STAGE(PG8_SA(0, 0), a2, voffA);
            PG8_BAR; PG8_WAIT_L(0); PG8_MMA(1, 0, At, B0); PG8_BAR; PG8_SCHED;
            PG8_STAGE(PG8_SB(0, 1), b2 + hstep, voffB);
            PG8_WAIT_V(6); PG8_BAR; PG8_MMA(1, 1, At, B1); PG8_BAR;
            PG8_LDB(B0, 1, 0); PG8_SCHED; PG8_LDA(At, 1, 0); PG8_STAGE(PG8_SA(0, 1), a2 + hstep, voffA);
            PG8_WAIT_L(8); PG8_BAR; PG8_WAIT_L(0); PG8_MMA(0, 0, At, B0); PG8_BAR; PG8_SCHED;
            PG8_LDB(B1, 1, 1); PG8_STAGE(PG8_SB(1, 0), b3, voffB);
            PG8_BAR; PG8_WAIT_L(0); PG8_MMA(0, 1, At, B1); PG8_BAR;
            PG8_LDA(At, 1, 1); PG8_STAGE(PG8_SA(1, 0), a3, voffA);
            PG8_BAR; PG8_WAIT_L(0); PG8_MMA(1, 0, At, B0); PG8_BAR; PG8_SCHED;
            PG8_STAGE(PG8_SB(1, 1), b3 + hstep, voffB);
            PG8_WAIT_V(6); PG8_BAR; PG8_MMA(1, 1, At, B1); PG8_BAR;
        }
        PG8_STAMP();
        if constexpr (!Epi::AFTER_DRAIN) { E(acc, cur, wr, wc, fr, fq); S.done(cur); }
        PG8_STAMP();
        if (!has_next) break;
#pragma unroll
        for (int a = 0; a < 2; ++a)
#pragma unroll
            for (int b = 0; b < 2; ++b)
#pragma unroll
                for (int m = 0; m < 4; ++m)
#pragma unroll
                    for (int n = 0; n < 2; ++n) acc[a][b][m][n] = (f32x4){0.f, 0.f, 0.f, 0.f};
        cur = nxt; cA = nA; cB = nB; ++ui;
    }
    PG8_WAIT_V(0);
    if (wr == 0) PG8_BAR;
    PG8_BAR;
    if constexpr (Epi::AFTER_DRAIN) { E.fused(acc, cur, wr, wc, fr, fq, lds, wid, lane); S.done(cur); }
    PG8_STAMP();
    if (STAMP && wid == 0) { stamps[lane] = lane < nts ? (((unsigned long long)(unsigned)ts_hi << 32) | (unsigned)ts_lo) : 0ull;
        if (lane == 62) stamps[62] = rt_entry; if (lane == 63) stamps[63] = (unsigned long long)wall_clock64(); }
#undef PG8_STAMP
#undef PG8_SA
#undef PG8_SB
#undef PG8_STAGE
#undef PG8_LDA
#undef PG8_LDB
#undef PG8_MMA
#undef PG8_WAIT_V
#undef PG8_WAIT_L
#undef PG8_BAR
#undef PG8_SCHED
}
template <class Epi, class Sched, bool STAMP = false>
__device__ __forceinline__ void gemm_phase_g(PG8_LAS unsigned char* lds, const Gemm g, const Sched& S, const Epi& E, const int* rowtok, unsigned long long* stamps, const int wave0) {
    int tid_l = wave0 * 64 + lane_id_(); asm volatile("" : "+v"(tid_l)); const int tid = tid_l, wid = __builtin_amdgcn_readfirstlane(tid >> 6), lane = tid & 63, wr = wid >> 2, wc = wid & 3, fr = lane & 15, fq = lane >> 4;
    const int K = g.K, nt = K / BK;
    int ts_lo = 0, ts_hi = 0, nts = 0; const unsigned long long rt_entry = STAMP ? (unsigned long long)wall_clock64() : 0ull;
#define PG8_STAMP() do { if (STAMP && wid == 0 && nts < 64) { const unsigned long long _c = (unsigned long long)clock64(); \
        ts_lo = (lane == nts) ? (int)(unsigned)_c : ts_lo; ts_hi = (lane == nts) ? (int)(unsigned)(_c >> 32) : ts_hi; ++nts; } } while (0)
    PG8_STAMP();
    unsigned voffA[2], voffB[2]; int rowA[2]; unsigned colA2[2];
#pragma unroll
    for (int i = 0; i < 2; ++i) { int R, C; stage_rc(tid * 16 + i * 8192, R, C); const int Rb = Epi::PERM ? ((R & ~31) + perm32(R & 31)) : R;
        voffA[i] = (unsigned)(R * K + C) * 2u; voffB[i] = (unsigned)(Rb * K + C) * 2u; rowA[i] = R; colA2[i] = (unsigned)C * 2u; }
    (void)voffA; const unsigned K2 = (unsigned)K * 2u; unsigned gc[2][2], gn[2][2];
    const size_t kstep = (size_t)(BK * 2);
    const size_t hstep = (size_t)HALF * K * 2;
    const size_t tstep = 2 * hstep;
    const unsigned ldsw = (unsigned)wid * 1024u;
    const int aoff = lds_byte(wr * 64 + fr, fq * 8), boff = lds_byte(wc * 32 + fr, fq * 8);
#define PG8_SA(b, h) (((b) * 2 + (h)) * HTB)
#define PG8_SB(b, h) ((4 + (b) * 2 + (h)) * HTB)
#define PG8_STAGE(bufoff, gbase, voff) do { _Pragma("unroll") for (int _i = 0; _i < 2; ++_i) \
        __builtin_amdgcn_global_load_lds((const unsigned*)((const char*)(gbase) + (voff)[_i]), (PG8_LAS unsigned*)(lds + (bufoff) + ldsw + _i * 8192), 16, 0, 0); } while (0)
#define PG8_LDA(dst, b, h) do { _Pragma("unroll") for (int m = 0; m < 4; ++m) _Pragma("unroll") for (int k = 0; k < 2; ++k) dst[m][k] = *(const PG8_LAS bf16x8*)(lds + PG8_SA(b, h) + aoff + m * 2048 + k * 1024); } while (0)
#define PG8_LDB(dst, b, h) do { _Pragma("unroll") for (int n = 0; n < 2; ++n) _Pragma("unroll") for (int k = 0; k < 2; ++k) dst[n][k] = *(const PG8_LAS bf16x8*)(lds + PG8_SB(b, h) + boff + n * 2048 + k * 1024); } while (0)
#define PG8_MMA(ai, bj, At, Bt) do { __builtin_amdgcn_s_setprio(1); _Pragma("unroll") for (int m = 0; m < 4; ++m) _Pragma("unroll") for (int n = 0; n < 2; ++n) _Pragma("unroll") for (int k = 0; k < 2; ++k) \
        acc[ai][bj][m][n] = __builtin_amdgcn_mfma_f32_16x16x32_bf16(Bt[n][k], At[m][k], acc[ai][bj][m][n], 0, 0, 0); __builtin_amdgcn_s_setprio(0); } while (0)
#define PG8_WAIT_V(n) asm volatile("s_waitcnt vmcnt(" #n ")" ::: "memory")
#define PG8_WAIT_L(n) asm volatile("s_waitcnt lgkmcnt(" #n ")" ::: "memory")
#define PG8_BAR __builtin_amdgcn_s_barrier()
#define PG8_SCHED __builtin_amdgcn_sched_barrier(0)
    Unit cur, nxt; int ui = 0;
    if (!S.next(0, cur)) return;
    f32x4 acc[2][2][4][2];
#pragma unroll
    for (int a = 0; a < 2; ++a)
#pragma unroll
        for (int b = 0; b < 2; ++b)
#pragma unroll
            for (int m = 0; m < 4; ++m)
#pragma unroll
                for (int n = 0; n < 2; ++n) acc[a][b][m][n] = (f32x4){0.f, 0.f, 0.f, 0.f};
    bf16x8 At[4][2], B0[2][2], B1[2][2];
    const char* const cA = (const char*)g.A; const char* cB = (const char*)g.Bt + (size_t)cur.pn * tstep;
#pragma unroll
    for (int h = 0; h < 2; ++h)
#pragma unroll
        for (int i = 0; i < 2; ++i) gc[h][i] = (unsigned)rowtok[cur.pm * BM + h * HALF + rowA[i]] * K2 + colA2[i];
    S.a_ready(cur);
    PG8_STAGE(PG8_SB(0, 0), cB, voffB); PG8_STAGE(PG8_SA(0, 0), cA, gc[0]); PG8_STAGE(PG8_SB(0, 1), cB + hstep, voffB); PG8_STAGE(PG8_SA(0, 1), cA, gc[1]);
    if (wr == 1) PG8_BAR;
    PG8_WAIT_V(4); PG8_BAR;
    PG8_STAGE(PG8_SB(1, 0), cB + kstep, voffB); PG8_STAGE(PG8_SA(1, 0), cA + kstep, gc[0]); PG8_STAGE(PG8_SB(1, 1), cB + hstep + kstep, voffB);
    PG8_WAIT_V(6); PG8_BAR;
    PG8_STAMP();
    for (;;) {
        const bool has_next = S.next(ui + 1, nxt);
        const char* nB = has_next ? (const char*)g.Bt + (size_t)nxt.pn * tstep : cB;
#pragma unroll
        for (int h = 0; h < 2; ++h)
#pragma unroll
            for (int i = 0; i < 2; ++i) gn[h][i] = has_next ? (unsigned)rowtok[nxt.pm * BM + h * HALF + rowA[i]] * K2 + colA2[i] : gc[h][i];
        for (int t = 0; t < nt; t += 2) {
            const bool last = (t == nt - 2);
            const char* a1 = cA + (size_t)(t + 1) * kstep;
            const char* a2 = last ? cA : cA + (size_t)(t + 2) * kstep; const char* b2 = last ? nB : cB + (size_t)(t + 2) * kstep;
            const unsigned o20[2] = {last ? gn[0][0] : gc[0][0], last ? gn[0][1] : gc[0][1]}, o21[2] = {last ? gn[1][0] : gc[1][0], last ? gn[1][1] : gc[1][1]};
            const char* a3 = a2 + kstep; const char* b3 = b2 + kstep;
            if (last && has_next) S.a_ready(nxt);
            PG8_LDB(B0, 0, 0); PG8_SCHED; PG8_LDA(At, 0, 0); PG8_STAGE(PG8_SA(1, 1), a1, gc[1]);
            PG8_WAIT_L(8); PG8_BAR; PG8_WAIT_L(0); PG8_MMA(0, 0, At, B0); PG8_BAR; PG8_SCHED;
            PG8_LDB(B1, 0, 1); PG8_STAGE(PG8_SB(0, 0), b2, voffB);
            PG8_BAR; PG8_WAIT_L(0); PG8_MMA(0, 1, At, B1); PG8_BAR;
            PG8_LDA(At, 0, 1); PG8_STAGE(PG8_SA(0, 0), a2, o20);
            PG8_BAR; PG8_WAIT_L(0); PG8_MMA(1, 0, At, B0); PG8_BAR; PG8_SCHED;
            PG8_STAGE(PG8_SB(0, 1), b2 + hstep, voffB);
            PG8_WAIT_V(6); PG8_BAR; PG8_MMA(1, 1, At, B1); PG8_BAR;
            PG8_LDB(B0, 1, 0); PG8_SCHED; PG8_LDA(At, 1, 0); PG8_STAGE(PG8_SA(0, 1), a2, o21);
            PG8_WAIT_L(8); PG8_BAR; PG8_WAIT_L(0); PG8_MMA(0, 0, At, B0); PG8_BAR; PG8_SCHED;
            PG8_LDB(B1, 1, 1); PG8_STAGE(PG8_SB(1, 0), b3, voffB);
            PG8_BAR; PG8_WAIT_L(0); PG8_MMA(0, 1, At, B1); PG8_BAR;
            PG8_LDA(At, 1, 1); PG8_STAGE(PG8_SA(1, 0), a3, o20);
            PG8_BAR; PG8_WAIT_L(0); PG8_MMA(1, 0, At, B0); PG8_BAR; PG8_SCHED;
            PG8_STAGE(PG8_SB(1, 1), b3 + hstep, voffB);
            PG8_WAIT_V(6); PG8_BAR; PG8_MMA(1, 1, At, B1); PG8_BAR;
        }
        PG8_STAMP();
        if constexpr (!Epi::AFTER_DRAIN) { E(acc, cur, wr, wc, fr, fq); S.done(cur); }
        PG8_STAMP();
        if (!has_next) break;
#pragma unroll
        for (int a = 0; a < 2; ++a)
#pragma unroll
            for (int b = 0; b < 2; ++b)
#pragma unroll
                for (int m = 0; m < 4; ++m)
#pragma unroll
                    for (int n = 0; n < 2; ++n) acc[a][b][m][n] = (f32x4){0.f, 0.f, 0.f, 0.f};
        cur = nxt; cB = nB; ++ui;
#pragma unroll
        for (int h = 0; h < 2; ++h)
#pragma unroll
            for (int i = 0; i < 2; ++i) gc[h][i] = gn[h][i];
    }
    PG8_WAIT_V(0);
    if (wr == 0) PG8_BAR;
    PG8_BAR;
    if constexpr (Epi::AFTER_DRAIN) { E.fused(acc, cur, wr, wc, fr, fq, lds, wid, lane); S.done(cur); }
    PG8_STAMP();
    if (STAMP && wid == 0) { stamps[lane] = lane < nts ? (((unsigned long long)(unsigned)ts_hi << 32) | (unsigned)ts_lo) : 0ull;
        if (lane == 62) stamps[62] = rt_entry; if (lane == 63) stamps[63] = (unsigned long long)wall_clock64(); }
#undef PG8_STAMP
#undef PG8_SA
#undef PG8_SB
#undef PG8_STAGE
#undef PG8_LDA
#undef PG8_LDB
#undef PG8_MMA
#undef PG8_WAIT_V
#undef PG8_WAIT_L
#undef PG8_BAR
#undef PG8_SCHED
}
}
typedef pg8::bf16_t bf16_t;
typedef pg8::f32x4 f32x4;
typedef pg8::u32x4 u32x4;
typedef unsigned u32x2 __attribute__((ext_vector_type(2)));

constexpr int D = 1024, NBATCH = 16, SEQ = 2048, NTOK = NBATCH * SEQ, NGRP = 2, GBATCH = NBATCH / NGRP, GTOK = GBATCH * SEQ, NCHUNK = SEQ / 64;
constexpr int NP0 = 7168, NP1 = 8192, KO0 = 2048, KO1 = 3072;
constexpr float EPS = 1e-6f;
constexpr int C_MQ = 0, C_MK = 512, C_MV = 1024, C_MO = 2048, C_GQ = 3072, C_GZ = 6144, C_SM0 = 7168;
constexpr int C_AQ = 0, C_AK = 1024, C_AV = 2048, C_Z = 3072, C_XBC = 5120, C_DT = 8192;
constexpr int MOE_MAXROWS = 73728;
__device__ __forceinline__ size_t pjt(size_t row, int col, int nt) { return (((row >> 8) * nt + (size_t)(col >> 8)) << 16) + (((row >> 6) & 3) << 14) + ((size_t)((col >> 6) & 3) << 12) + ((row & 63) << 6) + (size_t)(col & 63); }
__device__ __forceinline__ size_t pj0(size_t row, int col) { return pjt(row, col, 28); }
__device__ __forceinline__ size_t pj1(size_t row, int col) { return pjt(row, col, 32); }

constexpr size_t MiB = 1ull << 20;
constexpr size_t WS_BAR = 0;
constexpr size_t WS_CNT = 128 * 1024;
constexpr size_t WS_PANEL = 132 * 1024;
constexpr size_t WS_ZERO_BYTES = 160 * 1024;
constexpr size_t WS_ROWTOK = 2 * MiB + 512 * 1024;
constexpr size_t WS_RW = 3 * MiB + 640 * 1024;
constexpr size_t WS_WSM1 = 3 * MiB + 128 * 1024;
constexpr size_t WS_WSM = 3 * MiB + 512 * 1024, WS_SM0 = 348 * MiB, WS_SM1 = 380 * MiB;
constexpr size_t WS_ROUTE_E = 1 * MiB, WS_ROUTE_W = WS_ROUTE_E + 256 * 1024, WS_POS = WS_ROUTE_W + 256 * 1024, WS_WROW = 2 * MiB, WS_GTOT = 3 * MiB;
constexpr size_t WS_WIN = 4 * MiB, WS_WOUT = 21 * MiB;
constexpr size_t WS_XB3 = 92 * MiB;
constexpr size_t WS_XC = 384 * MiB, WS_HN1A = 384 * MiB, WS_HN1B = 480 * MiB;
constexpr size_t WS_AOUT = 28 * MiB, WS_PROJ = 124 * MiB, WS_HN = 388 * MiB, WS_PREP = 356 * MiB;
constexpr size_t WS_H2P = 28 * MiB, WS_ACT = 172 * MiB, WS_YP = 208 * MiB, WS_W1 = 352 * MiB, WS_W2 = 384 * MiB;
constexpr size_t WS_END = 512 * MiB;
constexpr int LDS_BYTES = 163840, LDS_BAR_OFF = LDS_BYTES - 16;

struct Args { const float* in[30]; float* out; unsigned char* ws; int ph_lo, ph_hi, li, pad; };

struct Ctx {
    const float* const* in; float* out; unsigned char* ws; LAS unsigned char* lds;
    int tid, lane, wave, G, bid, wave0;
};

__device__ __forceinline__ float bf2f(bf16_t b) { return __uint_as_float(((unsigned)b) << 16); }
__device__ __forceinline__ bf16_t f2bf(float f) { unsigned u = __float_as_uint(f); u += 0x7fffu + ((u >> 16) & 1u); return (bf16_t)(u >> 16); }
__device__ __forceinline__ unsigned pk2(float lo, float hi) { return (unsigned)f2bf(lo) | ((unsigned)f2bf(hi) << 16); }
template <int CTRL> __device__ __forceinline__ float dpp_(float v) { return __builtin_bit_cast(float, __builtin_amdgcn_update_dpp(0, __builtin_bit_cast(int, v), CTRL, 0xf, 0xf, true)); }
__device__ __forceinline__ float quad_sum(float v) { v += dpp_<0xB1>(v); v += dpp_<0x4E>(v); return v; }
__device__ __forceinline__ float row_sum16(float v) { v = quad_sum(v); v += dpp_<0x124>(v); v += dpp_<0x128>(v); return v; }
__device__ __forceinline__ float rdl_(float v, int l) { return __builtin_bit_cast(float, __builtin_amdgcn_readlane(__builtin_bit_cast(int, v), l)); }
__device__ __forceinline__ float wave_sum(float v) { v = row_sum16(v); return (rdl_(v, 0) + rdl_(v, 16)) + (rdl_(v, 32) + rdl_(v, 48)); }
__device__ __forceinline__ float half_sum(float v, int lane) {
    v = row_sum16(v); const float lo = rdl_(v, 0) + rdl_(v, 16), hi = rdl_(v, 32) + rdl_(v, 48); return (lane & 32) ? hi : lo;
}
__device__ __forceinline__ float frcp_(float x) { return __builtin_amdgcn_rcpf(x); }
__device__ __forceinline__ float sigmoidf_(float x) { return frcp_(1.f + __expf(-x)); }
__device__ __forceinline__ float siluf_(float x) { return x * frcp_(1.f + __expf(-x)); }
__device__ __forceinline__ float softplusf_(float x) { return x > 20.f ? x : log1pf(expf(x)); }
__device__ __forceinline__ int lds_inc(LAS int* p) { return __hip_atomic_fetch_add(p, 1, __ATOMIC_RELAXED, __HIP_MEMORY_SCOPE_WORKGROUP); }
#define LDS_WAIT() asm volatile("s_waitcnt lgkmcnt(0)" ::: "memory")

__device__ __forceinline__ void st8_wt(void* p, u32x2 v) { __hip_atomic_store((unsigned long long*)p, __builtin_bit_cast(unsigned long long, v), __ATOMIC_RELAXED, __HIP_MEMORY_SCOPE_AGENT); }
namespace pg8 {
__device__ __forceinline__ void st16_wt(void* p, u32x4 v) { asm volatile("global_store_dwordx4 %0, %1, off sc1\n\ts_nop 1" :: "v"(p), "v"(v) : "memory"); }
struct EpiBf16P {
    static constexpr bool PERM = true, AFTER_DRAIN = false;
    bf16_t* O; int ldc; int pn_mask;
    __device__ __forceinline__ void operator()(const f32x4 (&acc)[2][2][4][2], const Unit& u, int wr, int wc, int fr, int fq) const {
        const int row0 = u.pm * BM + wr * 64 + fr; const int col0 = (u.pn & pn_mask) * BM + wc * 32 + 8 * fq;
#pragma unroll
        for (int ai = 0; ai < 2; ++ai)
#pragma unroll
            for (int m = 0; m < 4; ++m) { bf16_t* rowp = O + (size_t)(row0 + ai * HALF + m * 16) * ldc + col0;
#pragma unroll
                for (int bj = 0; bj < 2; ++bj) { const f32x4 v0 = acc[ai][bj][m][0], v1 = acc[ai][bj][m][1];
                    u32x4 w; w.x = cvt_pk_bf16(v0[0], v0[1]); w.y = cvt_pk_bf16(v0[2], v0[3]); w.z = cvt_pk_bf16(v1[0], v1[1]); w.w = cvt_pk_bf16(v1[2], v1[3]);
                    *(u32x4*)(rowp + bj * HALF) = w; } }
    }
};
struct EpiBf16QK {
    static constexpr bool PERM = true, AFTER_DRAIN = false;
    bf16_t* O; int ldc; const PG8_LAS float* gn;
    __device__ __forceinline__ void operator()(const f32x4 (&acc)[2][2][4][2], const Unit& u, int wr, int wc, int fr, int fq) const {
        const int row0 = u.pm * BM + wr * 64 + fr;
        if (u.pn < 8) {
            const PG8_LAS float* gp = gn + (u.pn >= 4 ? 64 : 0) + 8 * fq;
            f32x4 gq[2][2];
#pragma unroll
            for (int bj = 0; bj < 2; ++bj)
#pragma unroll
                for (int n = 0; n < 2; ++n) gq[bj][n] = *(const PG8_LAS f32x4*)(gp + bj * 32 + n * 4);
            const int col0 = u.pn * BM + wc * 64 + 8 * fq;
#pragma unroll
            for (int ai = 0; ai < 2; ++ai)
#pragma unroll
                for (int m = 0; m < 4; ++m) { bf16_t* rowp = O + (size_t)(row0 + ai * HALF + m * 16) * ldc + col0;
                    float ss = 0.f;
#pragma unroll
                    for (int bj = 0; bj < 2; ++bj)
#pragma unroll
                        for (int n = 0; n < 2; ++n) { const f32x4 v = acc[ai][bj][m][n]; ss += v[0] * v[0] + v[1] * v[1] + v[2] * v[2] + v[3] * v[3]; }
                    ss += __shfl_xor(ss, 16); ss += __shfl_xor(ss, 32);
                    const float rs = __builtin_amdgcn_rsqf(ss * (1.f / 64.f) + 1e-6f);
#pragma unroll
                    for (int bj = 0; bj < 2; ++bj) { const f32x4 v0 = acc[ai][bj][m][0] * gq[bj][0] * rs, v1 = acc[ai][bj][m][1] * gq[bj][1] * rs;
                        u32x4 w; w.x = cvt_pk_bf16(v0[0], v0[1]); w.y = cvt_pk_bf16(v0[2], v0[3]); w.z = cvt_pk_bf16(v1[0], v1[1]); w.w = cvt_pk_bf16(v1[2], v1[3]);
                        *(u32x4*)(rowp + bj * 32) = w; } }
        } else {
            const int col0 = u.pn * BM + wc * 32 + 8 * fq;
#pragma unroll
            for (int ai = 0; ai < 2; ++ai)
#pragma unroll
                for (int m = 0; m < 4; ++m) { bf16_t* rowp = O + (size_t)(row0 + ai * HALF + m * 16) * ldc + col0;
#pragma unroll
                    for (int bj = 0; bj < 2; ++bj) { const f32x4 v0 = acc[ai][bj][m][0], v1 = acc[ai][bj][m][1];
                        u32x4 w; w.x = cvt_pk_bf16(v0[0], v0[1]); w.y = cvt_pk_bf16(v0[2], v0[3]); w.z = cvt_pk_bf16(v1[0], v1[1]); w.w = cvt_pk_bf16(v1[2], v1[3]);
                        *(u32x4*)(rowp + bj * HALF) = w; } }
        }
    }
};
template <bool QKN> struct EpiBf16QKT {
    static constexpr bool PERM = true, AFTER_DRAIN = false;
    bf16_t* O; int ldc; const PG8_LAS float* gn; PG8_LAS unsigned char* scr;
    __device__ __forceinline__ void operator()(const f32x4 (&acc)[2][2][4][2], const Unit& u, int wr, int wc, int fr, int fq) const {
        PG8_LAS unsigned char* sw = scr + (wr * 4 + wc) * 2304;
        PG8_LAS unsigned char* swr = sw + fr * 144 + fq * 16;
        const int lane = fq * 16 + fr; const PG8_LAS unsigned char* srd = sw + (lane >> 3) * 144 + (lane & 7) * 16;
        bf16_t* orow = O + (((size_t)u.pm * ldc + u.pn) << 16) + (wr * 4 + wc) * 4096 + (lane >> 3) * 64 + (lane & 7) * 8;
        const bool qk = QKN && u.pn < 8;
        f32x4 gq[2][2];
        if (qk) { const PG8_LAS float* gp = gn + (u.pn >= 4 ? 64 : 0) + 8 * fq;
#pragma unroll
            for (int bj = 0; bj < 2; ++bj)
#pragma unroll
                for (int n = 0; n < 2; ++n) gq[bj][n] = *(const PG8_LAS f32x4*)(gp + bj * 32 + n * 4); }
        u32x4 po0, po1;
#pragma unroll
        for (int pc = 0; pc < 8; ++pc) { const int ai = pc >> 2, m = pc & 3;
                float rs = 1.f;
                if (qk) { float ss = 0.f;
#pragma unroll
                    for (int bj = 0; bj < 2; ++bj)
#pragma unroll
                        for (int n = 0; n < 2; ++n) { const f32x4 v = acc[ai][bj][m][n]; ss += v[0] * v[0] + v[1] * v[1] + v[2] * v[2] + v[3] * v[3]; }
                    ss += __shfl_xor(ss, 16); ss += __shfl_xor(ss, 32);
                    rs = __builtin_amdgcn_rsqf(ss * (1.f / 64.f) + 1e-6f); }
#pragma unroll
                for (int bj = 0; bj < 2; ++bj) { f32x4 v0 = acc[ai][bj][m][0], v1 = acc[ai][bj][m][1];
                    if (qk) { v0 = v0 * gq[bj][0] * rs; v1 = v1 * gq[bj][1] * rs; }
                    u32x4 w; w.x = cvt_pk_bf16(v0[0], v0[1]); w.y = cvt_pk_bf16(v0[2], v0[3]); w.z = cvt_pk_bf16(v1[0], v1[1]); w.w = cvt_pk_bf16(v1[2], v1[3]);
                    *(PG8_LAS u32x4*)(swr + bj * 64) = w; }
                const u32x4 o0 = *(const PG8_LAS u32x4*)(srd), o1 = *(const PG8_LAS u32x4*)(srd + 8 * 144);
                if (pc > 0) { const int pa = (pc - 1) >> 2, pm_ = (pc - 1) & 3; st16_wt(orow + pa * 32768 + (pm_ * 16) * 64, po0); st16_wt(orow + pa * 32768 + (pm_ * 16 + 8) * 64, po1); }
                po0 = o0; po1 = o1;
        }
        st16_wt(orow + 32768 + (3 * 16) * 64, po0); st16_wt(orow + 32768 + (3 * 16 + 8) * 64, po1);
    }
};
struct EpiResid {
    static constexpr bool PERM = false, AFTER_DRAIN = false;
    const float* xin; float* out; int ldc;
    __device__ __forceinline__ void operator()(const f32x4 (&acc)[2][2][4][2], const Unit& u, int wr, int wc, int fr, int fq) const {
        const int row0 = u.pm * BM + wr * 64 + fr, col0 = u.pn * BM + wc * 32 + 4 * fq;
#pragma unroll
        for (int ai = 0; ai < 2; ++ai)
#pragma unroll
            for (int m = 0; m < 4; ++m) { const size_t ro = (size_t)(row0 + ai * HALF + m * 16) * ldc + col0;
#pragma unroll
                for (int bj = 0; bj < 2; ++bj)
#pragma unroll
                    for (int n = 0; n < 2; ++n) { const f32x4 r = *(const f32x4*)(xin + ro + bj * HALF + n * 16); *(f32x4*)(out + ro + bj * HALF + n * 16) = r + acc[ai][bj][m][n]; } }
    }
};
template <bool IN_BF16> struct EpiResidB {
    static constexpr bool PERM = true, AFTER_DRAIN = false;
    const void* xin; bf16_t* out; int ldc;
    __device__ __forceinline__ void operator()(const f32x4 (&acc)[2][2][4][2], const Unit& u, int wr, int wc, int fr, int fq) const {
        const int row0 = u.pm * BM + wr * 64 + fr, col0 = u.pn * BM + wc * 32 + 8 * fq;
#pragma unroll
        for (int ai = 0; ai < 2; ++ai)
#pragma unroll
            for (int m = 0; m < 4; ++m) { const size_t ro = (size_t)(row0 + ai * HALF + m * 16) * ldc + col0;
#pragma unroll
                for (int bj = 0; bj < 2; ++bj) { f32x4 r0, r1;
                    if (IN_BF16) { const u32x4 raw = *(const u32x4*)((const bf16_t*)xin + ro + bj * HALF);
                        r0 = (f32x4){__uint_as_float(raw.x << 16), __uint_as_float(raw.x & 0xffff0000u), __uint_as_float(raw.y << 16), __uint_as_float(raw.y & 0xffff0000u)};
                        r1 = (f32x4){__uint_as_float(raw.z << 16), __uint_as_float(raw.z & 0xffff0000u), __uint_as_float(raw.w << 16), __uint_as_float(raw.w & 0xffff0000u)}; }
                    else { r0 = *(const f32x4*)((const float*)xin + ro + bj * HALF); r1 = *(const f32x4*)((const float*)xin + ro + bj * HALF + 4); }
                    r0 = r0 + acc[ai][bj][m][0]; r1 = r1 + acc[ai][bj][m][1];
                    u32x4 w; w.x = cvt_pk_bf16(r0[0], r0[1]); w.y = cvt_pk_bf16(r0[2], r0[3]); w.z = cvt_pk_bf16(r1[0], r1[1]); w.w = cvt_pk_bf16(r1[2], r1[3]);
                    *(u32x4*)(out + ro + bj * HALF) = w; } }
    }
};
struct EpiSwiGLU {
    static constexpr bool PERM = true, AFTER_DRAIN = false;
    bf16_t* O; const float* wrow;
    __device__ __forceinline__ void operator()(const f32x4 (&acc)[2][2][4][2], const Unit& u, int wr, int wc, int fr, int fq) const {
        const int row0 = u.pm * BM + wr * 64 + fr; const int col0 = (u.pn & 1) * HALF + wc * 32 + 8 * fq;
#pragma unroll
        for (int ai = 0; ai < 2; ++ai)
#pragma unroll
            for (int m = 0; m < 4; ++m) { const int row = row0 + ai * HALF + m * 16; const float w = wrow[row];
                float o[8];
#pragma unroll
                for (int n = 0; n < 2; ++n)
#pragma unroll
                    for (int e = 0; e < 4; ++e) { const float g = acc[ai][0][m][n][e], up = acc[ai][1][m][n][e]; o[4 * n + e] = g * __builtin_amdgcn_rcpf(1.f + __expf(-g)) * up * w; }
                u32x4 pk; pk.x = cvt_pk_bf16(o[0], o[1]); pk.y = cvt_pk_bf16(o[2], o[3]); pk.z = cvt_pk_bf16(o[4], o[5]); pk.w = cvt_pk_bf16(o[6], o[7]);
                *(u32x4*)(O + (size_t)row * 256 + col0) = pk; }
    }
};
struct MoeOrder {
    const int* panel_expert; int nunits, G, c, shift;
    __device__ __forceinline__ bool next(int i, Unit& u) const {
        const long L = (long)i * G + c; if (L >= nunits) return false;
        const int p = (int)(L >> shift); const int e = panel_expert[p]; u.pm = p; u.pn = (e << shift) + (int)(L & ((1 << shift) - 1)); return true;
    }
    __device__ __forceinline__ void a_ready(const Unit&) const {}
    __device__ __forceinline__ void done(const Unit&) const {}
};
}

__device__ __forceinline__ void tr_item(const float* __restrict__ W, int ldw, int col0, int K, bf16_t* WT, int drow0, LAS float* scr, int kb, int nb, int lane) {
    const int k0 = 64 * kb, n0 = col0 + 32 * nb;
#pragma unroll
    for (int i = 0; i < 8; ++i) { const int idx = lane + 64 * i; const int kk = idx >> 3, n4 = (idx & 7) * 4;
        const f32x4 v = *(const f32x4*)(W + (size_t)(k0 + kk) * ldw + n0 + n4); LAS float* d = scr + kk * 33 + n4; d[0] = v[0]; d[1] = v[1]; d[2] = v[2]; d[3] = v[3]; }
    LDS_WAIT();
    const int c = lane & 7;
#pragma unroll
    for (int j = 0; j < 4; ++j) { const int n = (lane >> 3) + 8 * j; const LAS float* s = scr + (8 * c) * 33 + n;
        u32x4 o; o.x = pg8::cvt_pk_bf16(s[0 * 33], s[1 * 33]); o.y = pg8::cvt_pk_bf16(s[2 * 33], s[3 * 33]); o.z = pg8::cvt_pk_bf16(s[4 * 33], s[5 * 33]); o.w = pg8::cvt_pk_bf16(s[6 * 33], s[7 * 33]);
        *(u32x4*)(WT + (size_t)(drow0 + n) * K + k0 + 8 * c) = o; }
    LDS_WAIT();
}
__device__ __forceinline__ bool tr_seg(int& r, const float* W, int ldw, int col0, int ncols, int K, bf16_t* WT, int drow0, LAS float* scr, int lane, int qkblocks = 0) {
    const int nblk = ncols / 32, items = (K / 64) * nblk;
    if (r < items) { const int kb = r / nblk, nb = r % nblk;
        int nbd = nb; if (nb < qkblocks) { const int lb = nb & 7; nbd = (nb & ~7) + (lb & 1) * 4 + (lb >> 1); }
        tr_item(W, ldw, col0, K, WT, drow0 + 32 * nbd, scr, kb, nb, lane); return true; }
    r -= items; return false;
}
__device__ __forceinline__ void phase_convert(const Ctx& C, int layer) {
    LAS float* scr = (LAS float*)(C.lds + C.wave * 8448);
    const int gw = C.bid * 8 + C.wave, NGW = C.G * 8;
    bf16_t* Win = (bf16_t*)(C.ws + WS_WIN); bf16_t* Wout = (bf16_t*)(C.ws + WS_WOUT);
    const int IT_IN = (layer == 0) ? (16 * 96 + 16 * 128) : (16 * 256);
    const int IT_OUT = (layer == 0) ? (32 * 32) : (48 * 32);
    const int NITEMS = IT_IN + IT_OUT;
    for (int it = gw; it < NITEMS; it += NGW) {
        int r = it;
        if (layer == 0) {
            if (tr_seg(r, C.in[3], 7192, 0, 3072, 1024, Win, 0, scr, C.lane, 96)) continue;
            if (tr_seg(r, C.in[3], 7192, 3080, 4096, 1024, Win, 3072, scr, C.lane, 128)) continue;
            if (tr_seg(r, C.in[11], 1024, 0, 1024, 2048, Wout, 0, scr, C.lane)) continue;
        } else {
            if (tr_seg(r, C.in[12], 8224, 0, 8192, 1024, Win, 0, scr, C.lane, 256)) continue;
            if (tr_seg(r, C.in[22], 1024, 0, 1024, 3072, Wout, 0, scr, C.lane)) continue;
        }
    }
    if (layer == 0) { float* RW = (float*)(C.ws + WS_RW);
        for (size_t idx = (size_t)C.bid * 512 + C.tid; idx < 2 * 36 * 1024; idx += (size_t)C.G * 512) { const int l = (int)(idx / (36 * 1024)), rem = (int)(idx % (36 * 1024)), cc = rem >> 10, k = rem & 1023;
            RW[idx] = cc < 4 ? C.in[23][(size_t)l * 4096 + k * 4 + cc] : C.in[25][(size_t)l * 32768 + k * 32 + (cc - 4)]; } }
    if (layer == 0) {
        float* WSM0 = (float*)(C.ws + WS_WSM); float* WSM1 = (float*)(C.ws + WS_WSM1);
        const size_t gt = (size_t)C.bid * 512 + C.tid, GT = (size_t)C.G * 512;
        for (size_t idx = gt; idx < 2 * 32 * 1024; idx += GT) {
            const int l = (int)(idx >> 15), rr = (int)((idx >> 10) & 31), k = (int)(idx & 1023); float v = 0.f;
            if (l == 0) { const int sc = rr < 8 ? 3072 + rr : (rr < 24 ? 7176 + (rr - 8) : -1); if (sc >= 0) v = C.in[3][(size_t)k * 7192 + sc]; WSM0[idx & 32767] = v; }
            else { v = C.in[12][(size_t)k * 8224 + 8192 + rr]; WSM1[idx & 32767] = v; }
        }
    }
}
struct TrJob { const float* src; int ldw, K; bf16_t* dst; };
__device__ __forceinline__ TrJob moe_job(int it, const float* wg, const float* wu, const float* wd, bf16_t* W1, bf16_t* W2) {
    const int IT_MOE = 32 * 128; TrJob j; int r = it;
    if (r < 2 * IT_MOE) { const bool up = r >= IT_MOE; if (up) r -= IT_MOE; const int e = r >> 7, q = r & 127, kb = q >> 3, nb = q & 7;
        j.src = (up ? wu : wg) + (size_t)e * 1024 * 256 + (size_t)(64 * kb) * 256 + 32 * nb; j.ldw = 256; j.K = 1024;
        j.dst = W1 + (size_t)(e * 512 + (up ? 128 : 0) + (nb < 4 ? 32 * nb : 256 + 32 * (nb - 4))) * 1024 + 64 * kb; return j; }
    r -= 2 * IT_MOE; { const int e = r >> 7, q = r & 127, kb = q >> 5, nb = q & 31;
        j.src = wd + (size_t)e * 256 * 1024 + (size_t)(64 * kb) * 1024 + 32 * nb; j.ldw = 1024; j.K = 256; j.dst = W2 + (size_t)(e * 1024 + 32 * nb) * 256 + 64 * kb; return j; }
}
__device__ __forceinline__ void phase_convert_moe(const Ctx& C, int layer) {
    LAS float* scr = (LAS float*)(C.lds + C.wave * 8448);
    const int gw = C.bid * 8 + C.wave, NGW = C.G * 8; const int lane = C.lane;
    bf16_t* W1 = (bf16_t*)(C.ws + WS_W1); bf16_t* W2 = (bf16_t*)(C.ws + WS_W2);
    const float* wg = C.in[27] + (size_t)layer * 32 * 1024 * 256; const float* wu = C.in[28] + (size_t)layer * 32 * 1024 * 256; const float* wd = C.in[29] + (size_t)layer * 32 * 256 * 1024;
    const int NIT = 3 * 32 * 128;
    f32x4 nx[8];
#define TR_LOAD(job) do { _Pragma("unroll") for (int i = 0; i < 8; ++i) { const int idx = lane + 64 * i; nx[i] = *(const f32x4*)((job).src + (size_t)(idx >> 3) * (job).ldw + (idx & 7) * 4); } } while (0)
    if (gw < NIT) { const TrJob j0 = moe_job(gw, wg, wu, wd, W1, W2); TR_LOAD(j0); }
    for (int it = gw; it < NIT; it += NGW) {
        const TrJob cur = moe_job(it, wg, wu, wd, W1, W2);
#pragma unroll
        for (int i = 0; i < 8; ++i) { const int idx = lane + 64 * i; LAS float* d = scr + (idx >> 3) * 33 + (idx & 7) * 4; d[0] = nx[i][0]; d[1] = nx[i][1]; d[2] = nx[i][2]; d[3] = nx[i][3]; }
        if (it + NGW < NIT) { const TrJob nj = moe_job(it + NGW, wg, wu, wd, W1, W2); TR_LOAD(nj); }
        LDS_WAIT();
        const int c = lane & 7;
#pragma unroll
        for (int j = 0; j < 4; ++j) { const int n = (lane >> 3) + 8 * j; const LAS float* s = scr + (8 * c) * 33 + n;
            u32x4 o; o.x = pg8::cvt_pk_bf16(s[0 * 33], s[1 * 33]); o.y = pg8::cvt_pk_bf16(s[2 * 33], s[3 * 33]); o.z = pg8::cvt_pk_bf16(s[4 * 33], s[5 * 33]); o.w = pg8::cvt_pk_bf16(s[6 * 33], s[7 * 33]);
            *(u32x4*)(cur.dst + (size_t)n * cur.K + 8 * c) = o; }
        LDS_WAIT();
    }
#undef TR_LOAD
}

constexpr int SP_RS = 2064, SP_IMG = 16 * SP_RS;
struct SmallProjW { pg8::bf16x8 wh[4][2], wl[4][2]; };
__device__ __forceinline__ void smallproj_load(SmallProjW& W, const float* WSM, int wave, int lane) {
#pragma unroll
    for (int kb = 0; kb < 4; ++kb)
#pragma unroll
        for (int nt = 0; nt < 2; ++nt) { const int n = nt * 16 + (lane & 15), k = (4 * wave + kb) * 32 + 8 * (lane >> 4);
            const f32x4 a = *(const f32x4*)(WSM + (size_t)n * 1024 + k), b = *(const f32x4*)(WSM + (size_t)n * 1024 + k + 4);
            u32x4 h, l;
            h.x = pg8::cvt_pk_bf16(a[0], a[1]); h.y = pg8::cvt_pk_bf16(a[2], a[3]); h.z = pg8::cvt_pk_bf16(b[0], b[1]); h.w = pg8::cvt_pk_bf16(b[2], b[3]);
            l.x = pg8::cvt_pk_bf16(a[0] - __uint_as_float(h.x << 16), a[1] - __uint_as_float(h.x & 0xffff0000u)); l.y = pg8::cvt_pk_bf16(a[2] - __uint_as_float(h.y << 16), a[3] - __uint_as_float(h.y & 0xffff0000u));
            l.z = pg8::cvt_pk_bf16(b[0] - __uint_as_float(h.z << 16), b[1] - __uint_as_float(h.z & 0xffff0000u)); l.w = pg8::cvt_pk_bf16(b[2] - __uint_as_float(h.w << 16), b[3] - __uint_as_float(h.w & 0xffff0000u));
            W.wh[kb][nt] = __builtin_bit_cast(pg8::bf16x8, h); W.wl[kb][nt] = __builtin_bit_cast(pg8::bf16x8, l); }
}
__device__ __forceinline__ u32x2 smallproj_put(LAS unsigned char* img, int irow, int lane, int j, const f32x4 v) {
    u32x2 h, l; h.x = pg8::cvt_pk_bf16(v[0], v[1]); h.y = pg8::cvt_pk_bf16(v[2], v[3]);
    l.x = pg8::cvt_pk_bf16(v[0] - __uint_as_float(h.x << 16), v[1] - __uint_as_float(h.x & 0xffff0000u)); l.y = pg8::cvt_pk_bf16(v[2] - __uint_as_float(h.y << 16), v[3] - __uint_as_float(h.y & 0xffff0000u));
    const int ob = irow * SP_RS + (4 * lane + 256 * j) * 2;
    *(LAS u32x2*)(img + ob) = h; *(LAS u32x2*)(img + SP_IMG + ob) = l; return h;
}
__device__ __forceinline__ void smallproj_tile(const SmallProjW& W, LAS unsigned char* img, LAS float* part, float* smt, int wave, int lane, int tid) {
    f32x4 acc[2];
#pragma unroll
    for (int nt = 0; nt < 2; ++nt) acc[nt] = (f32x4){0.f, 0.f, 0.f, 0.f};
#pragma unroll
    for (int kb = 0; kb < 4; ++kb) { const int ob = (lane & 15) * SP_RS + ((4 * wave + kb) * 32 + 8 * (lane >> 4)) * 2;
        const pg8::bf16x8 ah = *(const LAS pg8::bf16x8*)(img + ob), al = *(const LAS pg8::bf16x8*)(img + SP_IMG + ob);
#pragma unroll
        for (int nt = 0; nt < 2; ++nt) { acc[nt] = __builtin_amdgcn_mfma_f32_16x16x32_bf16(ah, W.wh[kb][nt], acc[nt], 0, 0, 0);
            acc[nt] = __builtin_amdgcn_mfma_f32_16x16x32_bf16(al, W.wh[kb][nt], acc[nt], 0, 0, 0); acc[nt] = __builtin_amdgcn_mfma_f32_16x16x32_bf16(ah, W.wl[kb][nt], acc[nt], 0, 0, 0); } }
#pragma unroll
    for (int nt = 0; nt < 2; ++nt)
#pragma unroll
        for (int j = 0; j < 4; ++j) part[(wave * 2 + nt) * 256 + j * 64 + lane] = acc[nt][j];
    __syncthreads();
    { float s = 0.f;
#pragma unroll
      for (int w = 0; w < 8; ++w) s += part[w * 512 + tid];
      const int nt = tid >> 8, j = (tid >> 6) & 3, l = tid & 63; smt[(4 * (l >> 4) + j) * 32 + nt * 16 + (l & 15)] = s; }
}
__device__ __forceinline__ void phase_norm(const Ctx& C, const float* WSM, const float* x, const float* gain, bf16_t* out, float* sm, int nrows, int vb, int nb) {
    LAS unsigned char* img = C.lds; LAS float* part = (LAS float*)(C.lds + 2 * SP_IMG);
    __syncthreads();
    SmallProjW W; smallproj_load(W, WSM, C.wave, C.lane);
    const int lane = C.lane, w2 = 2 * C.wave;
    f32x4 g[4];
#pragma unroll
    for (int j = 0; j < 4; ++j) g[j] = *(const f32x4*)(gain + 4 * lane + 256 * j);
    f32x4 nx[2][4];
    if (vb < nrows / 16) {
#pragma unroll
        for (int i = 0; i < 2; ++i)
#pragma unroll
            for (int j = 0; j < 4; ++j) nx[i][j] = *(const f32x4*)(x + (size_t)(vb * 16 + w2 + i) * D + 4 * lane + 256 * j); }
    for (int tile = vb; tile < nrows / 16; tile += nb) {
        f32x4 cx[2][4];
#pragma unroll
        for (int i = 0; i < 2; ++i)
#pragma unroll
            for (int j = 0; j < 4; ++j) cx[i][j] = nx[i][j];
        if (tile + nb < nrows / 16) {
#pragma unroll
            for (int i = 0; i < 2; ++i)
#pragma unroll
                for (int j = 0; j < 4; ++j) nx[i][j] = *(const f32x4*)(x + (size_t)((tile + nb) * 16 + w2 + i) * D + 4 * lane + 256 * j); }
#pragma unroll
        for (int i = 0; i < 2; ++i) { const size_t r = (size_t)tile * 16 + w2 + i; float ss = 0.f;
#pragma unroll
            for (int j = 0; j < 4; ++j) ss += cx[i][j][0] * cx[i][j][0] + cx[i][j][1] * cx[i][j][1] + cx[i][j][2] * cx[i][j][2] + cx[i][j][3] * cx[i][j][3];
            const float rs = rsqrtf(wave_sum(ss) * (1.f / D) + EPS);
#pragma unroll
            for (int j = 0; j < 4; ++j) { const u32x2 h = smallproj_put(img, w2 + i, lane, j, cx[i][j] * rs * g[j]); st8_wt(out + r * D + 4 * lane + 256 * j, h); } }
        __syncthreads();
        smallproj_tile(W, img, part, sm + (size_t)tile * 16 * 32, C.wave, lane, C.tid);
        __syncthreads();
    }
}

__device__ __forceinline__ float fsig_(float x) { return frcp_(1.f + __expf(-x)); }
__device__ __forceinline__ void phase_gate0(const Ctx& C, const bf16_t* P, bf16_t* AO) {
    const int gw = C.bid * 8 + C.wave, NGW = C.G * 8; const int lane = C.lane;
    f32x4 mn[4]; const f32x4 gn = *(const f32x4*)(C.in[10] + ((4 * lane) & 127));
#pragma unroll
    for (int j = 0; j < 4; ++j) mn[j] = *(const f32x4*)(C.in[6] + 4 * lane + 256 * j);
    u32x2 nr[8], nz[8];
#define G0_LOAD(row) do { const bf16_t* ar_ = AO + (size_t)(row) * KO0 + 4 * lane; const bf16_t* pm_ = P + pj0((size_t)(row), C_MO + 4 * lane); const bf16_t* pg_ = P + pj0((size_t)(row), C_GZ + 4 * lane); \
        _Pragma("unroll") for (int j = 0; j < 4; ++j) { nr[j] = *(const u32x2*)(ar_ + 256 * j); nz[j] = *(const u32x2*)(pm_ + 65536 * j); nr[4 + j] = *(const u32x2*)(ar_ + 1024 + 256 * j); nz[4 + j] = *(const u32x2*)(pg_ + 65536 * j); } } while (0)
    if (gw < GTOK) G0_LOAD(gw);
    for (int r = gw; r < GTOK; r += NGW) {
        u32x2 cr[8], cz[8];
#pragma unroll
        for (int j = 0; j < 8; ++j) { cr[j] = nr[j]; cz[j] = nz[j]; }
        if (r + NGW < GTOK) G0_LOAD(r + NGW);
        bf16_t* ar = AO + (size_t)r * KO0 + 4 * lane;
#pragma unroll
        for (int j = 0; j < 8; ++j) {
            const float v[4] = {__uint_as_float(cr[j].x << 16), __uint_as_float(cr[j].x & 0xffff0000u), __uint_as_float(cr[j].y << 16), __uint_as_float(cr[j].y & 0xffff0000u)};
            const float z[4] = {__uint_as_float(cz[j].x << 16), __uint_as_float(cz[j].x & 0xffff0000u), __uint_as_float(cz[j].y << 16), __uint_as_float(cz[j].y & 0xffff0000u)};
            const float sq = v[0] * v[0] + v[1] * v[1] + v[2] * v[2] + v[3] * v[3];
            float o[4];
            if (j < 4) { const float rstd = rsqrtf(wave_sum(sq) * (1.f / 256.f) + EPS);
#pragma unroll
                for (int e = 0; e < 4; ++e) o[e] = v[e] * rstd * mn[j][e] * fsig_(z[e]); }
            else { const float rstd = rsqrtf(half_sum(sq, C.lane) * (1.f / 128.f) + EPS);
#pragma unroll
                for (int e = 0; e < 4; ++e) o[e] = v[e] * rstd * gn[e] * z[e] * fsig_(z[e]); }
            u32x2 w; w.x = pg8::cvt_pk_bf16(o[0], o[1]); w.y = pg8::cvt_pk_bf16(o[2], o[3]); st8_wt(ar + 256 * j, w); }
    }
#undef G0_LOAD
}
__device__ __forceinline__ void phase_gate1(const Ctx& C, const bf16_t* P, bf16_t* AO) {
    const int gw = C.bid * 8 + C.wave, NGW = C.G * 8; const int lane = C.lane;
    f32x4 sn[8];
#pragma unroll
    for (int j = 0; j < 8; ++j) sn[j] = *(const f32x4*)(C.in[21] + 4 * lane + 256 * j);
    u32x2 nr[8], nz[8];
#define G1_LOAD(row) do { const bf16_t* ar_ = AO + (size_t)(row) * KO1 + 1024 + 4 * lane; const bf16_t* pr_ = P + pj1((size_t)(row), C_Z + 4 * lane); \
        _Pragma("unroll") for (int j = 0; j < 8; ++j) { nr[j] = *(const u32x2*)(ar_ + 256 * j); nz[j] = *(const u32x2*)(pr_ + 65536 * j); } } while (0)
    if (gw < GTOK) G1_LOAD(gw);
    for (int r = gw; r < GTOK; r += NGW) {
        u32x2 cr[8], cz[8];
#pragma unroll
        for (int j = 0; j < 8; ++j) { cr[j] = nr[j]; cz[j] = nz[j]; }
        if (r + NGW < GTOK) G1_LOAD(r + NGW);
        bf16_t* ar = AO + (size_t)r * KO1 + 1024 + 4 * lane;
#pragma unroll
        for (int gq = 0; gq < 4; ++gq) { float y[8]; float ss = 0.f;
#pragma unroll
            for (int jj = 0; jj < 2; ++jj) { const int j = 2 * gq + jj;
                const float v[4] = {__uint_as_float(cr[j].x << 16), __uint_as_float(cr[j].x & 0xffff0000u), __uint_as_float(cr[j].y << 16), __uint_as_float(cr[j].y & 0xffff0000u)};
                const float z[4] = {__uint_as_float(cz[j].x << 16), __uint_as_float(cz[j].x & 0xffff0000u), __uint_as_float(cz[j].y << 16), __uint_as_float(cz[j].y & 0xffff0000u)};
#pragma unroll
                for (int e = 0; e < 4; ++e) { y[4 * jj + e] = v[e] * z[e] * fsig_(z[e]); ss += y[4 * jj + e] * y[4 * jj + e]; } }
            const float rstd = rsqrtf(wave_sum(ss) * (1.f / 512.f) + EPS);
#pragma unroll
            for (int jj = 0; jj < 2; ++jj) { const int j = 2 * gq + jj; u32x2 w;
                w.x = pg8::cvt_pk_bf16(y[4 * jj] * rstd * sn[j][0], y[4 * jj + 1] * rstd * sn[j][1]); w.y = pg8::cvt_pk_bf16(y[4 * jj + 2] * rstd * sn[j][2], y[4 * jj + 3] * rstd * sn[j][3]); st8_wt(ar + 256 * j, w); } }
    }
#undef G1_LOAD
}
__device__ __forceinline__ void phase_r1(const Ctx& C, int layer) {
    constexpr int RS = 2064, IMG = 16 * RS, NTILE = NTOK / 16;
    typedef pg8::bf16x8 bf16x8;
    LAS unsigned char* imgH = C.lds; LAS unsigned char* imgL = C.lds + IMG;
    LAS float* part = (LAS float*)(C.lds + 2 * IMG); LAS float* lg = part + 8 * 768; LAS int* hist = (LAS int*)(lg + 16 * 48);
    const float* bg = C.in[24] + layer * 4; const float* be = C.in[26] + layer * 32; const float* gain = C.in[2] + layer * D;
    __syncthreads();
    if (C.tid < 32) hist[C.tid] = 0;
    bf16x8 wh[4][3], wl[4][3];
    { const float* RW = (const float*)(C.ws + WS_RW) + (size_t)layer * 36 * 1024;
#pragma unroll
        for (int kb = 0; kb < 4; ++kb)
#pragma unroll
            for (int nt = 0; nt < 3; ++nt) { const int n = nt * 16 + (C.lane & 15), k = (4 * C.wave + kb) * 32 + 8 * (C.lane >> 4);
                f32x4 a = {0.f, 0.f, 0.f, 0.f}, b = a; if (n < 36) { a = *(const f32x4*)(RW + (size_t)n * 1024 + k); b = *(const f32x4*)(RW + (size_t)n * 1024 + k + 4); }
                u32x4 h, l;
                h.x = pg8::cvt_pk_bf16(a[0], a[1]); h.y = pg8::cvt_pk_bf16(a[2], a[3]); h.z = pg8::cvt_pk_bf16(b[0], b[1]); h.w = pg8::cvt_pk_bf16(b[2], b[3]);
                l.x = pg8::cvt_pk_bf16(a[0] - __uint_as_float(h.x << 16), a[1] - __uint_as_float(h.x & 0xffff0000u)); l.y = pg8::cvt_pk_bf16(a[2] - __uint_as_float(h.y << 16), a[3] - __uint_as_float(h.y & 0xffff0000u));
                l.z = pg8::cvt_pk_bf16(b[0] - __uint_as_float(h.z << 16), b[1] - __uint_as_float(h.z & 0xffff0000u)); l.w = pg8::cvt_pk_bf16(b[2] - __uint_as_float(h.w << 16), b[3] - __uint_as_float(h.w & 0xffff0000u));
                wh[kb][nt] = __builtin_bit_cast(bf16x8, h); wl[kb][nt] = __builtin_bit_cast(bf16x8, l); } }
    int* route_e = (int*)(C.ws + WS_ROUTE_E); float* route_w = (float*)(C.ws + WS_ROUTE_W); bf16_t* HN2 = (bf16_t*)(C.ws + WS_H2P);
    { int* ROWTOK = (int*)(C.ws + WS_ROWTOK); for (int idx = C.bid * 512 + C.tid; idx < MOE_MAXROWS; idx += C.G * 512) ROWTOK[idx] = 0; }
    f32x4 g[4];
#pragma unroll
    for (int j = 0; j < 4; ++j) g[j] = *(const f32x4*)(gain + 4 * C.lane + 256 * j);
    const bf16_t* XB = (const bf16_t*)C.out; bf16_t* XB3 = (bf16_t*)(C.ws + WS_XB3);
    const int w2 = 2 * C.wave;
    u32x2 nx[2][4];
    if (C.bid < NTILE) {
#pragma unroll
        for (int i = 0; i < 2; ++i)
#pragma unroll
            for (int j = 0; j < 4; ++j) nx[i][j] = *(const u32x2*)(XB + (size_t)(C.bid * 16 + w2 + i) * D + 4 * C.lane + 256 * j); }
    for (int tile = C.bid; tile < NTILE; tile += C.G) {
        const int r0 = tile * 16 + w2;
        u32x2 cx[2][4];
#pragma unroll
        for (int i = 0; i < 2; ++i)
#pragma unroll
            for (int j = 0; j < 4; ++j) cx[i][j] = nx[i][j];
        if (tile + C.G < NTILE) {
#pragma unroll
            for (int i = 0; i < 2; ++i)
#pragma unroll
                for (int j = 0; j < 4; ++j) nx[i][j] = *(const u32x2*)(XB + (size_t)((tile + C.G) * 16 + w2 + i) * D + 4 * C.lane + 256 * j); }
#pragma unroll
        for (int i = 0; i < 2; ++i) { const int r = r0 + i;
            f32x4 v[4]; float ss = 0.f;
#pragma unroll
            for (int j = 0; j < 4; ++j) { v[j] = (f32x4){__uint_as_float(cx[i][j].x << 16), __uint_as_float(cx[i][j].x & 0xffff0000u), __uint_as_float(cx[i][j].y << 16), __uint_as_float(cx[i][j].y & 0xffff0000u)};
                if (layer == 1) st8_wt(XB3 + (size_t)r * D + 4 * C.lane + 256 * j, cx[i][j]);
                ss += v[j][0] * v[j][0] + v[j][1] * v[j][1] + v[j][2] * v[j][2] + v[j][3] * v[j][3]; }
            const float rstd = rsqrtf(wave_sum(ss) * (1.f / D) + EPS);
#pragma unroll
            for (int j = 0; j < 4; ++j) { v[j] = v[j] * rstd * g[j];
                u32x2 h, l; h.x = pg8::cvt_pk_bf16(v[j][0], v[j][1]); h.y = pg8::cvt_pk_bf16(v[j][2], v[j][3]);
                st8_wt(HN2 + (size_t)r * D + 4 * C.lane + 256 * j, h);
                l.x = pg8::cvt_pk_bf16(v[j][0] - __uint_as_float(h.x << 16), v[j][1] - __uint_as_float(h.x & 0xffff0000u)); l.y = pg8::cvt_pk_bf16(v[j][2] - __uint_as_float(h.y << 16), v[j][3] - __uint_as_float(h.y & 0xffff0000u));
                const int ob = (w2 + i) * RS + (4 * C.lane + 256 * j) * 2;
                *(LAS u32x2*)(imgH + ob) = h; *(LAS u32x2*)(imgL + ob) = l; } }
        __syncthreads();
        f32x4 acc[3];
#pragma unroll
        for (int nt = 0; nt < 3; ++nt) acc[nt] = (f32x4){0.f, 0.f, 0.f, 0.f};
#pragma unroll
        for (int kb = 0; kb < 4; ++kb) { const int ob = (C.lane & 15) * RS + ((4 * C.wave + kb) * 32 + 8 * (C.lane >> 4)) * 2;
            const bf16x8 ah = *(const LAS bf16x8*)(imgH + ob), al = *(const LAS bf16x8*)(imgL + ob);
#pragma unroll
            for (int nt = 0; nt < 3; ++nt) { acc[nt] = __builtin_amdgcn_mfma_f32_16x16x32_bf16(ah, wh[kb][nt], acc[nt], 0, 0, 0);
                acc[nt] = __builtin_amdgcn_mfma_f32_16x16x32_bf16(al, wh[kb][nt], acc[nt], 0, 0, 0); acc[nt] = __builtin_amdgcn_mfma_f32_16x16x32_bf16(ah, wl[kb][nt], acc[nt], 0, 0, 0); } }
#pragma unroll
        for (int nt = 0; nt < 3; ++nt)
#pragma unroll
            for (int j = 0; j < 4; ++j) part[(C.wave * 3 + nt) * 256 + j * 64 + C.lane] = acc[nt][j];
        __syncthreads();
        for (int idx = C.tid; idx < 768; idx += 512) { float s = 0.f;
#pragma unroll
            for (int w = 0; w < 8; ++w) s += part[w * 768 + idx];
            const int nt = idx >> 8, j = (idx >> 6) & 3, l = idx & 63; lg[(4 * (l >> 4) + j) * 48 + nt * 16 + (l & 15)] = s; }
        __syncthreads();
        if (C.lane < 2) { const int r = r0 + C.lane; const LAS float* L = lg + (w2 + C.lane) * 48;
            float gl[4];
#pragma unroll
            for (int cc = 0; cc < 4; ++cc) gl[cc] = L[cc] + bg[cc];
            int gi = 0; float gm = gl[0];
#pragma unroll
            for (int cc = 1; cc < 4; ++cc) if (gl[cc] > gm) { gm = gl[cc]; gi = cc; }
            float gsum = 0.f;
#pragma unroll
            for (int cc = 0; cc < 4; ++cc) gsum += expf(gl[cc] - gm);
            const float gwt = 1.f / gsum;
            float el[8];
#pragma unroll
            for (int i = 0; i < 8; ++i) el[i] = L[4 + gi * 8 + i] + be[gi * 8 + i];
            int i0 = 0; float v0 = el[0];
#pragma unroll
            for (int i = 1; i < 8; ++i) if (el[i] > v0) { v0 = el[i]; i0 = i; }
            int i1 = -1; float v1 = -3.0e38f;
#pragma unroll
            for (int i = 0; i < 8; ++i) if (i != i0 && el[i] > v1) { v1 = el[i]; i1 = i; }
            if (i1 < 0) i1 = (i0 + 1) & 7;
            const float e1 = expf(v1 - v0), w0 = 1.f / (1.f + e1), w1 = e1 / (1.f + e1);
            const int ea = gi * 8 + i0, eb = gi * 8 + i1; route_e[2 * r] = ea; route_e[2 * r + 1] = eb; route_w[2 * r] = gwt * w0; route_w[2 * r + 1] = gwt * w1;
            lds_inc(&hist[ea]); lds_inc(&hist[eb]); }
    }
    __syncthreads();
    if (C.tid < 32 && hist[C.tid]) atomicAdd((int*)(C.ws + WS_CNT) + layer * 32 + C.tid, hist[C.tid]);
}
__device__ __forceinline__ void phase_r2(const Ctx& C, int layer) {
    LAS int* seg = (LAS int*)C.lds; LAS int* hist = seg + 40; LAS int* basee = hist + 32;
    const int* counts = (const int*)(C.ws + WS_CNT) + layer * 32; int* cursor = (int*)(C.ws + WS_CNT) + 64 + layer * 32; int* npan = (int*)(C.ws + WS_CNT) + 128 + layer;
    int* panel_expert = (int*)(C.ws + WS_PANEL) + layer * 320;
    const int* route_e = (const int*)(C.ws + WS_ROUTE_E); const float* route_w = (const float*)(C.ws + WS_ROUTE_W); int* POS = (int*)(C.ws + WS_POS); float* WROW = (float*)(C.ws + WS_WROW); int* ROWTOK = (int*)(C.ws + WS_ROWTOK);
    __syncthreads();
    if (C.tid == 0) { int run = 0; for (int e = 0; e < 32; ++e) { seg[e] = run; const int np = (counts[e] + 255) >> 8;
            if (C.bid == 0) for (int p = 0; p < np; ++p) panel_expert[(run >> 8) + p] = e;
            run += np << 8; }
        seg[32] = run; if (C.bid == 0) *npan = run >> 8; }
    for (int base = C.bid * 256; base < NTOK; base += C.G * 256) {
        __syncthreads();
        if (C.tid < 32) hist[C.tid] = 0;
        __syncthreads();
        const int e = route_e[2 * base + C.tid]; const int rank = lds_inc(&hist[e]);
        __syncthreads();
        if (C.tid < 32) basee[C.tid] = hist[C.tid] ? atomicAdd(&cursor[C.tid], hist[C.tid]) : 0;
        __syncthreads();
        const int pos = seg[e] + basee[e] + rank; POS[2 * base + C.tid] = pos; WROW[pos] = route_w[2 * base + C.tid]; ROWTOK[pos] = base + (C.tid >> 1);
    }
}
__device__ __forceinline__ void phase_combine(const Ctx& C) {
    const int* POS = (const int*)(C.ws + WS_POS); const bf16_t* YP = (const bf16_t*)(C.ws + WS_YP); const bf16_t* XB3 = (const bf16_t*)(C.ws + WS_XB3);
    const int gw = C.bid * 8 + C.wave, NGW = C.G * 8; const int lane = C.lane;
    for (int r = gw; r < NTOK; r += 2 * NGW) {
        const int r2 = r + NGW; const bool has2 = r2 < NTOK; const int rb = has2 ? r2 : r;
        const int pa0 = POS[2 * r], pa1 = POS[2 * r + 1], pb0 = POS[2 * rb], pb1 = POS[2 * rb + 1];
        float* xa = C.out + (size_t)r * D + 4 * lane; float* xb = C.out + (size_t)rb * D + 4 * lane;
        u32x2 va[4], vb[4], a0[4], a1[4], b0[4], b1[4];
#pragma unroll
        for (int j = 0; j < 4; ++j) { va[j] = *(const u32x2*)(XB3 + (size_t)r * D + 4 * lane + 256 * j); a0[j] = *(const u32x2*)(YP + (size_t)pa0 * D + 4 * lane + 256 * j); a1[j] = *(const u32x2*)(YP + (size_t)pa1 * D + 4 * lane + 256 * j);
            vb[j] = *(const u32x2*)(XB3 + (size_t)rb * D + 4 * lane + 256 * j); b0[j] = *(const u32x2*)(YP + (size_t)pb0 * D + 4 * lane + 256 * j); b1[j] = *(const u32x2*)(YP + (size_t)pb1 * D + 4 * lane + 256 * j); }
#pragma unroll
        for (int j = 0; j < 4; ++j) { f32x4 v;
            v[0] = __uint_as_float(va[j].x << 16) + __uint_as_float(a0[j].x << 16) + __uint_as_float(a1[j].x << 16); v[1] = __uint_as_float(va[j].x & 0xffff0000u) + __uint_as_float(a0[j].x & 0xffff0000u) + __uint_as_float(a1[j].x & 0xffff0000u);
            v[2] = __uint_as_float(va[j].y << 16) + __uint_as_float(a0[j].y << 16) + __uint_as_float(a1[j].y << 16); v[3] = __uint_as_float(va[j].y & 0xffff0000u) + __uint_as_float(a0[j].y & 0xffff0000u) + __uint_as_float(a1[j].y & 0xffff0000u);
            *(f32x4*)(xa + 256 * j) = v; }
        if (has2) {
#pragma unroll
            for (int j = 0; j < 4; ++j) { f32x4 v;
                v[0] = __uint_as_float(vb[j].x << 16) + __uint_as_float(b0[j].x << 16) + __uint_as_float(b1[j].x << 16); v[1] = __uint_as_float(vb[j].x & 0xffff0000u) + __uint_as_float(b0[j].x & 0xffff0000u) + __uint_as_float(b1[j].x & 0xffff0000u);
                v[2] = __uint_as_float(vb[j].y << 16) + __uint_as_float(b0[j].y << 16) + __uint_as_float(b1[j].y << 16); v[3] = __uint_as_float(vb[j].y & 0xffff0000u) + __uint_as_float(b0[j].y & 0xffff0000u) + __uint_as_float(b1[j].y & 0xffff0000u);
                *(f32x4*)(xb + 256 * j) = v; } }
    }
}

__device__ __forceinline__ void phase_combine_norm(const Ctx& C, const float* WSM, const float* gain, bf16_t* hn0, float* sm0, bf16_t* hn1, float* sm1) {
    LAS unsigned char* img = C.lds; LAS float* part = (LAS float*)(C.lds + 2 * SP_IMG);
    __syncthreads();
    SmallProjW W; smallproj_load(W, WSM, C.wave, C.lane);
    const int* POS = (const int*)(C.ws + WS_POS); const bf16_t* YP = (const bf16_t*)(C.ws + WS_YP);
    const int lane = C.lane, w2 = 2 * C.wave;
    f32x4 g[4];
#pragma unroll
    for (int j = 0; j < 4; ++j) g[j] = *(const f32x4*)(gain + 4 * lane + 256 * j);
    int np[4];
    if (C.bid < NTOK / 16) {
#pragma unroll
        for (int i = 0; i < 4; ++i) np[i] = POS[2 * (C.bid * 16 + w2) + i]; }
    for (int tile = C.bid; tile < NTOK / 16; tile += C.G) {
        int cp[4];
#pragma unroll
        for (int i = 0; i < 4; ++i) cp[i] = np[i];
        if (tile + C.G < NTOK / 16) {
#pragma unroll
            for (int i = 0; i < 4; ++i) np[i] = POS[2 * ((tile + C.G) * 16 + w2) + i]; }
        u32x2 xr[2][4], y0[2][4], y1[2][4];
#pragma unroll
        for (int i = 0; i < 2; ++i) { const size_t r = (size_t)tile * 16 + w2 + i;
#pragma unroll
            for (int j = 0; j < 4; ++j) { xr[i][j] = *(const u32x2*)((const bf16_t*)C.out + r * D + 4 * lane + 256 * j);
                y0[i][j] = *(const u32x2*)(YP + (size_t)cp[2 * i] * D + 4 * lane + 256 * j); y1[i][j] = *(const u32x2*)(YP + (size_t)cp[2 * i + 1] * D + 4 * lane + 256 * j); } }
#pragma unroll
        for (int i = 0; i < 2; ++i) { const size_t r = (size_t)tile * 16 + w2 + i; bf16_t* xo = (bf16_t*)C.out + r * D + 4 * lane;
            f32x4 v[4]; float ss = 0.f;
#pragma unroll
            for (int j = 0; j < 4; ++j) {
                v[j][0] = __uint_as_float(xr[i][j].x << 16) + (__uint_as_float(y0[i][j].x << 16) + __uint_as_float(y1[i][j].x << 16));
                v[j][1] = __uint_as_float(xr[i][j].x & 0xffff0000u) + (__uint_as_float(y0[i][j].x & 0xffff0000u) + __uint_as_float(y1[i][j].x & 0xffff0000u));
                v[j][2] = __uint_as_float(xr[i][j].y << 16) + (__uint_as_float(y0[i][j].y << 16) + __uint_as_float(y1[i][j].y << 16));
                v[j][3] = __uint_as_float(xr[i][j].y & 0xffff0000u) + (__uint_as_float(y0[i][j].y & 0xffff0000u) + __uint_as_float(y1[i][j].y & 0xffff0000u));
                u32x2 w_; w_.x = pg8::cvt_pk_bf16(v[j][0], v[j][1]); w_.y = pg8::cvt_pk_bf16(v[j][2], v[j][3]); st8_wt(xo + 256 * j, w_);
                ss += v[j][0] * v[j][0] + v[j][1] * v[j][1] + v[j][2] * v[j][2] + v[j][3] * v[j][3]; }
            const float rs = rsqrtf(wave_sum(ss) * (1.f / D) + EPS);
            bf16_t* ho = (r < (size_t)GTOK) ? hn0 + r * D : hn1 + (r - GTOK) * D;
#pragma unroll
            for (int j = 0; j < 4; ++j) { const u32x2 h = smallproj_put(img, w2 + i, lane, j, v[j] * rs * g[j]); st8_wt(ho + 4 * lane + 256 * j, h); } }
        __syncthreads();
        { const size_t r0 = (size_t)tile * 16; smallproj_tile(W, img, part, (r0 < (size_t)GTOK) ? sm0 + r0 * 32 : sm1 + (r0 - GTOK) * 32, C.wave, lane, C.tid); }
        __syncthreads();
    }
}
typedef pg8::bf16x8 bf16x8;
typedef short bf16x4 __attribute__((ext_vector_type(4)));
#define MFMA16(a, b, c) __builtin_amdgcn_mfma_f32_16x16x32_bf16(a, b, c, 0, 0, 0)
__device__ __forceinline__ bf16x8 ld_frag(const LAS bf16_t* base, int stride, int row, int kofs) { return *(const LAS bf16x8*)(base + row * stride + kofs); }
__device__ __forceinline__ bf16x8 ld_frag_perm(const LAS bf16_t* base, int stride, int row, int k0, int q) {
    const bf16x4 lo = *(const LAS bf16x4*)(base + row * stride + k0 + 4 * q), hi = *(const LAS bf16x4*)(base + row * stride + k0 + 16 + 4 * q);
    return __builtin_shufflevector(lo, hi, 0, 1, 2, 3, 4, 5, 6, 7);
}
__device__ __forceinline__ bf16x8 pack_frag(const f32x4 lo, const f32x4 hi) {
    u32x4 w; w.x = pg8::cvt_pk_bf16(lo[0], lo[1]); w.y = pg8::cvt_pk_bf16(lo[2], lo[3]); w.z = pg8::cvt_pk_bf16(hi[0], hi[1]); w.w = pg8::cvt_pk_bf16(hi[2], hi[3]);
    return __builtin_bit_cast(bf16x8, w);
}
__device__ __forceinline__ u32x2 pack4(const f32x4 v) { u32x2 w; w.x = pg8::cvt_pk_bf16(v[0], v[1]); w.y = pg8::cvt_pk_bf16(v[2], v[3]); return w; }
__device__ __forceinline__ float wave_incl_sum(float v, int lane) {
#pragma unroll
    for (int o = 1; o < 64; o <<= 1) { const float u = __shfl_up(v, o); if (lane >= o) v += u; }
    return v;
}
__device__ __forceinline__ float wave_incl_max(float v, int lane) {
#pragma unroll
    for (int o = 1; o < 64; o <<= 1) { const float u = __shfl_up(v, o); if (lane >= o) v = fmaxf(v, u); }
    return v;
}
__device__ __forceinline__ float wave_max(float v) {
#pragma unroll
    for (int o = 1; o < 64; o <<= 1) v = fmaxf(v, __shfl_xor(v, o));
    return v;
}
__device__ __forceinline__ bf16x8 ld_frag_tr(const LAS bf16_t* base, int stride, int c0, int k_lo, int k_hi, int r) {
    const LAS bf16_t* p = base + (r >> 2) * stride + c0 + 4 * (r & 3);
    const bf16x4 lo = __builtin_amdgcn_ds_read_tr16_b64_v4i16((LAS bf16x4*)(p + k_lo * stride)), hi = __builtin_amdgcn_ds_read_tr16_b64_v4i16((LAS bf16x4*)(p + k_hi * stride));
    return __builtin_shufflevector(lo, hi, 0, 1, 2, 3, 4, 5, 6, 7);
}
#define LDS_BARRIER() do { asm volatile("s_waitcnt lgkmcnt(0)" ::: "memory"); __builtin_amdgcn_s_barrier(); asm volatile("" ::: "memory"); } while (0)
__device__ __forceinline__ void phase_ssdconv(const Ctx& C, const bf16_t* P, bf16_t* XC) {
    const int gw = C.bid * 8 + C.wave, NGW = C.G * 8; const int lane = C.lane;
    const float* cw = C.in[16]; const float* cb = C.in[17];
    for (int u = gw; u < GBATCH * NCHUNK * 6 * 4; u += NGW) {
        const int slab = u % 6, qq = (u / 6) & 3, cc = (u / 24) & 31, bl = u / (24 * 32); const int ch = slab * 512 + lane * 8;
        float w[4][8], bb[8];
#pragma unroll
        for (int j = 0; j < 4; ++j) { const f32x4 a = *(const f32x4*)(cw + j * 3072 + ch), b = *(const f32x4*)(cw + j * 3072 + ch + 4);
            w[j][0] = a[0]; w[j][1] = a[1]; w[j][2] = a[2]; w[j][3] = a[3]; w[j][4] = b[0]; w[j][5] = b[1]; w[j][6] = b[2]; w[j][7] = b[3]; }
        { const f32x4 a = *(const f32x4*)(cb + ch), b = *(const f32x4*)(cb + ch + 4); bb[0] = a[0]; bb[1] = a[1]; bb[2] = a[2]; bb[3] = a[3]; bb[4] = b[0]; bb[5] = b[1]; bb[6] = b[2]; bb[7] = b[3]; }
        const size_t r0 = (size_t)bl * SEQ + (size_t)cc * 64 + (size_t)qq * 16;
        u32x4 h0 = (u32x4){0u, 0u, 0u, 0u}, h1 = h0, h2 = h0;
        if (cc > 0 || qq > 0) { h0 = *(const u32x4*)(P + pj1(r0 - 3, C_XBC + ch)); h1 = *(const u32x4*)(P + pj1(r0 - 2, C_XBC + ch)); h2 = *(const u32x4*)(P + pj1(r0 - 1, C_XBC + ch)); }
#pragma unroll
        for (int t = 0; t < 16; ++t) { const u32x4 h3 = *(const u32x4*)(P + pj1(r0 + t, C_XBC + ch));
            const unsigned x0[4] = {h0.x, h0.y, h0.z, h0.w}, x1[4] = {h1.x, h1.y, h1.z, h1.w}, x2[4] = {h2.x, h2.y, h2.z, h2.w}, x3[4] = {h3.x, h3.y, h3.z, h3.w};
            float o[8];
#pragma unroll
            for (int i = 0; i < 4; ++i) {
                float a0 = bb[2 * i] + w[0][2 * i] * __uint_as_float(x0[i] << 16) + w[1][2 * i] * __uint_as_float(x1[i] << 16) + w[2][2 * i] * __uint_as_float(x2[i] << 16) + w[3][2 * i] * __uint_as_float(x3[i] << 16);
                float a1 = bb[2 * i + 1] + w[0][2 * i + 1] * __uint_as_float(x0[i] & 0xffff0000u) + w[1][2 * i + 1] * __uint_as_float(x1[i] & 0xffff0000u) + w[2][2 * i + 1] * __uint_as_float(x2[i] & 0xffff0000u) + w[3][2 * i + 1] * __uint_as_float(x3[i] & 0xffff0000u);
                o[2 * i] = a0 * frcp_(1.f + __expf(-a0)); o[2 * i + 1] = a1 * frcp_(1.f + __expf(-a1)); }
            u32x4 pk; pk.x = pg8::cvt_pk_bf16(o[0], o[1]); pk.y = pg8::cvt_pk_bf16(o[2], o[3]); pk.z = pg8::cvt_pk_bf16(o[4], o[5]); pk.w = pg8::cvt_pk_bf16(o[6], o[7]);
            pg8::st16_wt(XC + (r0 + t) * 3072 + ch, pk);
            h0 = h1; h1 = h2; h2 = h3; }
    }
}
__device__ __forceinline__ void ssd_unit(const Ctx& C, const float* SM, const bf16_t* XC, bf16_t* AO, int unit) {
    const int head = unit & 31, bl = unit >> 5, grp = head >> 3;
    LAS bf16_t* Bn = (LAS bf16_t*)C.lds;
    LAS bf16_t* Cn = Bn + 64 * 136;
    LAS bf16_t* Xd = Cn + 64 * 136;
    LAS bf16_t* Xw = Xd + 64 * 72;
    LAS bf16_t* ST = Xw + 64 * 72;
    LAS float* dtL = (LAS float*)(ST + 64 * 136);
    LAS float* acL = dtL + 32 * 64;
    const int tid = C.tid, lane = C.lane, wave = C.wave, q = lane >> 4, r = lane & 15;
    const float A = -expf(C.in[18][head]), dtb = C.in[19][head], Dk = C.in[20][head];
    const int tt = wave & 3, pp = wave >> 2;
    f32x4 accst[4];
#pragma unroll
    for (int i = 0; i < 4; ++i) accst[i] = (f32x4){0.f, 0.f, 0.f, 0.f};
    LDS_BARRIER();
    for (int idx = tid; idx < 64 * 136 / 2; idx += 512) ((LAS unsigned*)ST)[idx] = 0u;
    for (int cc = wave; cc < NCHUNK; cc += 8) { const float dtv = softplusf_(SM[((size_t)bl * SEQ + (size_t)cc * 64 + lane) * 32 + head] + dtb); dtL[cc * 64 + lane] = dtv; acL[cc * 64 + lane] = wave_incl_sum(dtv * A, lane); }
    u32x4 xr, br[2], cr[2];
#define SSD_PREFETCH(cc) do { const size_t rr0 = (size_t)bl * SEQ + (size_t)(cc) * 64; \
        xr = *(const u32x4*)(XC + (rr0 + (tid >> 3)) * 3072 + head * 64 + (tid & 7) * 8); \
        _Pragma("unroll") for (int i = 0; i < 2; ++i) { const int idx = tid + 512 * i; const bf16_t* pr = XC + (rr0 + (idx >> 4)) * 3072 + 2048 + grp * 128 + (idx & 15) * 8; br[i] = *(const u32x4*)pr; cr[i] = *(const u32x4*)(pr + 512); } } while (0)
    SSD_PREFETCH(0);
    for (int c = 0; c < NCHUNK; ++c) {
        const size_t r0 = (size_t)bl * SEQ + (size_t)c * 64;
        LDS_BARRIER();
#pragma unroll
        for (int i = 0; i < 2; ++i) { const int idx = tid + 512 * i; *(LAS u32x4*)(Bn + (idx >> 4) * 136 + (idx & 15) * 8) = br[i]; *(LAS u32x4*)(Cn + (idx >> 4) * 136 + (idx & 15) * 8) = cr[i]; }
        const u32x4 xcur = xr;
        if (c + 1 < NCHUNK) SSD_PREFETCH(c + 1);
        const LAS float* dtc = dtL + c * 64; const LAS float* acc_ = acL + c * 64;
        { const int s = tid >> 3, c8 = tid & 7; const float dtv = dtc[s], de = __expf(acc_[63] - acc_[s]); const unsigned xx[4] = {xcur.x, xcur.y, xcur.z, xcur.w};
          u32x4 pd, pw; unsigned* pdp = (unsigned*)&pd; unsigned* pwp = (unsigned*)&pw;
#pragma unroll
          for (int i = 0; i < 4; ++i) { const float a = __uint_as_float(xx[i] << 16) * dtv, b = __uint_as_float(xx[i] & 0xffff0000u) * dtv; pdp[i] = pg8::cvt_pk_bf16(a, b); pwp[i] = pg8::cvt_pk_bf16(a * de, b * de); }
          *(LAS u32x4*)(Xd + s * 72 + c8 * 8) = pd; *(LAS u32x4*)(Xw + s * 72 + c8 * 8) = pw; }
        LDS_BARRIER();
        const int t = 16 * tt + r;
        f32x4 accy[2], accs[4];
#pragma unroll
        for (int i = 0; i < 2; ++i) accy[i] = (f32x4){0.f, 0.f, 0.f, 0.f};
#pragma unroll
        for (int i = 0; i < 4; ++i) accs[i] = (f32x4){0.f, 0.f, 0.f, 0.f};
#pragma unroll
        for (int kh = 0; kh < 2; ++kh) { bf16x8 fC[2], fS[2][2], fB[4][2];
#pragma unroll
          for (int k2 = 0; k2 < 2; ++k2) { const int ks = 2 * kh + k2; fC[k2] = ld_frag(Cn, 136, t, 32 * ks + 8 * q);
#pragma unroll
              for (int i = 0; i < 2; ++i) fS[i][k2] = ld_frag(ST, 136, 16 * (2 * pp + i) + r, 32 * ks + 8 * q);
#pragma unroll
              for (int mi = 0; mi < 4; ++mi) fB[mi][k2] = ld_frag(Bn, 136, 16 * mi + r, 32 * ks + 8 * q); }
          __builtin_amdgcn_sched_barrier(0);
#pragma unroll
          for (int k2 = 0; k2 < 2; ++k2) {
#pragma unroll
              for (int i = 0; i < 2; ++i) accy[i] = MFMA16(fS[i][k2], fC[k2], accy[i]);
#pragma unroll
              for (int mi = 0; mi < 4; ++mi) accs[mi] = MFMA16(fB[mi][k2], fC[k2], accs[mi]); } }
        const float ac_t = acc_[t], ea_t = __expf(ac_t), dinv_t = Dk * frcp_(dtc[t]);
#pragma unroll
        for (int i = 0; i < 2; ++i) accy[i] = accy[i] * ea_t;
#pragma unroll
        for (int mi = 0; mi < 4; ++mi) { const f32x4 acs = *(const LAS f32x4*)(acc_ + 16 * mi + 4 * q);
#pragma unroll
            for (int jj = 0; jj < 4; ++jj) { const int s = 16 * mi + 4 * q + jj; float dec = __expf(fminf(ac_t - acs[jj], 0.f)); asm volatile("" : "+v"(dec));
                float m = accs[mi][jj] * dec; m = (s <= t) ? m : 0.f; m = (s == t) ? m + dinv_t : m; accs[mi][jj] = m; } }
        bf16x8 fX[2][2], fBT[2], fXW[4][2];
#pragma unroll
        for (int ks2 = 0; ks2 < 2; ++ks2) {
#pragma unroll
            for (int i = 0; i < 2; ++i) fX[i][ks2] = ld_frag_tr(Xd, 72, 16 * (2 * pp + i), 32 * ks2 + 4 * q, 32 * ks2 + 16 + 4 * q, r);
            fBT[ks2] = ld_frag_tr(Bn, 136, 16 * wave, 32 * ks2 + 8 * q, 32 * ks2 + 8 * q + 4, r);
#pragma unroll
            for (int pt = 0; pt < 4; ++pt) fXW[pt][ks2] = ld_frag_tr(Xw, 72, 16 * pt, 32 * ks2 + 8 * q, 32 * ks2 + 8 * q + 4, r); }
        __builtin_amdgcn_sched_barrier(0);
#pragma unroll
        for (int ks2 = 0; ks2 < 2; ++ks2) { const bf16x8 bM = pack_frag(accs[2 * ks2], accs[2 * ks2 + 1]);
#pragma unroll
            for (int i = 0; i < 2; ++i) accy[i] = MFMA16(fX[i][ks2], bM, accy[i]); }
#pragma unroll
        for (int i = 0; i < 2; ++i) *(u32x2*)(AO + (r0 + t) * KO1 + 1024 + head * 64 + 16 * (2 * pp + i) + 4 * q) = pack4(accy[i]);
        const float gdec = __expf(acc_[63]);
#pragma unroll
        for (int pt = 0; pt < 4; ++pt) accst[pt] = accst[pt] * gdec;
#pragma unroll
        for (int ks = 0; ks < 2; ++ks) {
#pragma unroll
            for (int pt = 0; pt < 4; ++pt) accst[pt] = MFMA16(fBT[ks], fXW[pt][ks], accst[pt]); }
        LDS_BARRIER();
#pragma unroll
        for (int pt = 0; pt < 4; ++pt) *(LAS u32x2*)(ST + (16 * pt + r) * 136 + 16 * wave + 4 * q) = pack4(accst[pt]);
    }
#undef SSD_PREFETCH
}
__device__ __forceinline__ float logsigmoidf_(float x) { return fminf(x, 0.f) - log1pf(__expf(-fabsf(x))); }
__device__ __forceinline__ void mlstm_unit(const Ctx& C, const bf16_t* P, const float* SM, bf16_t* AO, int unit) {
    const int vs = unit & 3, h = (unit >> 2) & 3, bl = unit >> 4;
    LAS bf16_t* Qn = (LAS bf16_t*)C.lds;
    LAS bf16_t* Kn = Qn + 64 * 136;
    LAS bf16_t* Vn = Kn + 64 * 136;
    LAS bf16_t* VW = Vn + 64 * 88;
    LAS bf16_t* CT = VW + 64 * 88;
    LAS float* bcL = (LAS float*)(CT + 80 * 136);
    LAS float* lbL = bcL + 2048; LAS float* dmL = lbL + 2048; LAS float* weL = dmL + 2048;
    LAS float* scL = weL + 2048;
    const int tid = C.tid, lane = C.lane, wave = C.wave, q = lane >> 4, r = lane & 15;
    const float ib = C.in[4][h], fb = C.in[5][h]; const float scale = 0.08838834764831845f;
    const int tt = wave & 3, vg = wave >> 2;
    f32x4 accc[5];
#pragma unroll
    for (int i = 0; i < 5; ++i) accc[i] = (f32x4){0.f, 0.f, 0.f, 0.f};
    LDS_BARRIER();
    for (int idx = tid; idx < 80 * 136 / 2; idx += 512) ((LAS unsigned*)CT)[idx] = 0u;
    for (int idx = tid; idx < 64 * 8; idx += 512) { const int s_ = idx >> 3, cc = idx & 7; *(LAS unsigned*)(Vn + s_ * 88 + 64 + 2 * cc) = cc == 0 ? 0x00003f80u : 0u; *(LAS unsigned*)(VW + s_ * 88 + 64 + 2 * cc) = 0u; }
    for (int cc = wave; cc < NCHUNK; cc += 8) { const float* pr = SM + ((size_t)bl * SEQ + (size_t)cc * 64 + lane) * 32; const float li = pr[h] + ib, lf = logsigmoidf_(pr[4 + h] + fb);
        const float bcum = wave_incl_sum(lf, lane), b_end = __shfl(bcum, 63), g_end = b_end - bcum + li, m_loc = wave_max(g_end), lb = li - bcum;
        bcL[cc * 64 + lane] = bcum; lbL[cc * 64 + lane] = lb; dmL[cc * 64 + lane] = wave_incl_max(lb, lane); weL[cc * 64 + lane] = __expf(g_end - m_loc);
        if (lane == 0) { scL[cc] = b_end; scL[32 + cc] = m_loc; } }
    LDS_BARRIER();
    if (tid == 0) { float m_st = 0.f; for (int cc = 0; cc < NCHUNK; ++cc) { const float be = scL[cc], ml = scL[32 + cc], m_new = fmaxf(be + m_st, ml);
            scL[64 + cc] = m_st; scL[96 + cc] = __expf(be + m_st - m_new); scL[128 + cc] = __expf(ml - m_new); m_st = m_new; } }
    u32x4 vreg, qreg[2], kreg[2];
#define MLSTM_PREFETCH(cc) do { const size_t rr0 = (size_t)bl * SEQ + (size_t)(cc) * 64; \
        vreg = *(const u32x4*)(P + pj0(rr0 + (tid >> 3), C_MV + h * 256 + vs * 64 + (tid & 7) * 8)); \
        _Pragma("unroll") for (int it = 0; it < 2; ++it) { const int idx = tid + 512 * it; const size_t rw = rr0 + (idx >> 4); const int cq = h * 128 + (idx & 15) * 8; qreg[it] = *(const u32x4*)(P + pj0(rw, C_MQ + cq)); kreg[it] = *(const u32x4*)(P + pj0(rw, C_MK + cq)); } } while (0)
    MLSTM_PREFETCH(0);
    for (int c = 0; c < NCHUNK; ++c) {
        const size_t r0 = (size_t)bl * SEQ + (size_t)c * 64;
        LDS_BARRIER();
#pragma unroll
        for (int it = 0; it < 2; ++it) { const int idx = tid + 512 * it; *(LAS u32x4*)(Qn + (idx >> 4) * 136 + (idx & 15) * 8) = qreg[it]; *(LAS u32x4*)(Kn + (idx >> 4) * 136 + (idx & 15) * 8) = kreg[it]; }
        const u32x4 vv = vreg;
        *(LAS u32x4*)(Vn + (tid >> 3) * 88 + (tid & 7) * 8) = vv;
        if (c + 1 < NCHUNK) MLSTM_PREFETCH(c + 1);
        const float s_upd = scL[128 + c], s_old = scL[96 + c], m_prev = scL[64 + c];
        { const int s_ = tid >> 3; const float w = weL[c * 64 + s_] * s_upd; const unsigned w4[4] = {vv.x, vv.y, vv.z, vv.w}; u32x4 pw; unsigned* pwp = (unsigned*)&pw;
#pragma unroll
          for (int i = 0; i < 4; ++i) pwp[i] = pg8::cvt_pk_bf16(__uint_as_float(w4[i] << 16) * w, __uint_as_float(w4[i] & 0xffff0000u) * w);
          *(LAS u32x4*)(VW + s_ * 88 + (tid & 7) * 8) = pw;
          if (tid < 64) VW[tid * 88 + 64] = f2bf(weL[c * 64 + tid] * s_upd); }
        LDS_BARRIER();
        const int t = 16 * tt + r;
        f32x4 accn[3], accs[4];
#pragma unroll
        for (int i = 0; i < 3; ++i) accn[i] = (f32x4){0.f, 0.f, 0.f, 0.f};
#pragma unroll
        for (int i = 0; i < 4; ++i) accs[i] = (f32x4){0.f, 0.f, 0.f, 0.f};
#pragma unroll
        for (int ks = 0; ks < 4; ++ks) { const bf16x8 bQ = ld_frag(Qn, 136, t, 32 * ks + 8 * q);
#pragma unroll
            for (int i = 0; i < 3; ++i) accn[i] = MFMA16(ld_frag(CT, 136, 16 * (i < 2 ? 2 * vg + i : 4) + r, 32 * ks + 8 * q), bQ, accn[i]);
#pragma unroll
            for (int mi = 0; mi < 4; ++mi) accs[mi] = MFMA16(ld_frag(Kn, 136, 16 * mi + r, 32 * ks + 8 * q), bQ, accs[mi]); }
        const float bc_t = bcL[c * 64 + t], m_t = bc_t + fmaxf(m_prev, dmL[c * 64 + t]), winter = __expf(bc_t + m_prev - m_t) * scale, bt = bc_t - m_t;
#pragma unroll
        for (int i = 0; i < 3; ++i) accn[i] = accn[i] * winter;
#pragma unroll
        for (int mi = 0; mi < 4; ++mi) { const f32x4 lbs = *(const LAS f32x4*)(lbL + c * 64 + 16 * mi + 4 * q);
#pragma unroll
            for (int jj = 0; jj < 4; ++jj) { const int s = 16 * mi + 4 * q + jj; float wgt = __expf(fminf(bt + lbs[jj], 0.f)) * scale; asm volatile("" : "+v"(wgt)); const float m = accs[mi][jj] * wgt; accs[mi][jj] = (s <= t) ? m : 0.f; } }
#pragma unroll
        for (int ks2 = 0; ks2 < 2; ++ks2) { const bf16x8 bP = pack_frag(accs[2 * ks2], accs[2 * ks2 + 1]);
#pragma unroll
            for (int i = 0; i < 3; ++i) accn[i] = MFMA16(ld_frag_tr(Vn, 88, 16 * (i < 2 ? 2 * vg + i : 4), 32 * ks2 + 4 * q, 32 * ks2 + 16 + 4 * q, r), bP, accn[i]); }
        const float den = __shfl(accn[2][0], r); const float inv = frcp_(fmaxf(fabsf(den), __expf(-m_t)));
#pragma unroll
        for (int i = 0; i < 2; ++i) *(u32x2*)(AO + (r0 + t) * KO0 + h * 256 + vs * 64 + 16 * (2 * vg + i) + 4 * q) = pack4(accn[i] * inv);
#pragma unroll
        for (int vt = 0; vt < 5; ++vt) accc[vt] = accc[vt] * s_old;
#pragma unroll
        for (int ks = 0; ks < 2; ++ks) { const bf16x8 aK = ld_frag_tr(Kn, 136, 16 * wave, 32 * ks + 8 * q, 32 * ks + 8 * q + 4, r);
#pragma unroll
            for (int vt = 0; vt < 5; ++vt) accc[vt] = MFMA16(aK, ld_frag_tr(VW, 88, 16 * vt, 32 * ks + 8 * q, 32 * ks + 8 * q + 4, r), accc[vt]); }
        LDS_BARRIER();
#pragma unroll
        for (int vt = 0; vt < 5; ++vt) *(LAS u32x2*)(CT + (16 * vt + r) * 136 + 16 * wave + 4 * q) = pack4(accc[vt]);
    }
#undef MLSTM_PREFETCH
}
constexpr size_t PREP_UNIT_BYTES = 73728;
__device__ __forceinline__ void gdn_prep_phase(const Ctx& C, const bf16_t* P, const float* SM, unsigned char* prep, float* gtot) {
    LAS bf16_t* RAW = (LAS bf16_t*)C.lds;
    LAS float* Am = (LAS float*)C.lds;
    LAS float* Tf = Am + 64 * 65;
    LAS bf16_t* Tn = (LAS bf16_t*)(Tf + 64 * 65);
    LAS float* Ys = (LAS float*)(Tn + 64 * 72);
    LAS bf16_t* Kn = (LAS bf16_t*)(C.lds + 51456);
    LAS bf16_t* Qn = Kn + 64 * 136;
    LAS bf16_t* RK = Qn + 64 * 136;
    LAS bf16_t* RV = RK + 64 * 136;
    LAS float* fs = (LAS float*)(RV + 64 * 136);
    LAS float* cwl = fs + 256;
    const int tid = C.tid, lane = C.lane, wave = C.wave, q = lane >> 4, r = lane & 15;
    const float* cw = C.in[7];
    u32x4 rawreg[7]; float gareg = 0.f, gbreg = 0.f;
#define PREP_PREFETCH(uu) do { const int h_ = (uu) & 7, c_ = ((uu) >> 3) & 31, bl_ = (uu) >> 8; const size_t rr0 = (size_t)bl_ * SEQ + (size_t)c_ * 64; \
        _Pragma("unroll") for (int i = 0; i < 7; ++i) { const int idx = tid + 512 * i; const int rr = idx / 48, vv = idx - rr * 48; const int ts = c_ * 64 + rr - 3; \
            const int col = C_GQ + (vv >> 4) * 1024 + h_ * 128 + (vv & 15) * 8; rawreg[i] = (u32x4){0u, 0u, 0u, 0u}; \
            if (idx < 67 * 48 && ts >= 0) rawreg[i] = *(const u32x4*)(P + pj0(rr0 + rr - 3, col)); } \
        if (tid < 64) { const float* pr = SM + (rr0 + tid) * 32; gareg = pr[8 + h_]; gbreg = pr[16 + h_]; } } while (0)
    int h_loaded = -1;
    if (C.bid < 2048) PREP_PREFETCH(C.bid);
    for (int pu = C.bid; pu < 2048; pu += C.G) {
    const int h = pu & 7, c = (pu >> 3) & 31, bl = pu >> 8;
    const float na = -expf(C.in[8][h]), dtb = C.in[9][h];
    const size_t r0 = (size_t)bl * SEQ + (size_t)c * 64;
    bf16_t* gW = (bf16_t*)(prep + (size_t)pu * PREP_UNIT_BYTES); bf16_t* gQD = gW + 8192; bf16_t* gUT = gW + 16384; bf16_t* gKD = gW + 24576; bf16_t* gQK = gW + 32768;
    LDS_BARRIER();
#pragma unroll
    for (int i = 0; i < 7; ++i) { const int idx = tid + 512 * i; if (idx < 67 * 48) *(LAS u32x4*)(RAW + idx * 8) = rawreg[i]; }
    if (tid < 64) { const float g = na * softplusf_(gareg + dtb); const float gc = wave_incl_sum(g, lane), gl = __shfl(gc, 63);
        fs[tid] = gc; fs[64 + tid] = sigmoidf_(gbreg); fs[128 + tid] = __expf(gc); fs[192 + tid] = __expf(gl - gc);
        if (tid == 63) gtot[pu] = __expf(gc); }
    if (h != h_loaded) { for (int idx = tid; idx < 4 * 384; idx += 512) { const int j = idx / 384, cc = idx - j * 384; cwl[idx] = cw[j * 3072 + (cc >> 7) * 1024 + h * 128 + (cc & 127)]; } h_loaded = h; }
    if (pu + C.G < 2048) PREP_PREFETCH(pu + C.G);
    LDS_BARRIER();
#pragma unroll 1
    for (int it = 0; it < 6; ++it) { const int which = it >> 1; const int item = (tid + 512 * it) & 1023; const int t = item >> 4, c8 = item & 15;
        float a[8];
#pragma unroll
        for (int e = 0; e < 8; ++e) a[e] = 0.f;
#pragma unroll
        for (int j = 0; j < 4; ++j) { const u32x4 rv = *(const LAS u32x4*)(RAW + (t + j) * 384 + which * 128 + c8 * 8);
            const f32x4 w0 = *(const LAS f32x4*)(cwl + j * 384 + which * 128 + c8 * 8), w1 = *(const LAS f32x4*)(cwl + j * 384 + which * 128 + c8 * 8 + 4);
            a[0] += w0[0] * __uint_as_float(rv.x << 16); a[1] += w0[1] * __uint_as_float(rv.x & 0xffff0000u); a[2] += w0[2] * __uint_as_float(rv.y << 16); a[3] += w0[3] * __uint_as_float(rv.y & 0xffff0000u);
            a[4] += w1[0] * __uint_as_float(rv.z << 16); a[5] += w1[1] * __uint_as_float(rv.z & 0xffff0000u); a[6] += w1[2] * __uint_as_float(rv.w << 16); a[7] += w1[3] * __uint_as_float(rv.w & 0xffff0000u); }
        float ss = 0.f;
#pragma unroll
        for (int e = 0; e < 8; ++e) { a[e] = a[e] * frcp_(1.f + __expf(-a[e])); ss += a[e] * a[e]; }
        const float beta = fs[64 + t], egc = fs[128 + t], ekd = fs[192 + t];
        if (which < 2) {
            ss = row_sum16(ss);
            const float rs = rsqrtf(ss + EPS) * (which == 0 ? 0.08838834764831845f : 1.f);
#pragma unroll
            for (int e = 0; e < 8; ++e) a[e] *= rs;
            u32x4 pk; pk.x = pg8::cvt_pk_bf16(a[0], a[1]); pk.y = pg8::cvt_pk_bf16(a[2], a[3]); pk.z = pg8::cvt_pk_bf16(a[4], a[5]); pk.w = pg8::cvt_pk_bf16(a[6], a[7]);
            if (which == 0) { *(LAS u32x4*)(Qn + t * 136 + c8 * 8) = pk;
                u32x4 pd; pd.x = pg8::cvt_pk_bf16(a[0] * egc, a[1] * egc); pd.y = pg8::cvt_pk_bf16(a[2] * egc, a[3] * egc); pd.z = pg8::cvt_pk_bf16(a[4] * egc, a[5] * egc); pd.w = pg8::cvt_pk_bf16(a[6] * egc, a[7] * egc);
                *(u32x4*)(gQD + t * 128 + c8 * 8) = pd; }
            else { *(LAS u32x4*)(Kn + t * 136 + c8 * 8) = pk; const float bk = beta * egc;
                u32x4 p1, p2; unsigned* p1p = (unsigned*)&p1; unsigned* p2p = (unsigned*)&p2;
#pragma unroll
                for (int e = 0; e < 4; ++e) { p1p[e] = pg8::cvt_pk_bf16(a[2 * e] * bk, a[2 * e + 1] * bk); p2p[e] = pg8::cvt_pk_bf16(a[2 * e] * ekd, a[2 * e + 1] * ekd); }
                *(LAS u32x4*)(RK + t * 136 + c8 * 8) = p1; *(u32x4*)(gKD + t * 128 + c8 * 8) = p2; }
        } else {
            u32x4 p1; unsigned* p1p = (unsigned*)&p1;
#pragma unroll
            for (int e = 0; e < 4; ++e) p1p[e] = pg8::cvt_pk_bf16(a[2 * e] * beta, a[2 * e + 1] * beta);
            *(LAS u32x4*)(RV + t * 136 + c8 * 8) = p1;
        }
    }
    LDS_BARRIER();
    for (int idx = tid; idx < 64 * 65; idx += 512) Tf[idx] = 0.f;
    { const int jt = wave & 3, ih = wave >> 2;
      f32x4 akk[2], aqk[2];
#pragma unroll
      for (int i = 0; i < 2; ++i) { akk[i] = (f32x4){0.f, 0.f, 0.f, 0.f}; aqk[i] = (f32x4){0.f, 0.f, 0.f, 0.f}; }
#pragma unroll
      for (int ks = 0; ks < 4; ++ks) { const bf16x8 bK = ld_frag(Kn, 136, 16 * jt + r, 32 * ks + 8 * q), bQ = ld_frag(Qn, 136, 16 * jt + r, 32 * ks + 8 * q);
#pragma unroll
          for (int i = 0; i < 2; ++i) { const bf16x8 aK = ld_frag(Kn, 136, 16 * (2 * ih + i) + r, 32 * ks + 8 * q); akk[i] = MFMA16(aK, bK, akk[i]); aqk[i] = MFMA16(aK, bQ, aqk[i]); } }
      const int j = 16 * jt + r; const float gcj = fs[j];
#pragma unroll
      for (int i = 0; i < 2; ++i) { f32x4 qkv;
#pragma unroll
          for (int jj = 0; jj < 4; ++jj) { const int ii = 16 * (2 * ih + i) + 4 * q + jj; const float gci = fs[ii];
              float e1 = __expf(fminf(gci - gcj, 0.f)), e2 = __expf(fminf(gcj - gci, 0.f)); asm volatile("" : "+v"(e1), "+v"(e2));
              const float av = fs[64 + ii] * akk[i][jj] * e1, qv = aqk[i][jj] * e2;
              Am[ii * 65 + j] = (ii > j) ? av : 0.f;
              qkv[jj] = (ii <= j) ? qv : 0.f; }
          *(u32x2*)(gQK + j * 64 + 16 * (2 * ih + i) + 4 * q) = pack4(qkv); } }
    LDS_BARRIER();
    if (tid < 64) { const int b = tid >> 4, j = tid & 15; float x[16];
#pragma unroll
        for (int i = 0; i < 16; ++i) { float s = (i == j) ? 1.f : 0.f;
#pragma unroll
            for (int m = 0; m < i; ++m) s -= Am[(16 * b + i) * 65 + 16 * b + m] * x[m];
            x[i] = s; Tf[(16 * b + i) * 65 + 16 * b + j] = s; } }
    LDS_BARRIER();
    { const int pr = tid >> 8, i = (tid >> 4) & 15, j = tid & 15; const int hi = 2 * pr + 1, lo = 2 * pr; float s = 0.f;
#pragma unroll
      for (int m = 0; m < 16; ++m) s += Am[(16 * hi + i) * 65 + 16 * lo + m] * Tf[(16 * lo + m) * 65 + 16 * lo + j];
      Ys[pr * 16 * 17 + i * 17 + j] = s; }
    LDS_BARRIER();
    { const int pr = tid >> 8, i = (tid >> 4) & 15, j = tid & 15; const int hi = 2 * pr + 1, lo = 2 * pr; float s = 0.f;
#pragma unroll
      for (int m = 0; m < 16; ++m) s -= Tf[(16 * hi + i) * 65 + 16 * hi + m] * Ys[pr * 16 * 17 + m * 17 + j];
      Tf[(16 * hi + i) * 65 + 16 * lo + j] = s; }
    LDS_BARRIER();
    float y2[2];
#pragma unroll
    for (int e = 0; e < 2; ++e) { const int o = tid + 512 * e, i = o >> 5, j = o & 31; float s = 0.f;
#pragma unroll 8
        for (int m = 0; m < 32; ++m) s += Am[(32 + i) * 65 + m] * Tf[m * 65 + j];
        y2[e] = s; }
#pragma unroll
    for (int e = 0; e < 2; ++e) { const int o = tid + 512 * e; Ys[(o >> 5) * 33 + (o & 31)] = y2[e]; }
    LDS_BARRIER();
#pragma unroll
    for (int e = 0; e < 2; ++e) { const int o = tid + 512 * e, i = o >> 5, j = o & 31; float s = 0.f;
#pragma unroll 8
        for (int m = 0; m < 32; ++m) s -= Tf[(32 + i) * 65 + 32 + m] * Ys[m * 33 + j];
        Tf[(32 + i) * 65 + j] = s; }
    LDS_BARRIER();
    for (int idx = tid; idx < 64 * 32; idx += 512) { const int i = idx >> 5, j2 = (idx & 31) * 2; *(LAS unsigned*)(Tn + i * 72 + j2) = pg8::cvt_pk_bf16(Tf[i * 65 + j2], Tf[i * 65 + j2 + 1]); }
    LDS_BARRIER();
    { f32x4 aw[4], au[4];
#pragma unroll
      for (int i = 0; i < 4; ++i) { aw[i] = (f32x4){0.f, 0.f, 0.f, 0.f}; au[i] = (f32x4){0.f, 0.f, 0.f, 0.f}; }
#pragma unroll
      for (int ks = 0; ks < 2; ++ks) { const bf16x8 fK = ld_frag_tr(RK, 136, 16 * wave, 32 * ks + 8 * q, 32 * ks + 8 * q + 4, r), fV = ld_frag_tr(RV, 136, 16 * wave, 32 * ks + 8 * q, 32 * ks + 8 * q + 4, r);
#pragma unroll
          for (int tt = 0; tt < 4; ++tt) { const bf16x8 fT = ld_frag(Tn, 72, 16 * tt + r, 32 * ks + 8 * q); aw[tt] = MFMA16(fK, fT, aw[tt]); au[tt] = MFMA16(fT, fV, au[tt]); } }
#pragma unroll
      for (int tt = 0; tt < 4; ++tt) { *(u32x2*)(gW + (16 * tt + r) * 128 + 16 * wave + 4 * q) = pack4(aw[tt]);
          *(u32x2*)(gUT + (16 * wave + r) * 64 + 16 * tt + 4 * q) = pack4(au[tt]); } }
    }
#undef PREP_PREFETCH
}

__device__ __forceinline__ void gdn_scan_unit(const Ctx& C, const unsigned char* prep, const float* gtot, bf16_t* AO, int unit) {
    const int vs = unit & 1, h = (unit >> 1) & 7, bl = unit >> 4;
    LAS bf16_t* Wn = (LAS bf16_t*)C.lds;
    LAS bf16_t* Qd = Wn + 64 * 136;
    LAS bf16_t* Kd = Qd + 64 * 136;
    LAS bf16_t* QKn = Kd + 64 * 136;
    LAS bf16_t* UT = QKn + 64 * 72;
    LAS bf16_t* VNT = UT + 64 * 72;
    LAS bf16_t* ST = VNT + 64 * 72;
    const int tid = C.tid, lane = C.lane, wave = C.wave, q = lane >> 4, r = lane & 15;
    const int tt = wave & 3, vg = wave >> 2;
    f32x4 accS[4];
#pragma unroll
    for (int i = 0; i < 4; ++i) accS[i] = (f32x4){0.f, 0.f, 0.f, 0.f};
    LDS_BARRIER();
    for (int idx = tid; idx < 64 * 136 / 2; idx += 512) ((LAS unsigned*)ST)[idx] = 0u;
    u32x4 wreg[2], qreg[2], kreg[2], qkreg, ureg; float greg = 0.f;
#define GDN_PREFETCH(cc) do { const int pu_ = (bl * 32 + (cc)) * 8 + h; const bf16_t* gW_ = (const bf16_t*)(prep + (size_t)pu_ * PREP_UNIT_BYTES); \
        _Pragma("unroll") for (int it = 0; it < 2; ++it) { const int idx = tid + 512 * it, row = idx >> 4, ch = idx & 15; wreg[it] = *(const u32x4*)(gW_ + row * 128 + ch * 8); qreg[it] = *(const u32x4*)(gW_ + 8192 + row * 128 + ch * 8); kreg[it] = *(const u32x4*)(gW_ + 24576 + row * 128 + ch * 8); } \
        qkreg = *(const u32x4*)(gW_ + 32768 + (tid >> 3) * 64 + (tid & 7) * 8); ureg = *(const u32x4*)(gW_ + 16384 + vs * 64 * 64 + (tid >> 3) * 64 + (tid & 7) * 8); greg = gtot[pu_]; } while (0)
    GDN_PREFETCH(0);
    for (int c = 0; c < NCHUNK; ++c) {
        const size_t r0 = (size_t)bl * SEQ + (size_t)c * 64;
        LDS_BARRIER();
#pragma unroll
        for (int it = 0; it < 2; ++it) { const int idx = tid + 512 * it, row = idx >> 4, ch = idx & 15;
            *(LAS u32x4*)(Wn + row * 136 + ch * 8) = wreg[it]; *(LAS u32x4*)(Qd + row * 136 + ch * 8) = qreg[it]; *(LAS u32x4*)(Kd + row * 136 + ch * 8) = kreg[it]; }
        { const int row = tid >> 3, c8 = tid & 7; *(LAS u32x4*)(QKn + row * 72 + c8 * 8) = qkreg; *(LAS u32x4*)(UT + row * 72 + c8 * 8) = ureg; }
        const float g = greg;
        if (c + 1 < NCHUNK) GDN_PREFETCH(c + 1);
        LDS_BARRIER();
        { f32x4 d1[2];
#pragma unroll
          for (int i = 0; i < 2; ++i) d1[i] = (f32x4){0.f, 0.f, 0.f, 0.f};
#pragma unroll
          for (int ks = 0; ks < 4; ++ks) { const bf16x8 aW = ld_frag(Wn, 136, 16 * tt + r, 32 * ks + 8 * q);
#pragma unroll
              for (int i = 0; i < 2; ++i) d1[i] = MFMA16(aW, ld_frag(ST, 136, 16 * (2 * vg + i) + r, 32 * ks + 8 * q), d1[i]); }
#pragma unroll
          for (int i = 0; i < 2; ++i) { const int v = 16 * (2 * vg + i) + r; const u32x2 uu = *(const LAS u32x2*)(UT + v * 72 + 16 * tt + 4 * q);
              f32x4 vn; vn[0] = __uint_as_float(uu.x << 16) - d1[i][0]; vn[1] = __uint_as_float(uu.x & 0xffff0000u) - d1[i][1]; vn[2] = __uint_as_float(uu.y << 16) - d1[i][2]; vn[3] = __uint_as_float(uu.y & 0xffff0000u) - d1[i][3];
              *(LAS u32x2*)(VNT + v * 72 + 16 * tt + 4 * q) = pack4(vn); } }
        LDS_BARRIER();
        { f32x4 ao[2];
#pragma unroll
          for (int i = 0; i < 2; ++i) ao[i] = (f32x4){0.f, 0.f, 0.f, 0.f};
#pragma unroll
          for (int ks = 0; ks < 4; ++ks) { const bf16x8 bQ = ld_frag(Qd, 136, 16 * tt + r, 32 * ks + 8 * q);
#pragma unroll
              for (int i = 0; i < 2; ++i) ao[i] = MFMA16(ld_frag(ST, 136, 16 * (2 * vg + i) + r, 32 * ks + 8 * q), bQ, ao[i]); }
#pragma unroll
          for (int ks = 0; ks < 2; ++ks) { const bf16x8 bQK = ld_frag(QKn, 72, 16 * tt + r, 32 * ks + 8 * q);
#pragma unroll
              for (int i = 0; i < 2; ++i) ao[i] = MFMA16(ld_frag(VNT, 72, 16 * (2 * vg + i) + r, 32 * ks + 8 * q), bQK, ao[i]); }
#pragma unroll
          for (int i = 0; i < 2; ++i) *(u32x2*)(AO + (r0 + 16 * tt + r) * KO0 + 1024 + h * 128 + vs * 64 + 16 * (2 * vg + i) + 4 * q) = pack4(ao[i]); }
#pragma unroll
        for (int vt = 0; vt < 4; ++vt) accS[vt] = accS[vt] * g;
#pragma unroll
        for (int ks = 0; ks < 2; ++ks) { const bf16x8 aK = ld_frag_tr(Kd, 136, 16 * wave, 32 * ks + 8 * q, 32 * ks + 8 * q + 4, r);
#pragma unroll
            for (int vt = 0; vt < 4; ++vt) accS[vt] = MFMA16(aK, ld_frag(VNT, 72, 16 * vt + r, 32 * ks + 8 * q), accS[vt]); }
        LDS_BARRIER();
#pragma unroll
        for (int vt = 0; vt < 4; ++vt) *(LAS u32x2*)(ST + (16 * vt + r) * 136 + 16 * wave + 4 * q) = pack4(accS[vt]);
    }
#undef GDN_PREFETCH
}
constexpr int AW_KV = 16384, AW_T = 640;
__device__ __forceinline__ void attn_wave(const Ctx& C, const bf16_t* P, bf16_t* AO, int bl, int c, int head) {
    const int lane = C.lane;
    LAS unsigned char* Kb = C.lds + C.wave * AW_KV; LAS unsigned char* Vb = Kb + 8192;
    LAS float* Tb = (LAS float*)(C.lds + 8 * AW_KV) + C.wave * AW_T;
    const size_t r0 = (size_t)bl * SEQ + (size_t)c * 64;
    const int cb0 = c - 8 < 0 ? 0 : c - 8, nblk = c - cb0 + 1;
#define AW_BLK(n_) (c < 8 ? (n_) : c - ((c - (n_)) % 9))
#define AW_GK(cb_) ((const char*)(P + pj1((size_t)bl * SEQ + (size_t)(cb_) * 64, C_AK + head * 64)))
#define AW_GV(cb_) ((const char*)(P + pj1((size_t)bl * SEQ + (size_t)(cb_) * 64, C_AV + head * 64)))
#define AW_DMA_K(gb_) do { _Pragma("unroll") for (int i_ = 0; i_ < 8; ++i_) __builtin_amdgcn_global_load_lds((const unsigned*)((gb_) + (size_t)i_ * 1024 + (voK ^ ((i_ & 1) << 6))), (LAS unsigned*)(Kb + i_ * 1024), 16, 0, 0); } while (0)
#define AW_DMA_V(gb_) do { _Pragma("unroll") for (int i_ = 0; i_ < 8; ++i_) __builtin_amdgcn_global_load_lds((const unsigned*)((gb_) + (size_t)i_ * 1024 + voV), (LAS unsigned*)(Vb + i_ * 1024), 16, 0, 0); } while (0)
#define AW_LANE_CONSTS() int ln_ = lane; asm volatile("" : "+v"(ln_)); const int q = ln_ >> 4, r = ln_ & 15; \
    const unsigned voK = (unsigned)(((ln_ >> 3) * 64 + (((ln_ & 7) ^ (ln_ >> 4)) * 8)) * 2), voV = (unsigned)(((ln_ >> 3) * 64 + (((ln_ & 7) ^ (2 * (ln_ >> 4))) * 8)) * 2)
    asm volatile("s_waitcnt vmcnt(0)" ::: "memory");
    bf16x8 bQ[4][2];
    { AW_LANE_CONSTS(); const int cbf = AW_BLK(0); AW_DMA_K(AW_GK(cbf)); AW_DMA_V(AW_GV(cbf));
#pragma unroll
    for (int s = 0; s < 4; ++s)
#pragma unroll
        for (int ks = 0; ks < 2; ++ks) bQ[s][ks] = *(const bf16x8*)(P + pj1(r0 + 16 * s + r, C_AQ + head * 64 + 32 * ks + 8 * q)); }
#pragma unroll
    for (int i = 0; i < 10; ++i) { const int k = lane + 64 * i; int ri = 638 - k; ri = ri > 319 ? 319 : (ri < 0 ? 0 : ri); Tb[k] = C.in[15][head * 320 + ri] * 1.4426950408889634f; }
    f32x4 acco[4][4]; float m_run[4], l_run[4];
#pragma unroll
    for (int s = 0; s < 4; ++s) { m_run[s] = -1e30f; l_run[s] = 0.f;
#pragma unroll
        for (int md = 0; md < 4; ++md) acco[s][md] = (f32x4){0.f, 0.f, 0.f, 0.f}; }
#define XSH(v_, a_) __builtin_bit_cast(float, __builtin_amdgcn_ds_bpermute(a_, __builtin_bit_cast(int, v_)))
    asm volatile("s_waitcnt vmcnt(0)" ::: "memory");
    for (int n = 0; n < nblk; ++n) {
        const bool more = n + 1 < nblk; const int cb = AW_BLK(n), cbn = AW_BLK(n + 1);
        AW_LANE_CONSTS();
        const int kofs0 = r * 128 + ((q ^ (r >> 1)) * 16), kofs1 = kofs0 ^ 64;
        const int vsw = 2 * ((2 * q + (r >> 3)) & 3), vrow = (4 * q + (r >> 2)) * 128 + (r & 1) * 8, vc0 = (((r & 3) >> 1) ^ vsw) * 16;
        const int x16 = (ln_ ^ 16) * 4, x32 = (ln_ ^ 32) * 4;
        const int tb0 = 638 - 64 * (c - cb0) - 63 - (r - 4 * q) - 48;
        asm volatile("s_waitcnt vmcnt(8)" ::: "memory");
        const LAS float* tp = Tb + tb0 + 64 * (cb - cb0);
        bf16x8 pf[4][2]; f32x4 accs[4][4]; float mx[4];
#pragma unroll
        for (int s = 0; s < 4; ++s) {
#pragma unroll
            for (int mi = 0; mi < 4; ++mi) { const bf16x8 k0 = *(const LAS bf16x8*)(Kb + mi * 2048 + kofs0), k1 = *(const LAS bf16x8*)(Kb + mi * 2048 + kofs1);
                const LAS float* tq = tp + 16 * (mi - s + 3);
                accs[s][mi] = MFMA16(k0, bQ[s][0], ((f32x4){0.f, 0.f, 0.f, 0.f})); accs[s][mi] = MFMA16(k1, bQ[s][1], accs[s][mi]);
                accs[s][mi] = accs[s][mi] + (f32x4){tq[0], tq[1], tq[2], tq[3]}; }
            float m = -1e30f;
#pragma unroll
            for (int mi = 0; mi < 4; ++mi) m = fmaxf(fmaxf(m, fmaxf(accs[s][mi][0], accs[s][mi][1])), fmaxf(accs[s][mi][2], accs[s][mi][3]));
            m = fmaxf(m, XSH(m, x16)); mx[s] = fmaxf(m, XSH(m, x32));
        }
        asm volatile("s_waitcnt lgkmcnt(0)" ::: "memory");
        if (more) AW_DMA_K(AW_GK(cbn));
        const bool need = (mx[0] > m_run[0] + 8.f) | (mx[1] > m_run[1] + 8.f) | (mx[2] > m_run[2] + 8.f) | (mx[3] > m_run[3] + 8.f);
        if (__builtin_amdgcn_ballot_w64(need) != 0ull) {
#pragma unroll
            for (int s = 0; s < 4; ++s) { const float m_new = mx[s] > m_run[s] + 8.f ? mx[s] : m_run[s], al = __builtin_amdgcn_exp2f(m_run[s] - m_new); m_run[s] = m_new; l_run[s] *= al;
#pragma unroll
                for (int md = 0; md < 4; ++md) acco[s][md] = acco[s][md] * al; }
        }
#pragma unroll
        for (int s = 0; s < 4; ++s) { float ls = 0.f;
#pragma unroll
            for (int mi = 0; mi < 4; ++mi)
#pragma unroll
                for (int jj = 0; jj < 4; ++jj) { accs[s][mi][jj] = __builtin_amdgcn_exp2f(accs[s][mi][jj] - m_run[s]); ls += accs[s][mi][jj]; }
            l_run[s] += ls;
            pf[s][0] = pack_frag(accs[s][0], accs[s][1]); pf[s][1] = pack_frag(accs[s][2], accs[s][3]);
        }
        if (more) asm volatile("s_waitcnt vmcnt(8)" ::: "memory"); else asm volatile("s_waitcnt vmcnt(0)" ::: "memory");
        bf16x8 vf[4][2];
#pragma unroll
        for (int md = 0; md < 4; ++md)
#pragma unroll
            for (int ks2 = 0; ks2 < 2; ++ks2) { const LAS unsigned char* vp = Vb + vrow + ks2 * 4096 + (((2 * md) * 16) ^ vc0);
                const bf16x4 lo = __builtin_amdgcn_ds_read_tr16_b64_v4i16((LAS bf16x4*)(vp)), hi = __builtin_amdgcn_ds_read_tr16_b64_v4i16((LAS bf16x4*)(vp + 2048));
                vf[md][ks2] = __builtin_shufflevector(lo, hi, 0, 1, 2, 3, 4, 5, 6, 7); }
        asm volatile("s_waitcnt lgkmcnt(0)" ::: "memory");
        if (more) AW_DMA_V(AW_GV(cbn));
#pragma unroll
        for (int md = 0; md < 4; ++md)
#pragma unroll
            for (int ks2 = 0; ks2 < 2; ++ks2)
#pragma unroll
                for (int s = 0; s < 4; ++s) acco[s][md] = MFMA16(vf[md][ks2], pf[s][ks2], acco[s][md]);
    }
    AW_LANE_CONSTS(); const int x16 = (ln_ ^ 16) * 4, x32 = (ln_ ^ 32) * 4;
#pragma unroll
    for (int s = 0; s < 4; ++s) { float l = l_run[s]; l += XSH(l, x16); l += XSH(l, x32); const float inv = 1.f / l;
#pragma unroll
        for (int md = 0; md < 4; ++md) *(u32x2*)(AO + (r0 + 16 * s + r) * KO1 + head * 64 + 16 * md + 4 * q) = pack4(acco[s][md] * inv); }
#undef XSH
#undef AW_BLK
#undef AW_GK
#undef AW_GV
#undef AW_LANE_CONSTS
#undef AW_DMA_K
#undef AW_DMA_V
}
__device__ __forceinline__ void phase_attn(const Ctx& C, const bf16_t* P, bf16_t* AO) {
    LDS_BARRIER();
    for (int u = C.bid; u < 512; u += C.G) { const int x = u & 7, i = (u >> 3) & 31, second = u >> 8, seq = 2 * x + second, c = second ? 31 - i : i;
        attn_wave(C, P, AO, seq >> 1, c, 8 * (seq & 1) + C.wave); }
    asm volatile("s_waitcnt vmcnt(0)" ::: "memory");
}
#define PH_BEGIN if (ph >= lo && ph < hi) { { int t_ = C.wave0 * 64 + lane_id_(); asm volatile("" : "+v"(t_)); C.tid = t_; C.lane = t_ & 63; C.wave = __builtin_amdgcn_readfirstlane(t_ >> 6); }
#define PH_END   if (ph + 1 < hi) xcd_barrier(bar); } ++ph;

__device__ __forceinline__ void moe_block(Ctx& C, const XcdBarrier& bar, int& ph, const int lo, const int hi, const int layer) {
    PH_BEGIN phase_convert_moe(C, layer); __syncthreads(); phase_r1(C, layer); PH_END
    PH_BEGIN phase_r2(C, layer); PH_END
    PH_BEGIN {
        const int npan = *((const int*)(C.ws + WS_CNT) + 128 + layer);
        pg8::Gemm g{(const bf16_t*)(C.ws + WS_H2P), (const bf16_t*)(C.ws + WS_W1), NTOK, 32 * 512, 1024};
        pg8::MoeOrder S{(const int*)(C.ws + WS_PANEL) + layer * 320, npan * 2, C.G, C.bid, 1};
        pg8::EpiSwiGLU E{(bf16_t*)(C.ws + WS_ACT), (const float*)(C.ws + WS_WROW)};
        pg8::gemm_phase_g<pg8::EpiSwiGLU, pg8::MoeOrder, false>(C.lds, g, S, E, (const int*)(C.ws + WS_ROWTOK), nullptr, C.wave0);
    } PH_END
    PH_BEGIN {
        const int npan = *((const int*)(C.ws + WS_CNT) + 128 + layer);
        pg8::Gemm g{(const bf16_t*)(C.ws + WS_ACT), (const bf16_t*)(C.ws + WS_W2), MOE_MAXROWS, 32 * 1024, 256};
        pg8::MoeOrder S{(const int*)(C.ws + WS_PANEL) + layer * 320, npan * 4, C.G, C.bid, 2};
        pg8::EpiBf16P E{(bf16_t*)(C.ws + WS_YP), 1024, 3};
        pg8::gemm_phase<pg8::EpiBf16P, pg8::MoeOrder, false>(C.lds, g, S, E, nullptr, C.wave0);
    } PH_END
    PH_BEGIN { if (layer == 0) { phase_combine_norm(C, (const float*)(C.ws + WS_WSM1), C.in[1] + D, (bf16_t*)(C.ws + WS_HN1A), (float*)(C.ws + WS_SM1), (bf16_t*)(C.ws + WS_HN1B), (float*)(C.ws + WS_SM1 + 2 * MiB)); __syncthreads(); phase_convert(C, 1); }
               else phase_combine(C); } PH_END
}

__global__ void __launch_bounds__(512, 2) mega_fwd(Args args) {
    extern __shared__ __attribute__((aligned(16))) unsigned char lds_raw[];
    Ctx C; C.in = args.in; C.out = args.out; C.ws = args.ws; C.lds = (LAS unsigned char*)lds_raw;
    C.wave0 = __builtin_amdgcn_readfirstlane((int)threadIdx.x >> 6);
    C.lane = lane_id_(); C.tid = C.wave0 * 64 + C.lane; C.wave = C.wave0; C.G = gridDim.x; C.bid = blockIdx.x;
    if (C.tid < 4) ((LAS unsigned*)(C.lds + LDS_BAR_OFF))[C.tid] = 0u;
    __syncthreads();
    XcdBarrier bar = xcd_barrier_post((unsigned*)(C.ws + WS_BAR) + args.li * XCD_BAR_WORDS, (volatile LAS unsigned*)(C.lds + LDS_BAR_OFF), C.wave0);
    const int lo = args.ph_lo, hi = args.ph_hi; int ph = 0;
    bf16_t* HN = (bf16_t*)(C.ws + WS_HN); bf16_t* AO = (bf16_t*)(C.ws + WS_AOUT); bf16_t* PJ = (bf16_t*)(C.ws + WS_PROJ);
    const bf16_t* Win = (const bf16_t*)(C.ws + WS_WIN); const bf16_t* Wout = (const bf16_t*)(C.ws + WS_WOUT);

    PH_BEGIN phase_convert(C, 0); PH_END
    _Pragma("unroll") for (int g = 0; g < NGRP; ++g) {
        const size_t grow = (size_t)g * GTOK;
        if (g == 0) { PH_BEGIN phase_norm(C, (const float*)(C.ws + WS_WSM), C.in[0] + grow * D, C.in[1], HN, (float*)(C.ws + WS_SM0), GTOK, C.bid, C.G); PH_END }
        PH_BEGIN { pg8::Gemm gm{g == 0 ? HN : (const bf16_t*)(C.ws + WS_AOUT + 64 * MiB), Win, GTOK, NP0, D}; pg8::StaticOrder S; S.init(GTOK, NP0, C.G, C.bid); pg8::EpiBf16QKT<false> E{PJ, NP0 / 256, nullptr, C.lds + pg8::STAGE_BYTES + 512};
            pg8::gemm_phase<pg8::EpiBf16QKT<false>, pg8::StaticOrder, false>(C.lds, gm, S, E, nullptr, C.wave0); } PH_END
        PH_BEGIN { gdn_prep_phase(C, PJ, (const float*)(C.ws + WS_SM0 + (size_t)g * 2 * MiB), C.ws + WS_PREP, (float*)(C.ws + WS_GTOT)); } PH_END
        PH_BEGIN { const int nA = C.G >> 1;
            if (C.bid < nA) { for (int u = C.bid; u < 128; u += nA) gdn_scan_unit(C, C.ws + WS_PREP, (const float*)(C.ws + WS_GTOT), AO, u);
                if (g == 0) { __syncthreads(); phase_norm(C, (const float*)(C.ws + WS_WSM), C.in[0] + (size_t)GTOK * D, C.in[1], (bf16_t*)(C.ws + WS_AOUT + 64 * MiB), (float*)(C.ws + WS_SM0 + 2 * MiB), GTOK, C.bid, nA); } }
            else { for (int u = C.bid - nA; u < 128; u += C.G - nA) mlstm_unit(C, PJ, (const float*)(C.ws + WS_SM0 + (size_t)g * 2 * MiB), AO, u); } } PH_END
        PH_BEGIN phase_gate0(C, PJ, AO); PH_END
        PH_BEGIN { pg8::Gemm gm{AO, Wout, GTOK, D, KO0}; pg8::StaticOrder S; S.init(GTOK, D, C.G, C.bid); pg8::EpiResidB<false> E{C.in[0] + grow * D, (bf16_t*)C.out + grow * D, D};
            pg8::gemm_phase<pg8::EpiResidB<false>, pg8::StaticOrder, false>(C.lds, gm, S, E, nullptr, C.wave0); } PH_END
    }
    moe_block(C, bar, ph, lo, hi, 0);
    _Pragma("unroll") for (int g = 0; g < NGRP; ++g) {
        const size_t grow = (size_t)g * GTOK;
        PH_BEGIN { LAS float* gn = (LAS float*)(C.lds + pg8::STAGE_BYTES);
            if (C.tid < 128) gn[C.tid] = C.tid < 64 ? C.in[13][C.tid] * (0.125f * 1.4426950408889634f) : C.in[14][C.tid - 64];
            __syncthreads();
            pg8::Gemm gm{(const bf16_t*)(C.ws + (g == 0 ? WS_HN1A : WS_HN1B)), Win, GTOK, NP1, D}; pg8::StaticOrder S; S.init(GTOK, NP1, C.G, C.bid); pg8::EpiBf16QKT<true> E{PJ, NP1 / 256, gn, C.lds + pg8::STAGE_BYTES + 512};
            pg8::gemm_phase<pg8::EpiBf16QKT<true>, pg8::StaticOrder, false>(C.lds, gm, S, E, nullptr, C.wave0); } PH_END
        PH_BEGIN { phase_ssdconv(C, PJ, (bf16_t*)(C.ws + WS_XC)); } PH_END
        PH_BEGIN { for (int u = C.bid; u < 256; u += C.G) ssd_unit(C, (const float*)(C.ws + WS_SM1 + (size_t)g * 2 * MiB), (const bf16_t*)(C.ws + WS_XC), AO, u); phase_attn(C, PJ, AO); } PH_END
        PH_BEGIN phase_gate1(C, PJ, AO); PH_END
        PH_BEGIN { pg8::Gemm gm{AO, Wout, GTOK, D, KO1}; pg8::StaticOrder S; S.init(GTOK, D, C.G, C.bid); pg8::EpiResidB<true> E{(const bf16_t*)C.out + grow * D, (bf16_t*)C.out + grow * D, D};
            pg8::gemm_phase<pg8::EpiResidB<true>, pg8::StaticOrder, false>(C.lds, gm, S, E, nullptr, C.wave0); } PH_END
    }
    moe_block(C, bar, ph, lo, hi, 1);
}
constexpr int N_PHASES = 1 + (6 * NGRP + 5 - 1) + (5 * NGRP + 5);

#ifndef N_LAUNCHES
#define N_LAUNCHES 1
#endif
extern "C" void kernel_launch(void* const* d_in, const int* in_sizes, int n_in, void* d_out, int out_size, void* d_ws, size_t ws_size, hipStream_t stream) {
    static int grid = 0;
    if (grid == 0) {
        if (n_in != 30 || out_size != NTOK * D || ws_size < WS_END) { fprintf(stderr, "kernel_launch: unexpected shapes (n_in %d out %d ws %zu)\n", n_in, out_size, ws_size); grid = -1; return; }
        int dev = 0, cus = 0, per_cu = 0;
        if (hipGetDevice(&dev) != hipSuccess || hipDeviceGetAttribute(&cus, hipDeviceAttributeMultiprocessorCount, dev) != hipSuccess) { grid = -1; return; }
        if (hipFuncSetAttribute((const void*)mega_fwd, hipFuncAttributeMaxDynamicSharedMemorySize, LDS_BYTES) != hipSuccess) { fprintf(stderr, "kernel_launch: hipFuncSetAttribute failed\n"); grid = -1; return; }
        if (hipOccupancyMaxActiveBlocksPerMultiprocessor(&per_cu, (const void*)mega_fwd, 512, LDS_BYTES) != hipSuccess || per_cu < 1) fprintf(stderr, "kernel_launch: occupancy query says %d\n", per_cu);
        (void)hipGetLastError();
        grid = cus;
    }
    if (grid < 0) return;
    if (hipMemsetAsync(d_ws, 0, WS_ZERO_BYTES, stream) != hipSuccess) return;
    Args a{};
    for (int i = 0; i < 30; ++i) a.in[i] = (const float*)d_in[i];
    a.out = (float*)d_out; a.ws = (unsigned char*)d_ws; a.pad = 0;
    for (int li = 0; li < N_LAUNCHES; ++li) {
        a.ph_lo = (int)((long)N_PHASES * li / N_LAUNCHES); a.ph_hi = (int)((long)N_PHASES * (li + 1) / N_LAUNCHES); a.li = li;
        hipLaunchKernelGGL(mega_fwd, dim3(grid), dim3(512), LDS_BYTES, stream, a);
    }
}
```

```cpp
#include <hip/hip_runtime.h>
#include <cstdio>
#include <cstdint>
#define XB_TMO      128
#define XB_XCNT(j)  (256  + 64 * (j))
#define XB_XSUB(j)  (1280 + 64 * (j))
#define XB_XGEN(j)  (2304 + 64 * (j))
#define XB_TOP      3328
#define XB_TOPGEN   3392
#define XCD_BAR_WORDS 3456
#define XB_SPIN_CAP (1u << 22)
#define LAS __attribute__((address_space(3)))

__device__ __forceinline__ unsigned xb_ld(unsigned* p)              { return __hip_atomic_load(p, __ATOMIC_RELAXED, __HIP_MEMORY_SCOPE_AGENT); }
__device__ __forceinline__ unsigned xb_add(unsigned* p, unsigned v) { return __hip_atomic_fetch_add(p, v, __ATOMIC_RELAXED, __HIP_MEMORY_SCOPE_AGENT); }
__device__ __forceinline__ unsigned xb_xcc_id() { return (unsigned)__builtin_amdgcn_s_getreg((3 << 11) | 20) & 0xFu; }
#define XB_SPIN(cond, bar) do { unsigned _sp = 0; while (cond) { __builtin_amdgcn_s_sleep(1); \
    if ((++_sp & 255u) == 0u) { if (xb_ld(&(bar)[XB_TMO])) break; if (_sp > XB_SPIN_CAP) { atomicAdd(&(bar)[XB_TMO], 1u); break; } } } } while (0)

struct XcdBarrier {
    int w0;
    unsigned* bar; unsigned x;
    volatile LAS unsigned* st;
};

__device__ __forceinline__ int lane_id_() { int l; asm volatile("v_mbcnt_lo_u32_b32 %0, -1, 0\n\tv_mbcnt_hi_u32_b32 %0, -1, %0" : "=v"(l)); return l; }
__device__ __forceinline__ XcdBarrier xcd_barrier_post(unsigned* bar, volatile LAS unsigned* st, int w0) {
    XcdBarrier b; b.w0 = w0; b.bar = bar; b.x = xb_xcc_id(); b.st = st;
    if (w0 == 0 && lane_id_() == 0) (void)xb_add(&bar[XB_XCNT(b.x)], 1u);
    return b;
}
__device__ __forceinline__ void xcd_barrier_complete(unsigned* bar, unsigned x, unsigned& nloc, unsigned& nx) {
    const unsigned G = gridDim.x * gridDim.y * gridDim.z;
    unsigned sum, cnt, mine, sp = 0u;
    for (;;) {
        sum = 0u; cnt = 0u; mine = 0u;
#pragma unroll
        for (unsigned j = 0; j < 16; ++j) { const unsigned c = xb_ld(&bar[XB_XCNT(j)]); sum += c; cnt += (c > 0u) ? 1u : 0u; mine = (j == x) ? c : mine; }
        if (sum == G) break;
        __builtin_amdgcn_s_sleep(1);
        if ((++sp & 255u) == 0u) { if (xb_ld(&bar[XB_TMO])) break; if (sp > XB_SPIN_CAP) { atomicAdd(&bar[XB_TMO], 1u); break; } }
    }
    nloc = mine > 0u ? mine : 1u; nx = cnt > 0u ? cnt : 1u;
}

__device__ __forceinline__ void xcd_barrier(const XcdBarrier& b) {
    asm volatile("s_waitcnt vmcnt(0)" ::: "memory");
    __syncthreads();
    if (b.w0 == 0 && lane_id_() == 0) {
        unsigned* bar = b.bar;
        __builtin_amdgcn_s_waitcnt(0);
        unsigned nloc = b.st[0], nx = b.st[1];
        if (nloc == 0u) { xcd_barrier_complete(bar, b.x, nloc, nx); b.st[0] = nloc; b.st[1] = nx; }
        const unsigned old = xb_add(&bar[XB_XSUB(b.x)], 1u);
        const unsigned gen = old / nloc;
        if (old + 1u == (gen + 1u) * nloc) {
            __builtin_amdgcn_fence(__ATOMIC_RELEASE, "agent");
            asm volatile("s_waitcnt vmcnt(0)" ::: "memory");
            const unsigned og = xb_add(&bar[XB_TOP], 1u);
            const unsigned tg = og / nx;
            if (og + 1u == (tg + 1u) * nx) xb_add(&bar[XB_TOPGEN], 1u);
            else XB_SPIN(xb_ld(&bar[XB_TOPGEN]) == tg, bar);
            __builtin_amdgcn_fence(__ATOMIC_ACQUIRE, "agent");
            xb_add(&bar[XB_XGEN(b.x)], 1u);
            asm volatile("s_waitcnt vmcnt(0)" ::: "memory");
        } else {
            XB_SPIN(xb_ld(&bar[XB_XGEN(b.x)]) == gen, bar);
            __builtin_amdgcn_fence(__ATOMIC_ACQUIRE, "agent");
            asm volatile("s_waitcnt vmcnt(0)" ::: "memory");
        }
    }
    __syncthreads();
}
namespace pg8 {
#define PG8_LAS __attribute__((address_space(3)))
typedef unsigned short bf16_t;
typedef short bf16x8 __attribute__((ext_vector_type(8)));
typedef float f32x4 __attribute__((ext_vector_type(4)));
typedef unsigned u32x4 __attribute__((ext_vector_type(4)));
constexpr int BM = 256, BK = 64, HALF = 128, HTB = HALF * BK * 2  , STAGE_BYTES = 8 * HTB, NXCD = 8, WGM = 8;

__host__ __device__ __forceinline__ int lds_byte(int r, int c) { const int st = (r >> 4) * 2 + (c >> 5), rr = r & 15, cc = c & 31, ob = rr * 64 + cc * 2; return st * 1024 + (ob ^ (((ob >> 9) & 1) << 5)); }
__host__ __device__ __forceinline__ void stage_rc(int b, int& R, int& C) { const int st = b / 1024, sb = b % 1024, swz = sb ^ (((sb >> 9) & 1) << 5); R = (st >> 1) * 16 + swz / 64; C = (st & 1) * 32 + (swz % 64) / 2; }
__host__ __device__ __forceinline__ int perm32(int rho) { const int n = rho >> 4, i = rho & 15; return 8 * (i >> 2) + 4 * n + (i & 3); }

struct Unit { int pm, pn; };
struct Gemm { const bf16_t* A; const bf16_t* Bt; int M, N, K; };

struct StaticOrder {
    int nM, nN, nwg, G, c;
    __host__ __device__ void init(int M, int N, int G_, int c_) { nM = M / BM; nN = N / BM; nwg = nM * nN; G = G_; c = c_; }
    __host__ __device__ bool next(int i, Unit& u) const {
        const long L = (long)i * G + c; if (L >= nwg) return false;
        int wgid = (int)L; { const int q = nwg / NXCD, r = nwg % NXCD, xcd = wgid % NXCD, off = wgid / NXCD; wgid = (xcd < r ? xcd * (q + 1) : r * (q + 1) + (xcd - r) * q) + off; }
        const int nig = WGM * nN, gid = wgid / nig, fm = gid * WGM, gsz = (nM - fm) < WGM ? (nM - fm) : WGM;
        u.pm = fm + ((wgid % nig) % gsz); u.pn = (wgid % nig) / gsz; return true;
    }
    __device__ __forceinline__ void a_ready(const Unit&) const {}
    __device__ __forceinline__ void done(const Unit&) const {}
};

typedef float f32x2c __attribute__((ext_vector_type(2))); typedef __bf16 bf16x2c __attribute__((ext_vector_type(2)));
__device__ __forceinline__ unsigned cvt_pk_bf16(float lo, float hi) { const f32x2c v = {lo, hi}; return __builtin_bit_cast(unsigned, __builtin_convertvector(v, bf16x2c)); }
typedef float f32x2 __attribute__((ext_vector_type(2)));
template <class Epi, class Sched, bool STAMP = false>
__device__ __forceinline__ void gemm_phase(PG8_LAS unsigned char* lds, const Gemm g, const Sched& S, const Epi& E, unsigned long long* stamps, const int wave0) {
    int tid_l = wave0 * 64 + lane_id_(); asm volatile("" : "+v"(tid_l)); const int tid = tid_l, wid = __builtin_amdgcn_readfirstlane(tid >> 6), lane = tid & 63, wr = wid >> 2, wc = wid & 3, fr = lane & 15, fq = lane >> 4;
    const int K = g.K, nt = K / BK;
    int ts_lo = 0, ts_hi = 0, nts = 0; const unsigned long long rt_entry = STAMP ? (unsigned long long)wall_clock64() : 0ull;
#define PG8_STAMP() do { if (STAMP && wid == 0 && nts < 64) { const unsigned long long _c = (unsigned long long)clock64(); \
        ts_lo = (lane == nts) ? (int)(unsigned)_c : ts_lo; ts_hi = (lane == nts) ? (int)(unsigned)(_c >> 32) : ts_hi; ++nts; } } while (0)
    PG8_STAMP();
    unsigned voffA[2], voffB[2];
#pragma unroll
    for (int i = 0; i < 2; ++i) { int R, C; stage_rc(tid * 16 + i * 8192, R, C); const int Rb = Epi::PERM ? ((R & ~31) + perm32(R & 31)) : R;
        voffA[i] = (unsigned)(R * K + C) * 2u; voffB[i] = (unsigned)(Rb * K + C) * 2u; }
    const size_t kstep = (size_t)(BK * 2);
    const size_t hstep = (size_t)HALF * K * 2;
    const size_t tstep = 2 * hstep;
    const unsigned ldsw = (unsigned)wid * 1024u;
    const int aoff = lds_byte(wr * 64 + fr, fq * 8), boff = lds_byte(wc * 32 + fr, fq * 8);
#define PG8_SA(b, h) (((b) * 2 + (h)) * HTB)
#define PG8_SB(b, h) ((4 + (b) * 2 + (h)) * HTB)
#define PG8_STAGE(bufoff, gbase, voff) do { _Pragma("unroll") for (int _i = 0; _i < 2; ++_i) \
        __builtin_amdgcn_global_load_lds((const unsigned*)((const char*)(gbase) + (voff)[_i]), (PG8_LAS unsigned*)(lds + (bufoff) + ldsw + _i * 8192), 16, 0, 0); } while (0)
#define PG8_LDA(dst, b, h) do { _Pragma("unroll") for (int m = 0; m < 4; ++m) _Pragma("unroll") for (int k = 0; k < 2; ++k) dst[m][k] = *(const PG8_LAS bf16x8*)(lds + PG8_SA(b, h) + aoff + m * 2048 + k * 1024); } while (0)
#define PG8_LDB(dst, b, h) do { _Pragma("unroll") for (int n = 0; n < 2; ++n) _Pragma("unroll") for (int k = 0; k < 2; ++k) dst[n][k] = *(const PG8_LAS bf16x8*)(lds + PG8_SB(b, h) + boff + n * 2048 + k * 1024); } while (0)
#define PG8_MMA(ai, bj, At, Bt) do { __builtin_amdgcn_s_setprio(1); _Pragma("unroll") for (int m = 0; m < 4; ++m) _Pragma("unroll") for (int n = 0; n < 2; ++n) _Pragma("unroll") for (int k = 0; k < 2; ++k) \
        acc[ai][bj][m][n] = __builtin_amdgcn_mfma_f32_16x16x32_bf16(Bt[n][k], At[m][k], acc[ai][bj][m][n], 0, 0, 0); __builtin_amdgcn_s_setprio(0); } while (0)
#define PG8_WAIT_V(n) asm volatile("s_waitcnt vmcnt(" #n ")" ::: "memory")
#define PG8_WAIT_L(n) asm volatile("s_waitcnt lgkmcnt(" #n ")" ::: "memory")
#define PG8_BAR __builtin_amdgcn_s_barrier()
#define PG8_SCHED __builtin_amdgcn_sched_barrier(0)
    Unit cur, nxt; int ui = 0;
    if (!S.next(0, cur)) return;
    f32x4 acc[2][2][4][2];
#pragma unroll
    for (int a = 0; a < 2; ++a)
#pragma unroll
        for (int b = 0; b < 2; ++b)
#pragma unroll
            for (int m = 0; m < 4; ++m)
#pragma unroll
                for (int n = 0; n < 2; ++n) acc[a][b][m][n] = (f32x4){0.f, 0.f, 0.f, 0.f};
    bf16x8 At[4][2], B0[2][2], B1[2][2];
    const char* cA = (const char*)g.A + (size_t)cur.pm * tstep; const char* cB = (const char*)g.Bt + (size_t)cur.pn * tstep;
    S.a_ready(cur);
    PG8_STAGE(PG8_SB(0, 0), cB, voffB); PG8_STAGE(PG8_SA(0, 0), cA, voffA); PG8_STAGE(PG8_SB(0, 1), cB + hstep, voffB); PG8_STAGE(PG8_SA(0, 1), cA + hstep, voffA);
    if (wr == 1) PG8_BAR;
    PG8_WAIT_V(4); PG8_BAR;
    PG8_STAGE(PG8_SB(1, 0), cB + kstep, voffB); PG8_STAGE(PG8_SA(1, 0), cA + kstep, voffA); PG8_STAGE(PG8_SB(1, 1), cB + hstep + kstep, voffB);
    PG8_WAIT_V(6); PG8_BAR;
    PG8_STAMP();
    for (;;) {
        const bool has_next = S.next(ui + 1, nxt);
        const char* nA = has_next ? (const char*)g.A + (size_t)nxt.pm * tstep : cA; const char* nB = has_next ? (const char*)g.Bt + (size_t)nxt.pn * tstep : cB;
        for (int t = 0; t < nt; t += 2) {
            const bool last = (t == nt - 2);
            const char* a1 = cA + (size_t)(t + 1) * kstep;
            const char* a2 = last ? nA : cA + (size_t)(t + 2) * kstep; const char* b2 = last ? nB : cB + (size_t)(t + 2) * kstep;
            const char* a3 = a2 + kstep; const char* b3 = b2 + kstep;
            if (last && has_next) S.a_ready(nxt);
            PG8_LDB(B0, 0, 0); PG8_SCHED; PG8_LDA(At, 0, 0); PG8_STAGE(PG8_SA(1, 1), a1 + hstep, voffA);
            PG8_WAIT_L(8); PG8_BAR; PG8_WAIT_L(0); PG8_MMA(0, 0, At, B0); PG8_BAR; PG8_SCHED;
            PG8_LDB(B1, 0, 1); PG8_STAGE(PG8_SB(0, 0), b2, voffB);
            PG8_BAR; PG8_WAIT_L(0); PG8_MMA(0, 1, At, B1); PG8_BAR;
            PG8_LDA(At, 0, 1); PG8_STAGE(PG8_SA(0, 0), a2, voffA);
            PG8_BAR; PG8_WAIT_L(0); PG8_MMA(1, 0, At, B0); PG8_BAR; PG8_SCHED;
            PG8_STAGE(PG8_SB(0, 1), b2 + hstep, voffB);
            PG8_WAIT_V(6); PG8_BAR; PG8_MMA(1, 1, At, B1); PG8_BAR;
            PG8_LDB(B0, 1, 0); PG8_SCHED; PG8_LDA(At, 1, 0); PG8_STAGE(PG8_SA(0, 1), a2 + hstep, voffA);
            PG8_WAIT_L(8); PG8_BAR; PG8_WAIT_L(0); PG8_MMA(0, 0, At, B0); PG8_BAR; PG8_SCHED;
            PG8_LDB(B1, 1, 1); PG8_STAGE(PG8_SB(1, 0), b3, voffB);
            PG8_BAR; PG8_WAIT_L(0); PG8_MMA(0, 1, At, B1); PG8_BAR;
            PG8_LDA(At, 1, 1); PG8_STAGE(PG8_SA(1, 0), a3, voffA);
            PG8_BAR; PG8_WAIT_L(0); PG8_MMA(1, 0, At, B0); PG8_BAR; PG8_SCHED;
            PG8_STAGE(PG8_SB(1, 1), b3 + hstep, voffB);
            PG8_WAIT_V(6); PG8_BAR; PG8_MMA(1, 1, At, B1); PG8_BAR;
        }
        PG8_STAMP();
        if constexpr (!Epi::AFTER_DRAIN) { E(acc, cur, wr, wc, fr, fq); S.done(cur); }
        PG8_STAMP();
        if (!has_next) break;
#pragma unroll
        for (int a = 0; a < 2; ++a)
#pragma unroll
            for (int b = 0; b < 2; ++b)
#pragma unroll
                for (int m = 0; m < 4; ++m)
#pragma unroll
                    for (int n = 0; n < 2; ++n) acc[a][b][m][n] = (f32x4){0.f, 0.f, 0.f, 0.f};
        cur = nxt; cA = nA; cB = nB; ++ui;
    }
    PG8_WAIT_V(0);
    if (wr == 0) PG8_BAR;
    PG8_BAR;
    if constexpr (Epi::AFTER_DRAIN) { E.fused(acc, cur, wr, wc, fr, fq, lds, wid, lane); S.done(cur); }
    PG8_STAMP();
    if (STAMP && wid == 0) { stamps[lane] = lane < nts ? (((unsigned long long)(unsigned)ts_hi << 32) | (unsigned)ts_lo) : 0ull;
        if (lane == 62) stamps[62] = rt_entry; if (lane == 63) stamps[63] = (unsigned long long)wall_clock64(); }
#undef PG8_STAMP
#undef PG8_SA
#undef PG8_SB
#undef PG8_STAGE
#undef PG8_LDA
#undef PG8_LDB
#undef PG8_MMA
#undef PG8_WAIT_V
#undef PG8_WAIT_L
#undef PG8_BAR
#undef PG8_SCHED
}
template <class Epi, class Sched, bool STAMP = false>
__device__ __forceinline__ void gemm_phase_g(PG8_LAS unsigned char* lds, const Gemm g, const Sched& S, const Epi& E, const int* rowtok, unsigned long long* stamps, const int wave0) {
    int tid_l = wave0 * 64 + lane_id_(); asm volatile("" : "+v"(tid_l)); const int tid = tid_l, wid = __builtin_amdgcn_readfirstlane(tid >> 6), lane = tid & 63, wr = wid >> 2, wc = wid & 3, fr = lane & 15, fq = lane >> 4;
    const int K = g.K, nt = K / BK;
    int ts_lo = 0, ts_hi = 0, nts = 0; const unsigned long long rt_entry = STAMP ? (unsigned long long)wall_clock64() : 0ull;
#define PG8_STAMP() do { if (STAMP && wid == 0 && nts < 64) { const unsigned long long _c = (unsigned long long)clock64(); \
        ts_lo = (lane == nts) ? (int)(unsigned)_c : ts_lo; ts_hi = (lane == nts) ? (int)(unsigned)(_c >> 32) : ts_hi; ++nts; } } while (0)
    PG8_STAMP();
    unsigned voffA[2], voffB[2]; int rowA[2]; unsigned colA2[2];
#pragma unroll
    for (int i = 0; i < 2; ++i) { int R, C; stage_rc(tid * 16 + i * 8192, R, C); const int Rb = Epi::PERM ? ((R & ~31) + perm32(R & 31)) : R;
        voffA[i] = (unsigned)(R * K + C) * 2u; voffB[i] = (unsigned)(Rb * K + C) * 2u; rowA[i] = R; colA2[i] = (unsigned)C * 2u; }
    (void)voffA; const unsigned K2 = (unsigned)K * 2u; unsigned gc[2][2], gn[2][2];
    const size_t kstep = (size_t)(BK * 2);
    const size_t hstep = (size_t)HALF * K * 2;
    const size_t tstep = 2 * hstep;
    const unsigned ldsw = (unsigned)wid * 1024u;
    const int aoff = lds_byte(wr * 64 + fr, fq * 8), boff = lds_byte(wc * 32 + fr, fq * 8);
#define PG8_SA(b, h) (((b) * 2 + (h)) * HTB)
#define PG8_SB(b, h) ((4 + (b) * 2 + (h)) * HTB)
#define PG8_STAGE(bufoff, gbase, voff) do { _Pragma("unroll") for (int _i = 0; _i < 2; ++_i) \
        __builtin_amdgcn_global_load_lds((const unsigned*)((const char*)(gbase) + (voff)[_i]), (PG8_LAS unsigned*)(lds + (bufoff) + ldsw + _i * 8192), 16, 0, 0); } while (0)
#define PG8_LDA(dst, b, h) do { _Pragma("unroll") for (int m = 0; m < 4; ++m) _Pragma("unroll") for (int k = 0; k < 2; ++k) dst[m][k] = *(const PG8_LAS bf16x8*)(lds + PG8_SA(b, h) + aoff + m * 2048 + k * 1024); } while (0)
#define PG8_LDB(dst, b, h) do { _Pragma("unroll") for (int n = 0; n < 2; ++n) _Pragma("unroll") for (int k = 0; k < 2; ++k) dst[n][k] = *(const PG8_LAS bf16x8*)(lds + PG8_SB(b, h) + boff + n * 2048 + k * 1024); } while (0)
#define PG8_MMA(ai, bj, At, Bt) do { __builtin_amdgcn_s_setprio(1); _Pragma("unroll") for (int m = 0; m < 4; ++m) _Pragma("unroll") for (int n = 0; n < 2; ++n) _Pragma("unroll") for (int k = 0; k < 2; ++k) \
        acc[ai][bj][m][n] = __builtin_amdgcn_mfma_f32_16x16x32_bf16(Bt[n][k], At[m][k], acc[ai][bj][m][n], 0, 0, 0); __builtin_amdgcn_s_setprio(0); } while (0)
#define PG8_WAIT_V(n) asm volatile("s_waitcnt vmcnt(" #n ")" ::: "memory")
#define PG8_WAIT_L(n) asm volatile("s_waitcnt lgkmcnt(" #n ")" ::: "memory")
#define PG8_BAR __builtin_amdgcn_s_barrier()
#define PG8_SCHED __builtin_amdgcn_sched_barrier(0)
    Unit cur, nxt; int ui = 0;
    if (!S.next(0, cur)) return;
    f32x4 acc[2][2][4][2];
#pragma unroll
    for (int a = 0; a < 2; ++a)
#pragma unroll
        for (int b = 0; b < 2; ++b)
#pragma unroll
            for (int m = 0; m < 4; ++m)
#pragma unroll
                for (int n = 0; n < 2; ++n) acc[a][b][m][n] = (f32x4){0.f, 0.f, 0.f, 0.f};
    bf16x8 At[4][2], B0[2][2], B1[2][2];
    const char* const cA = (const char*)g.A; const char* cB = (const char*)g.Bt + (size_t)cur.pn * tstep;
#pragma unroll
    for (int h = 0; h < 2; ++h)
#pragma unroll
        for (int i = 0; i < 2; ++i) gc[h][i] = (unsigned)rowtok[cur.pm * BM + h * HALF + rowA[i]] * K2 + colA2[i];
    S.a_ready(cur);
    PG8_STAGE(PG8_SB(0, 0), cB, voffB); PG8_STAGE(PG8_SA(0, 0), cA, gc[0]); PG8_STAGE(PG8_SB(0, 1), cB + hstep, voffB); PG8_STAGE(PG8_SA(0, 1), cA, gc[1]);
    if (wr == 1) PG8_BAR;
    PG8_WAIT_V(4); PG8_BAR;
    PG8_STAGE(PG8_SB(1, 0), cB + kstep, voffB); PG8_STAGE(PG8_SA(1, 0), cA + kstep, gc[0]); PG8_STAGE(PG8_SB(1, 1), cB + hstep + kstep, voffB);
    PG8_WAIT_V(6); PG8_BAR;
    PG8_STAMP();
    for (;;) {
        const bool has_next = S.next(ui + 1, nxt);
        const char* nB = has_next ? (const char*)g.Bt + (size_t)nxt.pn * tstep : cB;
#pragma unroll
        for (int h = 0; h < 2; ++h)
#pragma unroll
            for (int i = 0; i < 2; ++i) gn[h][i] = has_next ? (unsigned)rowtok[nxt.pm * BM + h * HALF + rowA[i]] * K2 + colA2[i] : gc[h][i];
        for (int t = 0; t < nt; t += 2) {
            const bool last = (t == nt - 2);
            const char* a1 = cA + (size_t)(t + 1) * kstep;
            const char* a2 = last ? cA : cA + (size_t)(t + 2) * kstep; const char* b2 = last ? nB : cB + (size_t)(t + 2) * kstep;
            const unsigned o20[2] = {last ? gn[0][0] : gc[0][0], last ? gn[0][1] : gc[0][1]}, o21[2] = {last ? gn[1][0] : gc[1][0], last ? gn[1][1] : gc[1][1]};
            const char* a3 = a2 + kstep; const char* b3 = b2 + kstep;
            if (last && has_next) S.a_ready(nxt);
            PG8_LDB(B0, 0, 0); PG8_SCHED; PG8_LDA(At, 0, 0); PG8_STAGE(PG8_SA(1, 1), a1, gc[1]);
            PG8_WAIT_L(8); PG8_BAR; PG8_WAIT_L(0); PG8_MMA(0, 0, At, B0); PG8_BAR; PG8_SCHED;
            PG8_LDB(B1, 0, 1); PG8_STAGE(PG8_SB(0, 0), b2, voffB);
            PG8_BAR; PG8_WAIT_L(0); PG8_MMA(0, 1, At, B1); PG8_BAR;
            PG8_LDA(At, 0, 1); PG8_STAGE(PG8_SA(0, 0), a2, o20);
            PG8_BAR; PG8_WAIT_L(0); PG8_MMA(1, 0, At, B0); PG8_BAR; PG8_SCHED;
            PG8_STAGE(PG8_SB(0, 1), b2 + hstep, voffB);
            PG8_WAIT_V(6); PG8_BAR; PG8_MMA(1, 1, At, B1); PG8_BAR;
            PG8_LDB(B0, 1, 0); PG8_SCHED; PG8_LDA(At, 1, 0); PG8_STAGE(PG8_SA(0, 1), a2, o21);
            PG8_WAIT_L(8); PG8_BAR; PG8_WAIT_L(0); PG8_MMA(0, 0, At, B0); PG8_BAR; PG8_SCHED;
            PG8_LDB(B1, 1, 1); PG8_STAGE(PG8_SB(1, 0), b3, voffB);
            PG8_BAR; PG8_WAIT_L(0); PG8_MMA(0, 1, At, B1); PG8_BAR;
            PG8_LDA(At, 1, 1); PG8_STAGE(PG8_SA(1, 0), a3, o20);
            PG8_BAR; PG8_WAIT_L(0); PG8_MMA(1, 0, At, B0); PG8_BAR; PG8_SCHED;
            PG8_STAGE(PG8_SB(1, 1), b3 + hstep, voffB);
            PG8_WAIT_V(6); PG8_BAR; PG8_MMA(1, 1, At, B1); PG8_BAR;
        }
        PG8_STAMP();
        if constexpr (!Epi::AFTER_DRAIN) { E(acc, cur, wr, wc, fr, fq); S.done(cur); }
        PG8_STAMP();
        if (!has_next) break;
#pragma unroll
        for (int a = 0; a < 2; ++a)
#pragma unroll
            for (int b = 0; b < 2; ++b)
#pragma unroll
                for (int m = 0; m < 4; ++m)
#pragma unroll
                    for (int n = 0; n < 2; ++n) acc[a][b][m][n] = (f32x4){0.f, 0.f, 0.f, 0.f};
        cur = nxt; cB = nB; ++ui;
#pragma unroll
        for (int h = 0; h < 2; ++h)
#pragma unroll
            for (int i = 0; i < 2; ++i) gc[h][i] = gn[h][i];
    }
    PG8_WAIT_V(0);
    if (wr == 0) PG8_BAR;
    PG8_BAR;
    if constexpr (Epi::AFTER_DRAIN) { E.fused(acc, cur, wr, wc, fr, fq, lds, wid, lane); S.done(cur); }
    PG8_STAMP();
    if (STAMP && wid == 0) { stamps[lane] = lane < nts ? (((unsigned long long)(unsigned)ts_hi << 32) | (unsigned)ts_lo) : 0ull;
        if (lane == 62) stamps[62] = rt_entry; if (lane == 63) stamps[63] = (unsigned long long)wall_clock64(); }
#undef PG8_STAMP
#undef PG8_SA
#undef PG8_SB
#undef PG8_STAGE
#undef PG8_LDA
#undef PG8_LDB
#undef PG8_MMA
#undef PG8_WAIT_V
#undef PG8_WAIT_L
#undef PG8_BAR
#undef PG8_SCHED
}
}
typedef pg8::bf16_t bf16_t;
typedef pg8::f32x4 f32x4;
typedef pg8::u32x4 u32x4;
typedef unsigned u32x2 __attribute__((ext_vector_type(2)));

constexpr int D = 1024, NBATCH = 16, SEQ = 2048, NTOK = NBATCH * SEQ, NGRP = 2, GBATCH = NBATCH / NGRP, GTOK = GBATCH * SEQ, NCHUNK = SEQ / 64;
constexpr int NP0 = 7168, NP1 = 8192, KO0 = 2048, KO1 = 3072;
constexpr float EPS = 1e-6f;
constexpr int C_MQ = 0, C_MK = 512, C_MV = 1024, C_MO = 2048, C_GQ = 3072, C_GZ = 6144, C_SM0 = 7168;
constexpr int C_AQ = 0, C_AK = 1024, C_AV = 2048, C_Z = 3072, C_XBC = 5120, C_DT = 8192;
constexpr int MOE_MAXROWS = 73728;
__device__ __forceinline__ size_t pjt(size_t row, int col, int nt) { return (((row >> 8) * nt + (size_t)(col >> 8)) << 16) + (((row >> 6) & 3) << 14) + ((size_t)((col >> 6) & 3) << 12) + ((row & 63) << 6) + (size_t)(col & 63); }
__device__ __forceinline__ size_t pj0(size_t row, int col) { return pjt(row, col, 28); }
__device__ __forceinline__ size_t pj1(size_t row, int col) { return pjt(row, col, 32); }

constexpr size_t MiB = 1ull << 20;
constexpr size_t WS_BAR = 0;
constexpr size_t WS_CNT = 128 * 1024;
constexpr size_t WS_PANEL = 132 * 1024;
constexpr size_t WS_ZERO_BYTES = 160 * 1024;
constexpr size_t WS_ROWTOK = 2 * MiB + 512 * 1024;
constexpr size_t WS_RW = 3 * MiB + 640 * 1024;
constexpr size_t WS_WSM1 = 3 * MiB + 128 * 1024;
constexpr size_t WS_WSM = 3 * MiB + 512 * 1024, WS_SM0 = 348 * MiB, WS_SM1 = 380 * MiB;
constexpr size_t WS_ROUTE_E = 1 * MiB, WS_ROUTE_W = WS_ROUTE_E + 256 * 1024, WS_POS = WS_ROUTE_W + 256 * 1024, WS_WROW = 2 * MiB, WS_GTOT = 3 * MiB;
constexpr size_t WS_WIN = 4 * MiB, WS_WOUT = 21 * MiB;
constexpr size_t WS_XB3 = 92 * MiB;
constexpr size_t WS_XC = 384 * MiB, WS_HN1A = 384 * MiB, WS_HN1B = 480 * MiB;
constexpr size_t WS_AOUT = 28 * MiB, WS_PROJ = 124 * MiB, WS_HN = 388 * MiB, WS_PREP = 356 * MiB;
constexpr size_t WS_H2P = 28 * MiB, WS_ACT = 172 * MiB, WS_YP = 208 * MiB, WS_W1 = 352 * MiB, WS_W2 = 384 * MiB;
constexpr size_t WS_END = 512 * MiB;
constexpr int LDS_BYTES = 163840, LDS_BAR_OFF = LDS_BYTES - 16;

struct Args { const float* in[30]; float* out; unsigned char* ws; int ph_lo, ph_hi, li, pad; };

struct Ctx {
    const float* const* in; float* out; unsigned char* ws; LAS unsigned char* lds;
    int tid, lane, wave, G, bid, wave0;
};

__device__ __forceinline__ float bf2f(bf16_t b) { return __uint_as_float(((unsigned)b) << 16); }
__device__ __forceinline__ bf16_t f2bf(float f) { unsigned u = __float_as_uint(f); u += 0x7fffu + ((u >> 16) & 1u); return (bf16_t)(u >> 16); }
__device__ __forceinline__ unsigned pk2(float lo, float hi) { return (unsigned)f2bf(lo) | ((unsigned)f2bf(hi) << 16); }
template <int CTRL> __device__ __forceinline__ float dpp_(float v) { return __builtin_bit_cast(float, __builtin_amdgcn_update_dpp(0, __builtin_bit_cast(int, v), CTRL, 0xf, 0xf, true)); }
__device__ __forceinline__ float quad_sum(float v) { v += dpp_<0xB1>(v); v += dpp_<0x4E>(v); return v; }
__device__ __forceinline__ float row_sum16(float v) { v = quad_sum(v); v += dpp_<0x124>(v); v += dpp_<0x128>(v); return v; }
__device__ __forceinline__ float rdl_(float v, int l) { return __builtin_bit_cast(float, __builtin_amdgcn_readlane(__builtin_bit_cast(int, v), l)); }
__device__ __forceinline__ float wave_sum(float v) { v = row_sum16(v); return (rdl_(v, 0) + rdl_(v, 16)) + (rdl_(v, 32) + rdl_(v, 48)); }
__device__ __forceinline__ float half_sum(float v, int lane) {
    v = row_sum16(v); const float lo = rdl_(v, 0) + rdl_(v, 16), hi = rdl_(v, 32) + rdl_(v, 48); return (lane & 32) ? hi : lo;
}
__device__ __forceinline__ float frcp_(float x) { return __builtin_amdgcn_rcpf(x); }
__device__ __forceinline__ float sigmoidf_(float x) { return frcp_(1.f + __expf(-x)); }
__device__ __forceinline__ float siluf_(float x) { return x * frcp_(1.f + __expf(-x)); }
__device__ __forceinline__ float softplusf_(float x) { return x > 20.f ? x : log1pf(expf(x)); }
__device__ __forceinline__ int lds_inc(LAS int* p) { return __hip_atomic_fetch_add(p, 1, __ATOMIC_RELAXED, __HIP_MEMORY_SCOPE_WORKGROUP); }
#define LDS_WAIT() asm volatile("s_waitcnt lgkmcnt(0)" ::: "memory")

__device__ __forceinline__ void st8_wt(void* p, u32x2 v) { __hip_atomic_store((unsigned long long*)p, __builtin_bit_cast(unsigned long long, v), __ATOMIC_RELAXED, __HIP_MEMORY_SCOPE_AGENT); }
namespace pg8 {
__device__ __forceinline__ void st16_wt(void* p, u32x4 v) { asm volatile("global_store_dwordx4 %0, %1, off sc1\n\ts_nop 1" :: "v"(p), "v"(v) : "memory"); }
struct EpiBf16P {
    static constexpr bool PERM = true, AFTER_DRAIN = false;
    bf16_t* O; int ldc; int pn_mask;
    __device__ __forceinline__ void operator()(const f32x4 (&acc)[2][2][4][2], const Unit& u, int wr, int wc, int fr, int fq) const {
        const int row0 = u.pm * BM + wr * 64 + fr; const int col0 = (u.pn & pn_mask) * BM + wc * 32 + 8 * fq;
#pragma unroll
        for (int ai = 0; ai < 2; ++ai)
#pragma unroll
            for (int m = 0; m < 4; ++m) { bf16_t* rowp = O + (size_t)(row0 + ai * HALF + m * 16) * ldc + col0;
#pragma unroll
                for (int bj = 0; bj < 2; ++bj) { const f32x4 v0 = acc[ai][bj][m][0], v1 = acc[ai][bj][m][1];
                    u32x4 w; w.x = cvt_pk_bf16(v0[0], v0[1]); w.y = cvt_pk_bf16(v0[2], v0[3]); w.z = cvt_pk_bf16(v1[0], v1[1]); w.w = cvt_pk_bf16(v1[2], v1[3]);
                    *(u32x4*)(rowp + bj * HALF) = w; } }
    }
};
struct EpiBf16QK {
    static constexpr bool PERM = true, AFTER_DRAIN = false;
    bf16_t* O; int ldc; const PG8_LAS float* gn;
    __device__ __forceinline__ void operator()(const f32x4 (&acc)[2][2][4][2], const Unit& u, int wr, int wc, int fr, int fq) const {
        const int row0 = u.pm * BM + wr * 64 + fr;
        if (u.pn < 8) {
            const PG8_LAS float* gp = gn + (u.pn >= 4 ? 64 : 0) + 8 * fq;
            f32x4 gq[2][2];
#pragma unroll
            for (int bj = 0; bj < 2; ++bj)
#pragma unroll
                for (int n = 0; n < 2; ++n) gq[bj][n] = *(const PG8_LAS f32x4*)(gp + bj * 32 + n * 4);
            const int col0 = u.pn * BM + wc * 64 + 8 * fq;
#pragma unroll
            for (int ai = 0; ai < 2; ++ai)
#pragma unroll
                for (int m = 0; m < 4; ++m) { bf16_t* rowp = O + (size_t)(row0 + ai * HALF + m * 16) * ldc + col0;
                    float ss = 0.f;
#pragma unroll
                    for (int bj = 0; bj < 2; ++bj)
#pragma unroll
                        for (int n = 0; n < 2; ++n) { const f32x4 v = acc[ai][bj][m][n]; ss += v[0] * v[0] + v[1] * v[1] + v[2] * v[2] + v[3] * v[3]; }
                    ss += __shfl_xor(ss, 16); ss += __shfl_xor(ss, 32);
                    const float rs = __builtin_amdgcn_rsqf(ss * (1.f / 64.f) + 1e-6f);
#pragma unroll
                    for (int bj = 0; bj < 2; ++bj) { const f32x4 v0 = acc[ai][bj][m][0] * gq[bj][0] * rs, v1 = acc[ai][bj][m][1] * gq[bj][1] * rs;
                        u32x4 w; w.x = cvt_pk_bf16(v0[0], v0[1]); w.y = cvt_pk_bf16(v0[2], v0[3]); w.z = cvt_pk_bf16(v1[0], v1[1]); w.w = cvt_pk_bf16(v1[2], v1[3]);
                        *(u32x4*)(rowp + bj * 32) = w; } }
        } else {
            const int col0 = u.pn * BM + wc * 32 + 8 * fq;
#pragma unroll
            for (int ai = 0; ai < 2; ++ai)
#pragma unroll
                for (int m = 0; m < 4; ++m) { bf16_t* rowp = O + (size_t)(row0 + ai * HALF + m * 16) * ldc + col0;
#pragma unroll
                    for (int bj = 0; bj < 2; ++bj) { const f32x4 v0 = acc[ai][bj][m][0], v1 = acc[ai][bj][m][1];
                        u32x4 w; w.x = cvt_pk_bf16(v0[0], v0[1]); w.y = cvt_pk_bf16(v0[2], v0[3]); w.z = cvt_pk_bf16(v1[0], v1[1]); w.w = cvt_pk_bf16(v1[2], v1[3]);
                        *(u32x4*)(rowp + bj * HALF) = w; } }
        }
    }
};
template <bool QKN> struct EpiBf16QKT {
    static constexpr bool PERM = true, AFTER_DRAIN = false;
    bf16_t* O; int ldc; const PG8_LAS float* gn; PG8_LAS unsigned char* scr;
    __device__ __forceinline__ void operator()(const f32x4 (&acc)[2][2][4][2], const Unit& u, int wr, int wc, int fr, int fq) const {
        PG8_LAS unsigned char* sw = scr + (wr * 4 + wc) * 2304;
        PG8_LAS unsigned char* swr = sw + fr * 144 + fq * 16;
        const int lane = fq * 16 + fr; const PG8_LAS unsigned char* srd = sw + (lane >> 3) * 144 + (lane & 7) * 16;
        bf16_t* orow = O + (((size_t)u.pm * ldc + u.pn) << 16) + (wr * 4 + wc) * 4096 + (lane >> 3) * 64 + (lane & 7) * 8;
        const bool qk = QKN && u.pn < 8;
        f32x4 gq[2][2];
        if (qk) { const PG8_LAS float* gp = gn + (u.pn >= 4 ? 64 : 0) + 8 * fq;
#pragma unroll
            for (int bj = 0; bj < 2; ++bj)
#pragma unroll
                for (int n = 0; n < 2; ++n) gq[bj][n] = *(const PG8_LAS f32x4*)(gp + bj * 32 + n * 4); }
        u32x4 po0, po1;
#pragma unroll
        for (int pc = 0; pc < 8; ++pc) { const int ai = pc >> 2, m = pc & 3;
                float rs = 1.f;
                if (qk) { float ss = 0.f;
#pragma unroll
                    for (int bj = 0; bj < 2; ++bj)
#pragma unroll
                        for (int n = 0; n < 2; ++n) { const f32x4 v = acc[ai][bj][m][n]; ss += v[0] * v[0] + v[1] * v[1] + v[2] * v[2] + v[3] * v[3]; }
                    ss += __shfl_xor(ss, 16); ss += __shfl_xor(ss, 32);
                    rs = __builtin_amdgcn_rsqf(ss * (1.f / 64.f) + 1e-6f); }
#pragma unroll
                for (int bj = 0; bj < 2; ++bj) { f32x4 v0 = acc[ai][bj][m][0], v1 = acc[ai][bj][m][1];
                    if (qk) { v0 = v0 * gq[bj][0] * rs; v1 = v1 * gq[bj][1] * rs; }
                    u32x4 w; w.x = cvt_pk_bf16(v0[0], v0[1]); w.y = cvt_pk_bf16(v0[2], v0[3]); w.z = cvt_pk_bf16(v1[0], v1[1]); w.w = cvt_pk_bf16(v1[2], v1[3]);
                    *(PG8_LAS u32x4*)(swr + bj * 64) = w; }
                const u32x4 o0 = *(const PG8_LAS u32x4*)(srd), o1 = *(const PG8_LAS u32x4*)(srd + 8 * 144);
                if (pc > 0) { const int pa = (pc - 1) >> 2, pm_ = (pc - 1) & 3; st16_wt(orow + pa * 32768 + (pm_ * 16) * 64, po0); st16_wt(orow + pa * 32768 + (pm_ * 16 + 8) * 64, po1); }
                po0 = o0; po1 = o1;
        }
        st16_wt(orow + 32768 + (3 * 16) * 64, po0); st16_wt(orow + 32768 + (3 * 16 + 8) * 64, po1);
    }
};
struct EpiResid {
    static constexpr bool PERM = false, AFTER_DRAIN = false;
    const float* xin; float* out; int ldc;
    __device__ __forceinline__ void operator()(const f32x4 (&acc)[2][2][4][2], const Unit& u, int wr, int wc, int fr, int fq) const {
        const int row0 = u.pm * BM + wr * 64 + fr, col0 = u.pn * BM + wc * 32 + 4 * fq;
#pragma unroll
        for (int ai = 0; ai < 2; ++ai)
#pragma unroll
            for (int m = 0; m < 4; ++m) { const size_t ro = (size_t)(row0 + ai * HALF + m * 16) * ldc + col0;
#pragma unroll
                for (int bj = 0; bj < 2; ++bj)
#pragma unroll
                    for (int n = 0; n < 2; ++n) { const f32x4 r = *(const f32x4*)(xin + ro + bj * HALF + n * 16); *(f32x4*)(out + ro + bj * HALF + n * 16) = r + acc[ai][bj][m][n]; } }
    }
};
template <bool IN_BF16> struct EpiResidB {
    static constexpr bool PERM = true, AFTER_DRAIN = false;
    const void* xin; bf16_t* out; int ldc;
    __device__ __forceinline__ void operator()(const f32x4 (&acc)[2][2][4][2], const Unit& u, int wr, int wc, int fr, int fq) const {
        const int row0 = u.pm * BM + wr * 64 + fr, col0 = u.pn * BM + wc * 32 + 8 * fq;
#pragma unroll
        for (int ai = 0; ai < 2; ++ai)
#pragma unroll
            for (int m = 0; m < 4; ++m) { const size_t ro = (size_t)(row0 + ai * HALF + m * 16) * ldc + col0;
#pragma unroll
                for (int bj = 0; bj < 2; ++bj) { f32x4 r0, r1;
                    if (IN_BF16) { const u32x4 raw = *(const u32x4*)((const bf16_t*)xin + ro + bj * HALF);
                        r0 = (f32x4){__uint_as_float(raw.x << 16), __uint_as_float(raw.x & 0xffff0000u), __uint_as_float(raw.y << 16), __uint_as_float(raw.y & 0xffff0000u)};
                        r1 = (f32x4){__uint_as_float(raw.z << 16), __uint_as_float(raw.z & 0xffff0000u), __uint_as_float(raw.w << 16), __uint_as_float(raw.w & 0xffff0000u)}; }
                    else { r0 = *(const f32x4*)((const float*)xin + ro + bj * HALF); r1 = *(const f32x4*)((const float*)xin + ro + bj * HALF + 4); }
                    r0 = r0 + acc[ai][bj][m][0]; r1 = r1 + acc[ai][bj][m][1];
                    u32x4 w; w.x = cvt_pk_bf16(r0[0], r0[1]); w.y = cvt_pk_bf16(r0[2], r0[3]); w.z = cvt_pk_bf16(r1[0], r1[1]); w.w = cvt_pk_bf16(r1[2], r1[3]);
                    *(u32x4*)(out + ro + bj * HALF) = w; } }
    }
};
struct EpiSwiGLU {
    static constexpr bool PERM = true, AFTER_DRAIN = false;
    bf16_t* O; const float* wrow;
    __device__ __forceinline__ void operator()(const f32x4 (&acc)[2][2][4][2], const Unit& u, int wr, int wc, int fr, int fq) const {
        const int row0 = u.pm * BM + wr * 64 + fr; const int col0 = (u.pn & 1) * HALF + wc * 32 + 8 * fq;
#pragma unroll
        for (int ai = 0; ai < 2; ++ai)
#pragma unroll
            for (int m = 0; m < 4; ++m) { const int row = row0 + ai * HALF + m * 16; const float w = wrow[row];
                float o[8];
#pragma unroll
                for (int n = 0; n < 2; ++n)
#pragma unroll
                    for (int e = 0; e < 4; ++e) { const float g = acc[ai][0][m][n][e], up = acc[ai][1][m][n][e]; o[4 * n + e] = g * __builtin_amdgcn_rcpf(1.f + __expf(-g)) * up * w; }
                u32x4 pk; pk.x = cvt_pk_bf16(o[0], o[1]); pk.y = cvt_pk_bf16(o[2], o[3]); pk.z = cvt_pk_bf16(o[4], o[5]); pk.w = cvt_pk_bf16(o[6], o[7]);
                *(u32x4*)(O + (size_t)row * 256 + col0) = pk; }
    }
};
struct MoeOrder {
    const int* panel_expert; int nunits, G, c, shift;
    __device__ __forceinline__ bool next(int i, Unit& u) const {
        const long L = (long)i * G + c; if (L >= nunits) return false;
        const int p = (int)(L >> shift); const int e = panel_expert[p]; u.pm = p; u.pn = (e << shift) + (int)(L & ((1 << shift) - 1)); return true;
    }
    __device__ __forceinline__ void a_ready(const Unit&) const {}
    __device__ __forceinline__ void done(const Unit&) const {}
};
}

__device__ __forceinline__ void tr_item(const float* __restrict__ W, int ldw, int col0, int K, bf16_t* WT, int drow0, LAS float* scr, int kb, int nb, int lane) {
    const int k0 = 64 * kb, n0 = col0 + 32 * nb;
#pragma unroll
    for (int i = 0; i < 8; ++i) { const int idx = lane + 64 * i; const int kk = idx >> 3, n4 = (idx & 7) * 4;
        const f32x4 v = *(const f32x4*)(W + (size_t)(k0 + kk) * ldw + n0 + n4); LAS float* d = scr + kk * 33 + n4; d[0] = v[0]; d[1] = v[1]; d[2] = v[2]; d[3] = v[3]; }
    LDS_WAIT();
    const int c = lane & 7;
#pragma unroll
    for (int j = 0; j < 4; ++j) { const int n = (lane >> 3) + 8 * j; const LAS float* s = scr + (8 * c) * 33 + n;
        u32x4 o; o.x = pg8::cvt_pk_bf16(s[0 * 33], s[1 * 33]); o.y = pg8::cvt_pk_bf16(s[2 * 33], s[3 * 33]); o.z = pg8::cvt_pk_bf16(s[4 * 33], s[5 * 33]); o.w = pg8::cvt_pk_bf16(s[6 * 33], s[7 * 33]);
        *(u32x4*)(WT + (size_t)(drow0 + n) * K + k0 + 8 * c) = o; }
    LDS_WAIT();
}
__device__ __forceinline__ bool tr_seg(int& r, const float* W, int ldw, int col0, int ncols, int K, bf16_t* WT, int drow0, LAS float* scr, int lane, int qkblocks = 0) {
    const int nblk = ncols / 32, items = (K / 64) * nblk;
    if (r < items) { const int kb = r / nblk, nb = r % nblk;
        int nbd = nb; if (nb < qkblocks) { const int lb = nb & 7; nbd = (nb & ~7) + (lb & 1) * 4 + (lb >> 1); }
        tr_item(W, ldw, col0, K, WT, drow0 + 32 * nbd, scr, kb, nb, lane); return true; }
    r -= items; return false;
}
__device__ __forceinline__ void phase_convert(const Ctx& C, int layer) {
    LAS float* scr = (LAS float*)(C.lds + C.wave * 8448);
    const int gw = C.bid * 8 + C.wave, NGW = C.G * 8;
    bf16_t* Win = (bf16_t*)(C.ws + WS_WIN); bf16_t* Wout = (bf16_t*)(C.ws + WS_WOUT);
    const int IT_IN = (layer == 0) ? (16 * 96 + 16 * 128) : (16 * 256);
    const int IT_OUT = (layer == 0) ? (32 * 32) : (48 * 32);
    const int NITEMS = IT_IN + IT_OUT;
    for (int it = gw; it < NITEMS; it += NGW) {
        int r = it;
        if (layer == 0) {
            if (tr_seg(r, C.in[3], 7192, 0, 3072, 1024, Win, 0, scr, C.lane, 96)) continue;
            if (tr_seg(r, C.in[3], 7192, 3080, 4096, 1024, Win, 3072, scr, C.lane, 128)) continue;
            if (tr_seg(r, C.in[11], 1024, 0, 1024, 2048, Wout, 0, scr, C.lane)) continue;
        } else {
            if (tr_seg(r, C.in[12], 8224, 0, 8192, 1024, Win, 0, scr, C.lane, 256)) continue;
            if (tr_seg(r, C.in[22], 1024, 0, 1024, 3072, Wout, 0, scr, C.lane)) continue;
        }
    }
    if (layer == 0) { float* RW = (float*)(C.ws + WS_RW);
        for (size_t idx = (size_t)C.bid * 512 + C.tid; idx < 2 * 36 * 1024; idx += (size_t)C.G * 512) { const int l = (int)(idx / (36 * 1024)), rem = (int)(idx % (36 * 1024)), cc = rem >> 10, k = rem & 1023;
            RW[idx] = cc < 4 ? C.in[23][(size_t)l * 4096 + k * 4 + cc] : C.in[25][(size_t)l * 32768 + k * 32 + (cc - 4)]; } }
    if (layer == 0) {
        float* WSM0 = (float*)(C.ws + WS_WSM); float* WSM1 = (float*)(C.ws + WS_WSM1);
        const size_t gt = (size_t)C.bid * 512 + C.tid, GT = (size_t)C.G * 512;
        for (size_t idx = gt; idx < 2 * 32 * 1024; idx += GT) {
            const int l = (int)(idx >> 15), rr = (int)((idx >> 10) & 31), k = (int)(idx & 1023); float v = 0.f;
            if (l == 0) { const int sc = rr < 8 ? 3072 + rr : (rr < 24 ? 7176 + (rr - 8) : -1); if (sc >= 0) v = C.in[3][(size_t)k * 7192 + sc]; WSM0[idx & 32767] = v; }
            else { v = C.in[12][(size_t)k * 8224 + 8192 + rr]; WSM1[idx & 32767] = v; }
        }
    }
}
struct TrJob { const float* src; int ldw, K; bf16_t* dst; };
__device__ __forceinline__ TrJob moe_job(int it, const float* wg, const float* wu, const float* wd, bf16_t* W1, bf16_t* W2) {
    const int IT_MOE = 32 * 128; TrJob j; int r = it;
    if (r < 2 * IT_MOE) { const bool up = r >= IT_MOE; if (up) r -= IT_MOE; const int e = r >> 7, q = r & 127, kb = q >> 3, nb = q & 7;
        j.src = (up ? wu : wg) + (size_t)e * 1024 * 256 + (size_t)(64 * kb) * 256 + 32 * nb; j.ldw = 256; j.K = 1024;
        j.dst = W1 + (size_t)(e * 512 + (up ? 128 : 0) + (nb < 4 ? 32 * nb : 256 + 32 * (nb - 4))) * 1024 + 64 * kb; return j; }
    r -= 2 * IT_MOE; { const int e = r >> 7, q = r & 127, kb = q >> 5, nb = q & 31;
        j.src = wd + (size_t)e * 256 * 1024 + (size_t)(64 * kb) * 1024 + 32 * nb; j.ldw = 1024; j.K = 256; j.dst = W2 + (size_t)(e * 1024 + 32 * nb) * 256 + 64 * kb; return j; }
}
__device__ __forceinline__ void phase_convert_moe(const Ctx& C, int layer) {
    LAS float* scr = (LAS float*)(C.lds + C.wave * 8448);
    const int gw = C.bid * 8 + C.wave, NGW = C.G * 8; const int lane = C.lane;
    bf16_t* W1 = (bf16_t*)(C.ws + WS_W1); bf16_t* W2 = (bf16_t*)(C.ws + WS_W2);
    const float* wg = C.in[27] + (size_t)layer * 32 * 1024 * 256; const float* wu = C.in[28] + (size_t)layer * 32 * 1024 * 256; const float* wd = C.in[29] + (size_t)layer * 32 * 256 * 1024;
    const int NIT = 3 * 32 * 128;
    f32x4 nx[8];
#define TR_LOAD(job) do { _Pragma("unroll") for (int i = 0; i < 8; ++i) { const int idx = lane + 64 * i; nx[i] = *(const f32x4*)((job).src + (size_t)(idx >> 3) * (job).ldw + (idx & 7) * 4); } } while (0)
    if (gw < NIT) { const TrJob j0 = moe_job(gw, wg, wu, wd, W1, W2); TR_LOAD(j0); }
    for (int it = gw; it < NIT; it += NGW) {
        const TrJob cur = moe_job(it, wg, wu, wd, W1, W2);
#pragma unroll
        for (int i = 0; i < 8; ++i) { const int idx = lane + 64 * i; LAS float* d = scr + (idx >> 3) * 33 + (idx & 7) * 4; d[0] = nx[i][0]; d[1] = nx[i][1]; d[2] = nx[i][2]; d[3] = nx[i][3]; }
        if (it + NGW < NIT) { const TrJob nj = moe_job(it + NGW, wg, wu, wd, W1, W2); TR_LOAD(nj); }
        LDS_WAIT();
        const int c = lane & 7;
#pragma unroll
        for (int j = 0; j < 4; ++j) { const int n = (lane >> 3) + 8 * j; const LAS float* s = scr + (8 * c) * 33 + n;
            u32x4 o; o.x = pg8::cvt_pk_bf16(s[0 * 33], s[1 * 33]); o.y = pg8::cvt_pk_bf16(s[2 * 33], s[3 * 33]); o.z = pg8::cvt_pk_bf16(s[4 * 33], s[5 * 33]); o.w = pg8::cvt_pk_bf16(s[6 * 33], s[7 * 33]);
            *(u32x4*)(cur.dst + (size_t)n * cur.K + 8 * c) = o; }
        LDS_WAIT();
    }
#undef TR_LOAD
}

constexpr int SP_RS = 2064, SP_IMG = 16 * SP_RS;
struct SmallProjW { pg8::bf16x8 wh[4][2], wl[4][2]; };
__device__ __forceinline__ void smallproj_load(SmallProjW& W, const float* WSM, int wave, int lane) {
#pragma unroll
    for (int kb = 0; kb < 4; ++kb)
#pragma unroll
        for (int nt = 0; nt < 2; ++nt) { const int n = nt * 16 + (lane & 15), k = (4 * wave + kb) * 32 + 8 * (lane >> 4);
            const f32x4 a = *(const f32x4*)(WSM + (size_t)n * 1024 + k), b = *(const f32x4*)(WSM + (size_t)n * 1024 + k + 4);
            u32x4 h, l;
            h.x = pg8::cvt_pk_bf16(a[0], a[1]); h.y = pg8::cvt_pk_bf16(a[2], a[3]); h.z = pg8::cvt_pk_bf16(b[0], b[1]); h.w = pg8::cvt_pk_bf16(b[2], b[3]);
            l.x = pg8::cvt_pk_bf16(a[0] - __uint_as_float(h.x << 16), a[1] - __uint_as_float(h.x & 0xffff0000u)); l.y = pg8::cvt_pk_bf16(a[2] - __uint_as_float(h.y << 16), a[3] - __uint_as_float(h.y & 0xffff0000u));
            l.z = pg8::cvt_pk_bf16(b[0] - __uint_as_float(h.z << 16), b[1] - __uint_as_float(h.z & 0xffff0000u)); l.w = pg8::cvt_pk_bf16(b[2] - __uint_as_float(h.w << 16), b[3] - __uint_as_float(h.w & 0xffff0000u));
            W.wh[kb][nt] = __builtin_bit_cast(pg8::bf16x8, h); W.wl[kb][nt] = __builtin_bit_cast(pg8::bf16x8, l); }
}
__device__ __forceinline__ u32x2 smallproj_put(LAS unsigned char* img, int irow, int lane, int j, const f32x4 v) {
    u32x2 h, l; h.x = pg8::cvt_pk_bf16(v[0], v[1]); h.y = pg8::cvt_pk_bf16(v[2], v[3]);
    l.x = pg8::cvt_pk_bf16(v[0] - __uint_as_float(h.x << 16), v[1] - __uint_as_float(h.x & 0xffff0000u)); l.y = pg8::cvt_pk_bf16(v[2] - __uint_as_float(h.y << 16), v[3] - __uint_as_float(h.y & 0xffff0000u));
    const int ob = irow * SP_RS + (4 * lane + 256 * j) * 2;
    *(LAS u32x2*)(img + ob) = h; *(LAS u32x2*)(img + SP_IMG + ob) = l; return h;
}
__device__ __forceinline__ void smallproj_tile(const SmallProjW& W, LAS unsigned char* img, LAS float* part, float* smt, int wave, int lane, int tid) {
    f32x4 acc[2];
#pragma unroll
    for (int nt = 0; nt < 2; ++nt) acc[nt] = (f32x4){0.f, 0.f, 0.f, 0.f};
#pragma unroll
    for (int kb = 0; kb < 4; ++kb) { const int ob = (lane & 15) * SP_RS + ((4 * wave + kb) * 32 + 8 * (lane >> 4)) * 2;
        const pg8::bf16x8 ah = *(const LAS pg8::bf16x8*)(img + ob), al = *(const LAS pg8::bf16x8*)(img + SP_IMG + ob);
#pragma unroll
        for (int nt = 0; nt < 2; ++nt) { acc[nt] = __builtin_amdgcn_mfma_f32_16x16x32_bf16(ah, W.wh[kb][nt], acc[nt], 0, 0, 0);
            acc[nt] = __builtin_amdgcn_mfma_f32_16x16x32_bf16(al, W.wh[kb][nt], acc[nt], 0, 0, 0); acc[nt] = __builtin_amdgcn_mfma_f32_16x16x32_bf16(ah, W.wl[kb][nt], acc[nt], 0, 0, 0); } }
#pragma unroll
    for (int nt = 0; nt < 2; ++nt)
#pragma unroll
        for (int j = 0; j < 4; ++j) part[(wave * 2 + nt) * 256 + j * 64 + lane] = acc[nt][j];
    __syncthreads();
    { float s = 0.f;
#pragma unroll
      for (int w = 0; w < 8; ++w) s += part[w * 512 + tid];
      const int nt = tid >> 8, j = (tid >> 6) & 3, l = tid & 63; smt[(4 * (l >> 4) + j) * 32 + nt * 16 + (l & 15)] = s; }
}
__device__ __forceinline__ void phase_norm(const Ctx& C, const float* WSM, const float* x, const float* gain, bf16_t* out, float* sm, int nrows, int vb, int nb) {
    LAS unsigned char* img = C.lds; LAS float* part = (LAS float*)(C.lds + 2 * SP_IMG);
    __syncthreads();
    SmallProjW W; smallproj_load(W, WSM, C.wave, C.lane);
    const int lane = C.lane, w2 = 2 * C.wave;
    f32x4 g[4];
#pragma unroll
    for (int j = 0; j < 4; ++j) g[j] = *(const f32x4*)(gain + 4 * lane + 256 * j);
    f32x4 nx[2][4];
    if (vb < nrows / 16) {
#pragma unroll
        for (int i = 0; i < 2; ++i)
#pragma unroll
            for (int j = 0; j < 4; ++j) nx[i][j] = *(const f32x4*)(x + (size_t)(vb * 16 + w2 + i) * D + 4 * lane + 256 * j); }
    for (int tile = vb; tile < nrows / 16; tile += nb) {
        f32x4 cx[2][4];
#pragma unroll
        for (int i = 0; i < 2; ++i)
#pragma unroll
            for (int j = 0; j < 4; ++j) cx[i][j] = nx[i][j];
        if (tile + nb < nrows / 16) {
#pragma unroll
            for (int i = 0; i < 2; ++i)
#pragma unroll
                for (int j = 0; j < 4; ++j) nx[i][j] = *(const f32x4*)(x + (size_t)((tile + nb) * 16 + w2 + i) * D + 4 * lane + 256 * j); }
#pragma unroll
        for (int i = 0; i < 2; ++i) { const size_t r = (size_t)tile * 16 + w2 + i; float ss = 0.f;
#pragma unroll
            for (int j = 0; j < 4; ++j) ss += cx[i][j][0] * cx[i][j][0] + cx[i][j][1] * cx[i][j][1] + cx[i][j][2] * cx[i][j][2] + cx[i][j][3] * cx[i][j][3];
            const float rs = rsqrtf(wave_sum(ss) * (1.f / D) + EPS);
#pragma unroll
            for (int j = 0; j < 4; ++j) { const u32x2 h = smallproj_put(img, w2 + i, lane, j, cx[i][j] * rs * g[j]); st8_wt(out + r * D + 4 * lane + 256 * j, h); } }
        __syncthreads();
        smallproj_tile(W, img, part, sm + (size_t)tile * 16 * 32, C.wave, lane, C.tid);
        __syncthreads();
    }
}

__device__ __forceinline__ float fsig_(float x) { return frcp_(1.f + __expf(-x)); }
__device__ __forceinline__ void phase_gate0(const Ctx& C, const bf16_t* P, bf16_t* AO) {
    const int gw = C.bid * 8 + C.wave, NGW = C.G * 8; const int lane = C.lane;
    f32x4 mn[4]; const f32x4 gn = *(const f32x4*)(C.in[10] + ((4 * lane) & 127));
#pragma unroll
    for (int j = 0; j < 4; ++j) mn[j] = *(const f32x4*)(C.in[6] + 4 * lane + 256 * j);
    u32x2 nr[8], nz[8];
#define G0_LOAD(row) do { const bf16_t* ar_ = AO + (size_t)(row) * KO0 + 4 * lane; const bf16_t* pm_ = P + pj0((size_t)(row), C_MO + 4 * lane); const bf16_t* pg_ = P + pj0((size_t)(row), C_GZ + 4 * lane); \
        _Pragma("unroll") for (int j = 0; j < 4; ++j) { nr[j] = *(const u32x2*)(ar_ + 256 * j); nz[j] = *(const u32x2*)(pm_ + 65536 * j); nr[4 + j] = *(const u32x2*)(ar_ + 1024 + 256 * j); nz[4 + j] = *(const u32x2*)(pg_ + 65536 * j); } } while (0)
    if (gw < GTOK) G0_LOAD(gw);
    for (int r = gw; r < GTOK; r += NGW) {
        u32x2 cr[8], cz[8];
#pragma unroll
        for (int j = 0; j < 8; ++j) { cr[j] = nr[j]; cz[j] = nz[j]; }
        if (r + NGW < GTOK) G0_LOAD(r + NGW);
        bf16_t* ar = AO + (size_t)r * KO0 + 4 * lane;
#pragma unroll
        for (int j = 0; j < 8; ++j) {
            const float v[4] = {__uint_as_float(cr[j].x << 16), __uint_as_float(cr[j].x & 0xffff0000u), __uint_as_float(cr[j].y << 16), __uint_as_float(cr[j].y & 0xffff0000u)};
            const float z[4] = {__uint_as_float(cz[j].x << 16), __uint_as_float(cz[j].x & 0xffff0000u), __uint_as_float(cz[j].y << 16), __uint_as_float(cz[j].y & 0xffff0000u)};
            const float sq = v[0] * v[0] + v[1] * v[1] + v[2] * v[2] + v[3] * v[3];
            float o[4];
            if (j < 4) { const float rstd = rsqrtf(wave_sum(sq) * (1.f / 256.f) + EPS);
#pragma unroll
                for (int e = 0; e < 4; ++e) o[e] = v[e] * rstd * mn[j][e] * fsig_(z[e]); }
            else { const float rstd = rsqrtf(half_sum(sq, C.lane) * (1.f / 128.f) + EPS);
#pragma unroll
                for (int e = 0; e < 4; ++e) o[e] = v[e] * rstd * gn[e] * z[e] * fsig_(z[e]); }
            u32x2 w; w.x = pg8::cvt_pk_bf16(o[0], o[1]); w.y = pg8::cvt_pk_bf16(o[2], o[3]); st8_wt(ar + 256 * j, w); }
    }
#undef G0_LOAD
}
__device__ __forceinline__ void phase_gate1(const Ctx& C, const bf16_t* P, bf16_t* AO) {
    const int gw = C.bid * 8 + C.wave, NGW = C.G * 8; const int lane = C.lane;
    f32x4 sn[8];
#pragma unroll
    for (int j = 0; j < 8; ++j) sn[j] = *(const f32x4*)(C.in[21] + 4 * lane + 256 * j);
    u32x2 nr[8], nz[8];
#define G1_LOAD(row) do { const bf16_t* ar_ = AO + (size_t)(row) * KO1 + 1024 + 4 * lane; const bf16_t* pr_ = P + pj1((size_t)(row), C_Z + 4 * lane); \
        _Pragma("unroll") for (int j = 0; j < 8; ++j) { nr[j] = *(const u32x2*)(ar_ + 256 * j); nz[j] = *(const u32x2*)(pr_ + 65536 * j); } } while (0)
    if (gw < GTOK) G1_LOAD(gw);
    for (int r = gw; r < GTOK; r += NGW) {
        u32x2 cr[8], cz[8];
#pragma unroll
        for (int j = 0; j < 8; ++j) { cr[j] = nr[j]; cz[j] = nz[j]; }
        if (r + NGW < GTOK) G1_LOAD(r + NGW);
        bf16_t* ar = AO + (size_t)r * KO1 + 1024 + 4 * lane;
#pragma unroll
        for (int gq = 0; gq < 4; ++gq) { float y[8]; float ss = 0.f;
#pragma unroll
            for (int jj = 0; jj < 2; ++jj) { const int j = 2 * gq + jj;
                const float v[4] = {__uint_as_float(cr[j].x << 16), __uint_as_float(cr[j].x & 0xffff0000u), __uint_as_float(cr[j].y << 16), __uint_as_float(cr[j].y & 0xffff0000u)};
                const float z[4] = {__uint_as_float(cz[j].x << 16), __uint_as_float(cz[j].x & 0xffff0000u), __uint_as_float(cz[j].y << 16), __uint_as_float(cz[j].y & 0xffff0000u)};
#pragma unroll
                for (int e = 0; e < 4; ++e) { y[4 * jj + e] = v[e] * z[e] * fsig_(z[e]); ss += y[4 * jj + e] * y[4 * jj + e]; } }
            const float rstd = rsqrtf(wave_sum(ss) * (1.f / 512.f) + EPS);
#pragma unroll
            for (int jj = 0; jj < 2; ++jj) { const int j = 2 * gq + jj; u32x2 w;
                w.x = pg8::cvt_pk_bf16(y[4 * jj] * rstd * sn[j][0], y[4 * jj + 1] * rstd * sn[j][1]); w.y = pg8::cvt_pk_bf16(y[4 * jj + 2] * rstd * sn[j][2], y[4 * jj + 3] * rstd * sn[j][3]); st8_wt(ar + 256 * j, w); } }
    }
#undef G1_LOAD
}
__device__ __forceinline__ void phase_r1(const Ctx& C, int layer) {
    constexpr int RS = 2064, IMG = 16 * RS, NTILE = NTOK / 16;
    typedef pg8::bf16x8 bf16x8;
    LAS unsigned char* imgH = C.lds; LAS unsigned char* imgL = C.lds + IMG;
    LAS float* part = (LAS float*)(C.lds + 2 * IMG); LAS float* lg = part + 8 * 768; LAS int* hist = (LAS int*)(lg + 16 * 48);
    const float* bg = C.in[24] + layer * 4; const float* be = C.in[26] + layer * 32; const float* gain = C.in[2] + layer * D;
    __syncthreads();
    if (C.tid < 32) hist[C.tid] = 0;
    bf16x8 wh[4][3], wl[4][3];
    { const float* RW = (const float*)(C.ws + WS_RW) + (size_t)layer * 36 * 1024;
#pragma unroll
        for (int kb = 0; kb < 4; ++kb)
#pragma unroll
            for (int nt = 0; nt < 3; ++nt) { const int n = nt * 16 + (C.lane & 15), k = (4 * C.wave + kb) * 32 + 8 * (C.lane >> 4);
                f32x4 a = {0.f, 0.f, 0.f, 0.f}, b = a; if (n < 36) { a = *(const f32x4*)(RW + (size_t)n * 1024 + k); b = *(const f32x4*)(RW + (size_t)n * 1024 + k + 4); }
                u32x4 h, l;
                h.x = pg8::cvt_pk_bf16(a[0], a[1]); h.y = pg8::cvt_pk_bf16(a[2], a[3]); h.z = pg8::cvt_pk_bf16(b[0], b[1]); h.w = pg8::cvt_pk_bf16(b[2], b[3]);
                l.x = pg8::cvt_pk_bf16(a[0] - __uint_as_float(h.x << 16), a[1] - __uint_as_float(h.x & 0xffff0000u)); l.y = pg8::cvt_pk_bf16(a[2] - __uint_as_float(h.y << 16), a[3] - __uint_as_float(h.y & 0xffff0000u));
                l.z = pg8::cvt_pk_bf16(b[0] - __uint_as_float(h.z << 16), b[1] - __uint_as_float(h.z & 0xffff0000u)); l.w = pg8::cvt_pk_bf16(b[2] - __uint_as_float(h.w << 16), b[3] - __uint_as_float(h.w & 0xffff0000u));
                wh[kb][nt] = __builtin_bit_cast(bf16x8, h); wl[kb][nt] = __builtin_bit_cast(bf16x8, l); } }
    int* route_e = (int*)(C.ws + WS_ROUTE_E); float* route_w = (float*)(C.ws + WS_ROUTE_W); bf16_t* HN2 = (bf16_t*)(C.ws + WS_H2P);
    { int* ROWTOK = (int*)(C.ws + WS_ROWTOK); for (int idx = C.bid * 512 + C.tid; idx < MOE_MAXROWS; idx += C.G * 512) ROWTOK[idx] = 0; }
    f32x4 g[4];
#pragma unroll
    for (int j = 0; j < 4; ++j) g[j] = *(const f32x4*)(gain + 4 * C.lane + 256 * j);
    const bf16_t* XB = (const bf16_t*)C.out; bf16_t* XB3 = (bf16_t*)(C.ws + WS_XB3);
    const int w2 = 2 * C.wave;
    u32x2 nx[2][4];
    if (C.bid < NTILE) {
#pragma unroll
        for (int i = 0; i < 2; ++i)
#pragma unroll
            for (int j = 0; j < 4; ++j) nx[i][j] = *(const u32x2*)(XB + (size_t)(C.bid * 16 + w2 + i) * D + 4 * C.lane + 256 * j); }
    for (int tile = C.bid; tile < NTILE; tile += C.G) {
        const int r0 = tile * 16 + w2;
        u32x2 cx[2][4];
#pragma unroll
        for (int i = 0; i < 2; ++i)
#pragma unroll
            for (int j = 0; j < 4; ++j) cx[i][j] = nx[i][j];
        if (tile + C.G < NTILE) {
#pragma unroll
            for (int i = 0; i < 2; ++i)
#pragma unroll
                for (int j = 0; j < 4; ++j) nx[i][j] = *(const u32x2*)(XB + (size_t)((tile + C.G) * 16 + w2 + i) * D + 4 * C.lane + 256 * j); }
#pragma unroll
        for (int i = 0; i < 2; ++i) { const int r = r0 + i;
            f32x4 v[4]; float ss = 0.f;
#pragma unroll
            for (int j = 0; j < 4; ++j) { v[j] = (f32x4){__uint_as_float(cx[i][j].x << 16), __uint_as_float(cx[i][j].x & 0xffff0000u), __uint_as_float(cx[i][j].y << 16), __uint_as_float(cx[i][j].y & 0xffff0000u)};
                if (layer == 1) st8_wt(XB3 + (size_t)r * D + 4 * C.lane + 256 * j, cx[i][j]);
                ss += v[j][0] * v[j][0] + v[j][1] * v[j][1] + v[j][2] * v[j][2] + v[j][3] * v[j][3]; }
            const float rstd = rsqrtf(wave_sum(ss) * (1.f / D) + EPS);
#pragma unroll
            for (int j = 0; j < 4; ++j) { v[j] = v[j] * rstd * g[j];
                u32x2 h, l; h.x = pg8::cvt_pk_bf16(v[j][0], v[j][1]); h.y = pg8::cvt_pk_bf16(v[j][2], v[j][3]);
                st8_wt(HN2 + (size_t)r * D + 4 * C.lane + 256 * j, h);
                l.x = pg8::cvt_pk_bf16(v[j][0] - __uint_as_float(h.x << 16), v[j][1] - __uint_as_float(h.x & 0xffff0000u)); l.y = pg8::cvt_pk_bf16(v[j][2] - __uint_as_float(h.y << 16), v[j][3] - __uint_as_float(h.y & 0xffff0000u));
                const int ob = (w2 + i) * RS + (4 * C.lane + 256 * j) * 2;
                *(LAS u32x2*)(imgH + ob) = h; *(LAS u32x2*)(imgL + ob) = l; } }
        __syncthreads();
        f32x4 acc[3];
#pragma unroll
        for (int nt = 0; nt < 3; ++nt) acc[nt] = (f32x4){0.f, 0.f, 0.f, 0.f};
#pragma unroll
        for (int kb = 0; kb < 4; ++kb) { const int ob = (C.lane & 15) * RS + ((4 * C.wave + kb) * 32 + 8 * (C.lane >> 4)) * 2;
            const bf16x8 ah = *(const LAS bf16x8*)(imgH + ob), al = *(const LAS bf16x8*)(imgL + ob);
#pragma unroll
            for (int nt = 0; nt < 3; ++nt) { acc[nt] = __builtin_amdgcn_mfma_f32_16x16x32_bf16(ah, wh[kb][nt], acc[nt], 0, 0, 0);
                acc[nt] = __builtin_amdgcn_mfma_f32_16x16x32_bf16(al, wh[kb][nt], acc[nt], 0, 0, 0); acc[nt] = __builtin_amdgcn_mfma_f32_16x16x32_bf16(ah, wl[kb][nt], acc[nt], 0, 0, 0); } }
#pragma unroll
        for (int nt = 0; nt < 3; ++nt)
#pragma unroll
            for (int j = 0; j < 4; ++j) part[(C.wave * 3 + nt) * 256 + j * 64 + C.lane] = acc[nt][j];
        __syncthreads();
        for (int idx = C.tid; idx < 768; idx += 512) { float s = 0.f;
#pragma unroll
            for (int w = 0; w < 8; ++w) s += part[w * 768 + idx];
            const int nt = idx >> 8, j = (idx >> 6) & 3, l = idx & 63; lg[(4 * (l >> 4) + j) * 48 + nt * 16 + (l & 15)] = s; }
        __syncthreads();
        if (C.lane < 2) { const int r = r0 + C.lane; const LAS float* L = lg + (w2 + C.lane) * 48;
            float gl[4];
#pragma unroll
            for (int cc = 0; cc < 4; ++cc) gl[cc] = L[cc] + bg[cc];
            int gi = 0; float gm = gl[0];
#pragma unroll
            for (int cc = 1; cc < 4; ++cc) if (gl[cc] > gm) { gm = gl[cc]; gi = cc; }
            float gsum = 0.f;
#pragma unroll
            for (int cc = 0; cc < 4; ++cc) gsum += expf(gl[cc] - gm);
            const float gwt = 1.f / gsum;
            float el[8];
#pragma unroll
            for (int i = 0; i < 8; ++i) el[i] = L[4 + gi * 8 + i] + be[gi * 8 + i];
            int i0 = 0; float v0 = el[0];
#pragma unroll
            for (int i = 1; i < 8; ++i) if (el[i] > v0) { v0 = el[i]; i0 = i; }
            int i1 = -1; float v1 = -3.0e38f;
#pragma unroll
            for (int i = 0; i < 8; ++i) if (i != i0 && el[i] > v1) { v1 = el[i]; i1 = i; }
            if (i1 < 0) i1 = (i0 + 1) & 7;
            const float e1 = expf(v1 - v0), w0 = 1.f / (1.f + e1), w1 = e1 / (1.f + e1);
            const int ea = gi * 8 + i0, eb = gi * 8 + i1; route_e[2 * r] = ea; route_e[2 * r + 1] = eb; route_w[2 * r] = gwt * w0; route_w[2 * r + 1] = gwt * w1;
            lds_inc(&hist[ea]); lds_inc(&hist[eb]); }
    }
    __syncthreads();
    if (C.tid < 32 && hist[C.tid]) atomicAdd((int*)(C.ws + WS_CNT) + layer * 32 + C.tid, hist[C.tid]);
}
__device__ __forceinline__ void phase_r2(const Ctx& C, int layer) {
    LAS int* seg = (LAS int*)C.lds; LAS int* hist = seg + 40; LAS int* basee = hist + 32;
    const int* counts = (const int*)(C.ws + WS_CNT) + layer * 32; int* cursor = (int*)(C.ws + WS_CNT) + 64 + layer * 32; int* npan = (int*)(C.ws + WS_CNT) + 128 + layer;
    int* panel_expert = (int*)(C.ws + WS_PANEL) + layer * 320;
    const int* route_e = (const int*)(C.ws + WS_ROUTE_E); const float* route_w = (const float*)(C.ws + WS_ROUTE_W); int* POS = (int*)(C.ws + WS_POS); float* WROW = (float*)(C.ws + WS_WROW); int* ROWTOK = (int*)(C.ws + WS_ROWTOK);
    __syncthreads();
    if (C.tid == 0) { int run = 0; for (int e = 0; e < 32; ++e) { seg[e] = run; const int np = (counts[e] + 255) >> 8;
            if (C.bid == 0) for (int p = 0; p < np; ++p) panel_expert[(run >> 8) + p] = e;
            run += np << 8; }
        seg[32] = run; if (C.bid == 0) *npan = run >> 8; }
    for (int base = C.bid * 256; base < NTOK; base += C.G * 256) {
        __syncthreads();
        if (C.tid < 32) hist[C.tid] = 0;
        __syncthreads();
        const int e = route_e[2 * base + C.tid]; const int rank = lds_inc(&hist[e]);
        __syncthreads();
        if (C.tid < 32) basee[C.tid] = hist[C.tid] ? atomicAdd(&cursor[C.tid], hist[C.tid]) : 0;
        __syncthreads();
        const int pos = seg[e] + basee[e] + rank; POS[2 * base + C.tid] = pos; WROW[pos] = route_w[2 * base + C.tid]; ROWTOK[pos] = base + (C.tid >> 1);
    }
}
__device__ __forceinline__ void phase_combine(const Ctx& C) {
    const int* POS = (const int*)(C.ws + WS_POS); const bf16_t* YP = (const bf16_t*)(C.ws + WS_YP); const bf16_t* XB3 = (const bf16_t*)(C.ws + WS_XB3);
    const int gw = C.bid * 8 + C.wave, NGW = C.G * 8; const int lane = C.lane;
    for (int r = gw; r < NTOK; r += 2 * NGW) {
        const int r2 = r + NGW; const bool has2 = r2 < NTOK; const int rb = has2 ? r2 : r;
        const int pa0 = POS[2 * r], pa1 = POS[2 * r + 1], pb0 = POS[2 * rb], pb1 = POS[2 * rb + 1];
        float* xa = C.out + (size_t)r * D + 4 * lane; float* xb = C.out + (size_t)rb * D + 4 * lane;
        u32x2 va[4], vb[4], a0[4], a1[4], b0[4], b1[4];
#pragma unroll
        for (int j = 0; j < 4; ++j) { va[j] = *(const u32x2*)(XB3 + (size_t)r * D + 4 * lane + 256 * j); a0[j] = *(const u32x2*)(YP + (size_t)pa0 * D + 4 * lane + 256 * j); a1[j] = *(const u32x2*)(YP + (size_t)pa1 * D + 4 * lane + 256 * j);
            vb[j] = *(const u32x2*)(XB3 + (size_t)rb * D + 4 * lane + 256 * j); b0[j] = *(const u32x2*)(YP + (size_t)pb0 * D + 4 * lane + 256 * j); b1[j] = *(const u32x2*)(YP + (size_t)pb1 * D + 4 * lane + 256 * j); }
#pragma unroll
        for (int j = 0; j < 4; ++j) { f32x4 v;
            v[0] = __uint_as_float(va[j].x << 16) + __uint_as_float(a0[j].x << 16) + __uint_as_float(a1[j].x << 16); v[1] = __uint_as_float(va[j].x & 0xffff0000u) + __uint_as_float(a0[j].x & 0xffff0000u) + __uint_as_float(a1[j].x & 0xffff0000u);
            v[2] = __uint_as_float(va[j].y << 16) + __uint_as_float(a0[j].y << 16) + __uint_as_float(a1[j].y << 16); v[3] = __uint_as_float(va[j].y & 0xffff0000u) + __uint_as_float(a0[j].y & 0xffff0000u) + __uint_as_float(a1[j].y & 0xffff0000u);
            *(f32x4*)(xa + 256 * j) = v; }
        if (has2) {
#pragma unroll
            for (int j = 0; j < 4; ++j) { f32x4 v;
                v[0] = __uint_as_float(vb[j].x << 16) + __uint_as_float(b0[j].x << 16) + __uint_as_float(b1[j].x << 16); v[1] = __uint_as_float(vb[j].x & 0xffff0000u) + __uint_as_float(b0[j].x & 0xffff0000u) + __uint_as_float(b1[j].x & 0xffff0000u);
                v[2] = __uint_as_float(vb[j].y << 16) + __uint_as_float(b0[j].y << 16) + __uint_as_float(b1[j].y << 16); v[3] = __uint_as_float(vb[j].y & 0xffff0000u) + __uint_as_float(b0[j].y & 0xffff0000u) + __uint_as_float(b1[j].y & 0xffff0000u);
                *(f32x4*)(xb + 256 * j) = v; } }
    }
}

__device__ __forceinline__ void phase_combine_norm(const Ctx& C, const float* WSM, const float* gain, bf16_t* hn0, float* sm0, bf16_t* hn1, float* sm1) {
    LAS unsigned char* img = C.lds; LAS float* part = (LAS float*)(C.lds + 2 * SP_IMG);
    __syncthreads();
    SmallProjW W; smallproj_load(W, WSM, C.wave, C.lane);
    const int* POS = (const int*)(C.ws + WS_POS); const bf16_t* YP = (const bf16_t*)(C.ws + WS_YP);
    const int lane = C.lane, w2 = 2 * C.wave;
    f32x4 g[4];
#pragma unroll
    for (int j = 0; j < 4; ++j) g[j] = *(const f32x4*)(gain + 4 * lane + 256 * j);
    int np[4];
    if (C.bid < NTOK / 16) {
#pragma unroll
        for (int i = 0; i < 4; ++i) np[i] = POS[2 * (C.bid * 16 + w2) + i]; }
    for (int tile = C.bid; tile < NTOK / 16; tile += C.G) {
        int cp[4];
#pragma unroll
        for (int i = 0; i < 4; ++i) cp[i] = np[i];
        if (tile + C.G < NTOK / 16) {
#pragma unroll
            for (int i = 0; i < 4; ++i) np[i] = POS[2 * ((tile + C.G) * 16 + w2) + i]; }
        u32x2 xr[2][4], y0[2][4], y1[2][4];
#pragma unroll
        for (int i = 0; i < 2; ++i) { const size_t r = (size_t)tile * 16 + w2 + i;
#pragma unroll
            for (int j = 0; j < 4; ++j) { xr[i][j] = *(const u32x2*)((const bf16_t*)C.out + r * D + 4 * lane + 256 * j);
                y0[i][j] = *(const u32x2*)(YP + (size_t)cp[2 * i] * D + 4 * lane + 256 * j); y1[i][j] = *(const u32x2*)(YP + (size_t)cp[2 * i + 1] * D + 4 * lane + 256 * j); } }
#pragma unroll
        for (int i = 0; i < 2; ++i) { const size_t r = (size_t)tile * 16 + w2 + i; bf16_t* xo = (bf16_t*)C.out + r * D + 4 * lane;
            f32x4 v[4]; float ss = 0.f;
#pragma unroll
            for (int j = 0; j < 4; ++j) {
                v[j][0] = __uint_as_float(xr[i][j].x << 16) + (__uint_as_float(y0[i][j].x << 16) + __uint_as_float(y1[i][j].x << 16));
                v[j][1] = __uint_as_float(xr[i][j].x & 0xffff0000u) + (__uint_as_float(y0[i][j].x & 0xffff0000u) + __uint_as_float(y1[i][j].x & 0xffff0000u));
                v[j][2] = __uint_as_float(xr[i][j].y << 16) + (__uint_as_float(y0[i][j].y << 16) + __uint_as_float(y1[i][j].y << 16));
                v[j][3] = __uint_as_float(xr[i][j].y & 0xffff0000u) + (__uint_as_float(y0[i][j].y & 0xffff0000u) + __uint_as_float(y1[i][j].y & 0xffff0000u));
                u32x2 w_; w_.x = pg8::cvt_pk_bf16(v[j][0], v[j][1]); w_.y = pg8::cvt_pk_bf16(v[j][2], v[j][3]); st8_wt(xo + 256 * j, w_);
                ss += v[j][0] * v[j][0] + v[j][1] * v[j][1] + v[j][2] * v[j][2] + v[j][3] * v[j][3]; }
            const float rs = rsqrtf(wave_sum(ss) * (1.f / D) + EPS);
            bf16_t* ho = (r < (size_t)GTOK) ? hn0 + r * D : hn1 + (r - GTOK) * D;
#pragma unroll
            for (int j = 0; j < 4; ++j) { const u32x2 h = smallproj_put(img, w2 + i, lane, j, v[j] * rs * g[j]); st8_wt(ho + 4 * lane + 256 * j, h); } }
        __syncthreads();
        { const size_t r0 = (size_t)tile * 16; smallproj_tile(W, img, part, (r0 < (size_t)GTOK) ? sm0 + r0 * 32 : sm1 + (r0 - GTOK) * 32, C.wave, lane, C.tid); }
        __syncthreads();
    }
}
typedef pg8::bf16x8 bf16x8;
typedef short bf16x4 __attribute__((ext_vector_type(4)));
#define MFMA16(a, b, c) __builtin_amdgcn_mfma_f32_16x16x32_bf16(a, b, c, 0, 0, 0)
__device__ __forceinline__ bf16x8 ld_frag(const LAS bf16_t* base, int stride, int row, int kofs) { return *(const LAS bf16x8*)(base + row * stride + kofs); }
__device__ __forceinline__ bf16x8 ld_frag_perm(const LAS bf16_t* base, int stride, int row, int k0, int q) {
    const bf16x4 lo = *(const LAS bf16x4*)(base + row * stride + k0 + 4 * q), hi = *(const LAS bf16x4*)(base + row * stride + k0 + 16 + 4 * q);
    return __builtin_shufflevector(lo, hi, 0, 1, 2, 3, 4, 5, 6, 7);
}
__device__ __forceinline__ bf16x8 pack_frag(const f32x4 lo, const f32x4 hi) {
    u32x4 w; w.x = pg8::cvt_pk_bf16(lo[0], lo[1]); w.y = pg8::cvt_pk_bf16(lo[2], lo[3]); w.z = pg8::cvt_pk_bf16(hi[0], hi[1]); w.w = pg8::cvt_pk_bf16(hi[2], hi[3]);
    return __builtin_bit_cast(bf16x8, w);
}
__device__ __forceinline__ u32x2 pack4(const f32x4 v) { u32x2 w; w.x = pg8::cvt_pk_bf16(v[0], v[1]); w.y = pg8::cvt_pk_bf16(v[2], v[3]); return w; }
__device__ __forceinline__ float wave_incl_sum(float v, int lane) {
#pragma unroll
    for (int o = 1; o < 64; o <<= 1) { const float u = __shfl_up(v, o); if (lane >= o) v += u; }
    return v;
}
__device__ __forceinline__ float wave_incl_max(float v, int lane) {
#pragma unroll
    for (int o = 1; o < 64; o <<= 1) { const float u = __shfl_up(v, o); if (lane >= o) v = fmaxf(v, u); }
    return v;
}
__device__ __forceinline__ float wave_max(float v) {
#pragma unroll
    for (int o = 1; o < 64; o <<= 1) v = fmaxf(v, __shfl_xor(v, o));
    return v;
}
__device__ __forceinline__ bf16x8 ld_frag_tr(const LAS bf16_t* base, int stride, int c0, int k_lo, int k_hi, int r) {
    const LAS bf16_t* p = base + (r >> 2) * stride + c0 + 4 * (r & 3);
    const bf16x4 lo = __builtin_amdgcn_ds_read_tr16_b64_v4i16((LAS bf16x4*)(p + k_lo * stride)), hi = __builtin_amdgcn_ds_read_tr16_b64_v4i16((LAS bf16x4*)(p + k_hi * stride));
    return __builtin_shufflevector(lo, hi, 0, 1, 2, 3, 4, 5, 6, 7);
}
#define LDS_BARRIER() do { asm volatile("s_waitcnt lgkmcnt(0)" ::: "memory"); __builtin_amdgcn_s_barrier(); asm volatile("" ::: "memory"); } while (0)
__device__ __forceinline__ void phase_ssdconv(const Ctx& C, const bf16_t* P, bf16_t* XC) {
    const int gw = C.bid * 8 + C.wave, NGW = C.G * 8; const int lane = C.lane;
    const float* cw = C.in[16]; const float* cb = C.in[17];
    for (int u = gw; u < GBATCH * NCHUNK * 6 * 4; u += NGW) {
        const int slab = u % 6, qq = (u / 6) & 3, cc = (u / 24) & 31, bl = u / (24 * 32); const int ch = slab * 512 + lane * 8;
        float w[4][8], bb[8];
#pragma unroll
        for (int j = 0; j < 4; ++j) { const f32x4 a = *(const f32x4*)(cw + j * 3072 + ch), b = *(const f32x4*)(cw + j * 3072 + ch + 4);
            w[j][0] = a[0]; w[j][1] = a[1]; w[j][2] = a[2]; w[j][3] = a[3]; w[j][4] = b[0]; w[j][5] = b[1]; w[j][6] = b[2]; w[j][7] = b[3]; }
        { const f32x4 a = *(const f32x4*)(cb + ch), b = *(const f32x4*)(cb + ch + 4); bb[0] = a[0]; bb[1] = a[1]; bb[2] = a[2]; bb[3] = a[3]; bb[4] = b[0]; bb[5] = b[1]; bb[6] = b[2]; bb[7] = b[3]; }
        const size_t r0 = (size_t)bl * SEQ + (size_t)cc * 64 + (size_t)qq * 16;
        u32x4 h0 = (u32x4){0u, 0u, 0u, 0u}, h1 = h0, h2 = h0;
        if (cc > 0 || qq > 0) { h0 = *(const u32x4*)(P + pj1(r0 - 3, C_XBC + ch)); h1 = *(const u32x4*)(P + pj1(r0 - 2, C_XBC + ch)); h2 = *(const u32x4*)(P + pj1(r0 - 1, C_XBC + ch)); }
#pragma unroll
        for (int t = 0; t < 16; ++t) { const u32x4 h3 = *(const u32x4*)(P + pj1(r0 + t, C_XBC + ch));
            const unsigned x0[4] = {h0.x, h0.y, h0.z, h0.w}, x1[4] = {h1.x, h1.y, h1.z, h1.w}, x2[4] = {h2.x, h2.y, h2.z, h2.w}, x3[4] = {h3.x, h3.y, h3.z, h3.w};
            float o[8];
#pragma unroll
            for (int i = 0; i < 4; ++i) {
                float a0 = bb[2 * i] + w[0][2 * i] * __uint_as_float(x0[i] << 16) + w[1][2 * i] * __uint_as_float(x1[i] << 16) + w[2][2 * i] * __uint_as_float(x2[i] << 16) + w[3][2 * i] * __uint_as_float(x3[i] << 16);
                float a1 = bb[2 * i + 1] + w[0][2 * i + 1] * __uint_as_float(x0[i] & 0xffff0000u) + w[1][2 * i + 1] * __uint_as_float(x1[i] & 0xffff0000u) + w[2][2 * i + 1] * __uint_as_float(x2[i] & 0xffff0000u) + w[3][2 * i + 1] * __uint_as_float(x3[i] & 0xffff0000u);
                o[2 * i] = a0 * frcp_(1.f + __expf(-a0)); o[2 * i + 1] = a1 * frcp_(1.f + __expf(-a1)); }
            u32x4 pk; pk.x = pg8::cvt_pk_bf16(o[0], o[1]); pk.y = pg8::cvt_pk_bf16(o[2], o[3]); pk.z = pg8::cvt_pk_bf16(o[4], o[5]); pk.w = pg8::cvt_pk_bf16(o[6], o[7]);
            pg8::st16_wt(XC + (r0 + t) * 3072 + ch, pk);
            h0 = h1; h1 = h2; h2 = h3; }
    }
}
__device__ __forceinline__ void ssd_unit(const Ctx& C, const float* SM, const bf16_t* XC, bf16_t* AO, int unit) {
    const int head = unit & 31, bl = unit >> 5, grp = head >> 3;
    LAS bf16_t* Bn = (LAS bf16_t*)C.lds;
    LAS bf16_t* Cn = Bn + 64 * 136;
    LAS bf16_t* Xd = Cn + 64 * 136;
    LAS bf16_t* Xw = Xd + 64 * 72;
    LAS bf16_t* ST = Xw + 64 * 72;
    LAS float* dtL = (LAS float*)(ST + 64 * 136);
    LAS float* acL = dtL + 32 * 64;
    const int tid = C.tid, lane = C.lane, wave = C.wave, q = lane >> 4, r = lane & 15;
    const float A = -expf(C.in[18][head]), dtb = C.in[19][head], Dk = C.in[20][head];
    const int tt = wave & 3, pp = wave >> 2;
    f32x4 accst[4];
#pragma unroll
    for (int i = 0; i < 4; ++i) accst[i] = (f32x4){0.f, 0.f, 0.f, 0.f};
    LDS_BARRIER();
    for (int idx = tid; idx < 64 * 136 / 2; idx += 512) ((LAS unsigned*)ST)[idx] = 0u;
    for (int cc = wave; cc < NCHUNK; cc += 8) { const float dtv = softplusf_(SM[((size_t)bl * SEQ + (size_t)cc * 64 + lane) * 32 + head] + dtb); dtL[cc * 64 + lane] = dtv; acL[cc * 64 + lane] = wave_incl_sum(dtv * A, lane); }
    u32x4 xr, br[2], cr[2];
#define SSD_PREFETCH(cc) do { const size_t rr0 = (size_t)bl * SEQ + (size_t)(cc) * 64; \
        xr = *(const u32x4*)(XC + (rr0 + (tid >> 3)) * 3072 + head * 64 + (tid & 7) * 8); \
        _Pragma("unroll") for (int i = 0; i < 2; ++i) { const int idx = tid + 512 * i; const bf16_t* pr = XC + (rr0 + (idx >> 4)) * 3072 + 2048 + grp * 128 + (idx & 15) * 8; br[i] = *(const u32x4*)pr; cr[i] = *(const u32x4*)(pr + 512); } } while (0)
    SSD_PREFETCH(0);
    for (int c = 0; c < NCHUNK; ++c) {
        const size_t r0 = (size_t)bl * SEQ + (size_t)c * 64;
        LDS_BARRIER();
#pragma unroll
        for (int i = 0; i < 2; ++i) { const int idx = tid + 512 * i; *(LAS u32x4*)(Bn + (idx >> 4) * 136 + (idx & 15) * 8) = br[i]; *(LAS u32x4*)(Cn + (idx >> 4) * 136 + (idx & 15) * 8) = cr[i]; }
        const u32x4 xcur = xr;
        if (c + 1 < NCHUNK) SSD_PREFETCH(c + 1);
        const LAS float* dtc = dtL + c * 64; const LAS float* acc_ = acL + c * 64;
        { const int s = tid >> 3, c8 = tid & 7; const float dtv = dtc[s], de = __expf(acc_[63] - acc_[s]); const unsigned xx[4] = {xcur.x, xcur.y, xcur.z, xcur.w};
          u32x4 pd, pw; unsigned* pdp = (unsigned*)&pd; unsigned* pwp = (unsigned*)&pw;
#pragma unroll
          for (int i = 0; i < 4; ++i) { const float a = __uint_as_float(xx[i] << 16) * dtv, b = __uint_as_float(xx[i] & 0xffff0000u) * dtv; pdp[i] = pg8::cvt_pk_bf16(a, b); pwp[i] = pg8::cvt_pk_bf16(a * de, b * de); }
          *(LAS u32x4*)(Xd + s * 72 + c8 * 8) = pd; *(LAS u32x4*)(Xw + s * 72 + c8 * 8) = pw; }
        LDS_BARRIER();
        const int t = 16 * tt + r;
        f32x4 accy[2], accs[4];
#pragma unroll
        for (int i = 0; i < 2; ++i) accy[i] = (f32x4){0.f, 0.f, 0.f, 0.f};
#pragma unroll
        for (int i = 0; i < 4; ++i) accs[i] = (f32x4){0.f, 0.f, 0.f, 0.f};
#pragma unroll
        for (int kh = 0; kh < 2; ++kh) { bf16x8 fC[2], fS[2][2], fB[4][2];
#pragma unroll
          for (int k2 = 0; k2 < 2; ++k2) { const int ks = 2 * kh + k2; fC[k2] = ld_frag(Cn, 136, t, 32 * ks + 8 * q);
#pragma unroll
              for (int i = 0; i < 2; ++i) fS[i][k2] = ld_frag(ST, 136, 16 * (2 * pp + i) + r, 32 * ks + 8 * q);
#pragma unroll
              for (int mi = 0; mi < 4; ++mi) fB[mi][k2] = ld_frag(Bn, 136, 16 * mi + r, 32 * ks + 8 * q); }
          __builtin_amdgcn_sched_barrier(0);
#pragma unroll
          for (int k2 = 0; k2 < 2; ++k2) {
#pragma unroll
              for (int i = 0; i < 2; ++i) accy[i] = MFMA16(fS[i][k2], fC[k2], accy[i]);
#pragma unroll
              for (int mi = 0; mi < 4; ++mi) accs[mi] = MFMA16(fB[mi][k2], fC[k2], accs[mi]); } }
        const float ac_t = acc_[t], ea_t = __expf(ac_t), dinv_t = Dk * frcp_(dtc[t]);
#pragma unroll
        for (int i = 0; i < 2; ++i) accy[i] = accy[i] * ea_t;
#pragma unroll
        for (int mi = 0; mi < 4; ++mi) { const f32x4 acs = *(const LAS f32x4*)(acc_ + 16 * mi + 4 * q);
#pragma unroll
            for (int jj = 0; jj < 4; ++jj) { const int s = 16 * mi + 4 * q + jj; float dec = __expf(fminf(ac_t - acs[jj], 0.f)); asm volatile("" : "+v"(dec));
                float m = accs[mi][jj] * dec; m = (s <= t) ? m : 0.f; m = (s == t) ? m + dinv_t : m; accs[mi][jj] = m; } }
        bf16x8 fX[2][2], fBT[2], fXW[4][2];
#pragma unroll
        for (int ks2 = 0; ks2 < 2; ++ks2) {
#pragma unroll
            for (int i = 0; i < 2; ++i) fX[i][ks2] = ld_frag_tr(Xd, 72, 16 * (2 * pp + i), 32 * ks2 + 4 * q, 32 * ks2 + 16 + 4 * q, r);
            fBT[ks2] = ld_frag_tr(Bn, 136, 16 * wave, 32 * ks2 + 8 * q, 32 * ks2 + 8 * q + 4, r);
#pragma unroll
            for (int pt = 0; pt < 4; ++pt) fXW[pt][ks2] = ld_frag_tr(Xw, 72, 16 * pt, 32 * ks2 + 8 * q, 32 * ks2 + 8 * q + 4, r); }
        __builtin_amdgcn_sched_barrier(0);
#pragma unroll
        for (int ks2 = 0; ks2 < 2; ++ks2) { const bf16x8 bM = pack_frag(accs[2 * ks2], accs[2 * ks2 + 1]);
#pragma unroll
            for (int i = 0; i < 2; ++i) accy[i] = MFMA16(fX[i][ks2], bM, accy[i]); }
#pragma unroll
        for (int i = 0; i < 2; ++i) *(u32x2*)(AO + (r0 + t) * KO1 + 1024 + head * 64 + 16 * (2 * pp + i) + 4 * q) = pack4(accy[i]);
        const float gdec = __expf(acc_[63]);
#pragma unroll
        for (int pt = 0; pt < 4; ++pt) accst[pt] = accst[pt] * gdec;
#pragma unroll
        for (int ks = 0; ks < 2; ++ks) {
#pragma unroll
            for (int pt = 0; pt < 4; ++pt) accst[pt] = MFMA16(fBT[ks], fXW[pt][ks], accst[pt]); }
        LDS_BARRIER();
#pragma unroll
        for (int pt = 0; pt < 4; ++pt) *(LAS u32x2*)(ST + (16 * pt + r) * 136 + 16 * wave + 4 * q) = pack4(accst[pt]);
    }
#undef SSD_PREFETCH
}
__device__ __forceinline__ float logsigmoidf_(float x) { return fminf(x, 0.f) - log1pf(__expf(-fabsf(x))); }
__device__ __forceinline__ void mlstm_unit(const Ctx& C, const bf16_t* P, const float* SM, bf16_t* AO, int unit) {
    const int vs = unit & 3, h = (unit >> 2) & 3, bl = unit >> 4;
    LAS bf16_t* Qn = (LAS bf16_t*)C.lds;
    LAS bf16_t* Kn = Qn + 64 * 136;
    LAS bf16_t* Vn = Kn + 64 * 136;
    LAS bf16_t* VW = Vn + 64 * 88;
    LAS bf16_t* CT = VW + 64 * 88;
    LAS float* bcL = (LAS float*)(CT + 80 * 136);
    LAS float* lbL = bcL + 2048; LAS float* dmL = lbL + 2048; LAS float* weL = dmL + 2048;
    LAS float* scL = weL + 2048;
    const int tid = C.tid, lane = C.lane, wave = C.wave, q = lane >> 4, r = lane & 15;
    const float ib = C.in[4][h], fb = C.in[5][h]; const float scale = 0.08838834764831845f;
    const int tt = wave & 3, vg = wave >> 2;
    f32x4 accc[5];
#pragma unroll
    for (int i = 0; i < 5; ++i) accc[i] = (f32x4){0.f, 0.f, 0.f, 0.f};
    LDS_BARRIER();
    for (int idx = tid; idx < 80 * 136 / 2; idx += 512) ((LAS unsigned*)CT)[idx] = 0u;
    for (int idx = tid; idx < 64 * 8; idx += 512) { const int s_ = idx >> 3, cc = idx & 7; *(LAS unsigned*)(Vn + s_ * 88 + 64 + 2 * cc) = cc == 0 ? 0x00003f80u : 0u; *(LAS unsigned*)(VW + s_ * 88 + 64 + 2 * cc) = 0u; }
    for (int cc = wave; cc < NCHUNK; cc += 8) { const float* pr = SM + ((size_t)bl * SEQ + (size_t)cc * 64 + lane) * 32; const float li = pr[h] + ib, lf = logsigmoidf_(pr[4 + h] + fb);
        const float bcum = wave_incl_sum(lf, lane), b_end = __shfl(bcum, 63), g_end = b_end - bcum + li, m_loc = wave_max(g_end), lb = li - bcum;
        bcL[cc * 64 + lane] = bcum; lbL[cc * 64 + lane] = lb; dmL[cc * 64 + lane] = wave_incl_max(lb, lane); weL[cc * 64 + lane] = __expf(g_end - m_loc);
        if (lane == 0) { scL[cc] = b_end; scL[32 + cc] = m_loc; } }
    LDS_BARRIER();
    if (tid == 0) { float m_st = 0.f; for (int cc = 0; cc < NCHUNK; ++cc) { const float be = scL[cc], ml = scL[32 + cc], m_new = fmaxf(be + m_st, ml);
            scL[64 + cc] = m_st; scL[96 + cc] = __expf(be + m_st - m_new); scL[128 + cc] = __expf(ml - m_new); m_st = m_new; } }
    u32x4 vreg, qreg[2], kreg[2];
#define MLSTM_PREFETCH(cc) do { const size_t rr0 = (size_t)bl * SEQ + (size_t)(cc) * 64; \
        vreg = *(const u32x4*)(P + pj0(rr0 + (tid >> 3), C_MV + h * 256 + vs * 64 + (tid & 7) * 8)); \
        _Pragma("unroll") for (int it = 0; it < 2; ++it) { const int idx = tid + 512 * it; const size_t rw = rr0 + (idx >> 4); const int cq = h * 128 + (idx & 15) * 8; qreg[it] = *(const u32x4*)(P + pj0(rw, C_MQ + cq)); kreg[it] = *(const u32x4*)(P + pj0(rw, C_MK + cq)); } } while (0)
    MLSTM_PREFETCH(0);
    for (int c = 0; c < NCHUNK; ++c) {
        const size_t r0 = (size_t)bl * SEQ + (size_t)c * 64;
        LDS_BARRIER();
#pragma unroll
        for (int it = 0; it < 2; ++it) { const int idx = tid + 512 * it; *(LAS u32x4*)(Qn + (idx >> 4) * 136 + (idx & 15) * 8) = qreg[it]; *(LAS u32x4*)(Kn + (idx >> 4) * 136 + (idx & 15) * 8) = kreg[it]; }
        const u32x4 vv = vreg;
        *(LAS u32x4*)(Vn + (tid >> 3) * 88 + (tid & 7) * 8) = vv;
        if (c + 1 < NCHUNK) MLSTM_PREFETCH(c + 1);
        const float s_upd = scL[128 + c], s_old = scL[96 + c], m_prev = scL[64 + c];
        { const int s_ = tid >> 3; const float w = weL[c * 64 + s_] * s_upd; const unsigned w4[4] = {vv.x, vv.y, vv.z, vv.w}; u32x4 pw; unsigned* pwp = (unsigned*)&pw;
#pragma unroll
          for (int i = 0; i < 4; ++i) pwp[i] = pg8::cvt_pk_bf16(__uint_as_float(w4[i] << 16) * w, __uint_as_float(w4[i] & 0xffff0000u) * w);
          *(LAS u32x4*)(VW + s_ * 88 + (tid & 7) * 8) = pw;
          if (tid < 64) VW[tid * 88 + 64] = f2bf(weL[c * 64 + tid] * s_upd); }
        LDS_BARRIER();
        const int t = 16 * tt + r;
        f32x4 accn[3], accs[4];
#pragma unroll
        for (int i = 0; i < 3; ++i) accn[i] = (f32x4){0.f, 0.f, 0.f, 0.f};
#pragma unroll
        for (int i = 0; i < 4; ++i) accs[i] = (f32x4){0.f, 0.f, 0.f, 0.f};
#pragma unroll
        for (int ks = 0; ks < 4; ++ks) { const bf16x8 bQ = ld_frag(Qn, 136, t, 32 * ks + 8 * q);
#pragma unroll
            for (int i = 0; i < 3; ++i) accn[i] = MFMA16(ld_frag(CT, 136, 16 * (i < 2 ? 2 * vg + i : 4) + r, 32 * ks + 8 * q), bQ, accn[i]);
#pragma unroll
            for (int mi = 0; mi < 4; ++mi) accs[mi] = MFMA16(ld_frag(Kn, 136, 16 * mi + r, 32 * ks + 8 * q), bQ, accs[mi]); }
        const float bc_t = bcL[c * 64 + t], m_t = bc_t + fmaxf(m_prev, dmL[c * 64 + t]), winter = __expf(bc_t + m_prev - m_t) * scale, bt = bc_t - m_t;
#pragma unroll
        for (int i = 0; i < 3; ++i) accn[i] = accn[i] * winter;
#pragma unroll
        for (int mi = 0; mi < 4; ++mi) { const f32x4 lbs = *(const LAS f32x4*)(lbL + c * 64 + 16 * mi + 4 * q);
#pragma unroll
            for (int jj = 0; jj < 4; ++jj) { const int s = 16 * mi + 4 * q + jj; float wgt = __expf(fminf(bt + lbs[jj], 0.f)) * scale; asm volatile("" : "+v"(wgt)); const float m = accs[mi][jj] * wgt; accs[mi][jj] = (s <= t) ? m : 0.f; } }
#pragma unroll
        for (int ks2 = 0; ks2 < 2; ++ks2) { const bf16x8 bP = pack_frag(accs[2 * ks2], accs[2 * ks2 + 1]);
#pragma unroll
            for (int i = 0; i < 3; ++i) accn[i] = MFMA16(ld_frag_tr(Vn, 88, 16 * (i < 2 ? 2 * vg + i : 4), 32 * ks2 + 4 * q, 32 * ks2 + 16 + 4 * q, r), bP, accn[i]); }
        const float den = __shfl(accn[2][0], r); const float inv = frcp_(fmaxf(fabsf(den), __expf(-m_t)));
#pragma unroll
        for (int i = 0; i < 2; ++i) *(u32x2*)(AO + (r0 + t) * KO0 + h * 256 + vs * 64 + 16 * (2 * vg + i) + 4 * q) = pack4(accn[i] * inv);
#pragma unroll
        for (int vt = 0; vt < 5; ++vt) accc[vt] = accc[vt] * s_old;
#pragma unroll
        for (int ks = 0; ks < 2; ++ks) { const bf16x8 aK = ld_frag_tr(Kn, 136, 16 * wave, 32 * ks + 8 * q, 32 * ks + 8 * q + 4, r);
#pragma unroll
            for (int vt = 0; vt < 5; ++vt) accc[vt] = MFMA16(aK, ld_frag_tr(VW, 88, 16 * vt, 32 * ks + 8 * q, 32 * ks + 8 * q + 4, r), accc[vt]); }
        LDS_BARRIER();
#pragma unroll
        for (int vt = 0; vt < 5; ++vt) *(LAS u32x2*)(CT + (16 * vt + r) * 136 + 16 * wave + 4 * q) = pack4(accc[vt]);
    }
#undef MLSTM_PREFETCH
}
constexpr size_t PREP_UNIT_BYTES = 73728;
__device__ __forceinline__ void gdn_prep_phase(const Ctx& C, const bf16_t* P, const float* SM, unsigned char* prep, float* gtot) {
    LAS bf16_t* RAW = (LAS bf16_t*)C.lds;
    LAS float* Am = (LAS float*)C.lds;
    LAS float* Tf = Am + 64 * 65;
    LAS bf16_t* Tn = (LAS bf16_t*)(Tf + 64 * 65);
    LAS float* Ys = (LAS float*)(Tn + 64 * 72);
    LAS bf16_t* Kn = (LAS bf16_t*)(C.lds + 51456);
    LAS bf16_t* Qn = Kn + 64 * 136;
    LAS bf16_t* RK = Qn + 64 * 136;
    LAS bf16_t* RV = RK + 64 * 136;
    LAS float* fs = (LAS float*)(RV + 64 * 136);
    LAS float* cwl = fs + 256;
    const int tid = C.tid, lane = C.lane, wave = C.wave, q = lane >> 4, r = lane & 15;
    const float* cw = C.in[7];
    u32x4 rawreg[7]; float gareg = 0.f, gbreg = 0.f;
#define PREP_PREFETCH(uu) do { const int h_ = (uu) & 7, c_ = ((uu) >> 3) & 31, bl_ = (uu) >> 8; const size_t rr0 = (size_t)bl_ * SEQ + (size_t)c_ * 64; \
        _Pragma("unroll") for (int i = 0; i < 7; ++i) { const int idx = tid + 512 * i; const int rr = idx / 48, vv = idx - rr * 48; const int ts = c_ * 64 + rr - 3; \
            const int col = C_GQ + (vv >> 4) * 1024 + h_ * 128 + (vv & 15) * 8; rawreg[i] = (u32x4){0u, 0u, 0u, 0u}; \
            if (idx < 67 * 48 && ts >= 0) rawreg[i] = *(const u32x4*)(P + pj0(rr0 + rr - 3, col)); } \
        if (tid < 64) { const float* pr = SM + (rr0 + tid) * 32; gareg = pr[8 + h_]; gbreg = pr[16 + h_]; } } while (0)
    int h_loaded = -1;
    if (C.bid < 2048) PREP_PREFETCH(C.bid);
    for (int pu = C.bid; pu < 2048; pu += C.G) {
    const int h = pu & 7, c = (pu >> 3) & 31, bl = pu >> 8;
    const float na = -expf(C.in[8][h]), dtb = C.in[9][h];
    const size_t r0 = (size_t)bl * SEQ + (size_t)c * 64;
    bf16_t* gW = (bf16_t*)(prep + (size_t)pu * PREP_UNIT_BYTES); bf16_t* gQD = gW + 8192; bf16_t* gUT = gW + 16384; bf16_t* gKD = gW + 24576; bf16_t* gQK = gW + 32768;
    LDS_BARRIER();
#pragma unroll
    for (int i = 0; i < 7; ++i) { const int idx = tid + 512 * i; if (idx < 67 * 48) *(LAS u32x4*)(RAW + idx * 8) = rawreg[i]; }
    if (tid < 64) { const float g = na * softplusf_(gareg + dtb); const float gc = wave_incl_sum(g, lane), gl = __shfl(gc, 63);
        fs[tid] = gc; fs[64 + tid] = sigmoidf_(gbreg); fs[128 + tid] = __expf(gc); fs[192 + tid] = __expf(gl - gc);
        if (tid == 63) gtot[pu] = __expf(gc); }
    if (h != h_loaded) { for (int idx = tid; idx < 4 * 384; idx += 512) { const int j = idx / 384, cc = idx - j * 384; cwl[idx] = cw[j * 3072 + (cc >> 7) * 1024 + h * 128 + (cc & 127)]; } h_loaded = h; }
    if (pu + C.G < 2048) PREP_PREFETCH(pu + C.G);
    LDS_BARRIER();
#pragma unroll 1
    for (int it = 0; it < 6; ++it) { const int which = it >> 1; const int item = (tid + 512 * it) & 1023; const int t = item >> 4, c8 = item & 15;
        float a[8];
#pragma unroll
        for (int e = 0; e < 8; ++e) a[e] = 0.f;
#pragma unroll
        for (int j = 0; j < 4; ++j) { const u32x4 rv = *(const LAS u32x4*)(RAW + (t + j) * 384 + which * 128 + c8 * 8);
            const f32x4 w0 = *(const LAS f32x4*)(cwl + j * 384 + which * 128 + c8 * 8), w1 = *(const LAS f32x4*)(cwl + j * 384 + which * 128 + c8 * 8 + 4);
            a[0] += w0[0] * __uint_as_float(rv.x << 16); a[1] += w0[1] * __uint_as_float(rv.x & 0xffff0000u); a[2] += w0[2] * __uint_as_float(rv.y << 16); a[3] += w0[3] * __uint_as_float(rv.y & 0xffff0000u);
            a[4] += w1[0] * __uint_as_float(rv.z << 16); a[5] += w1[1] * __uint_as_float(rv.z & 0xffff0000u); a[6] += w1[2] * __uint_as_float(rv.w << 16); a[7] += w1[3] * __uint_as_float(rv.w & 0xffff0000u); }
        float ss = 0.f;
#pragma unroll
        for (int e = 0; e < 8; ++e) { a[e] = a[e] * frcp_(1.f + __expf(-a[e])); ss += a[e] * a[e]; }
        const float beta = fs[64 + t], egc = fs[128 + t], ekd = fs[192 + t];
        if (which < 2) {
            ss = row_sum16(ss);
            const float rs = rsqrtf(ss + EPS) * (which == 0 ? 0.08838834764831845f : 1.f);
#pragma unroll
            for (int e = 0; e < 8; ++e) a[e] *= rs;
            u32x4 pk; pk.x = pg8::cvt_pk_bf16(a[0], a[1]); pk.y = pg8::cvt_pk_bf16(a[2], a[3]); pk.z = pg8::cvt_pk_bf16(a[4], a[5]); pk.w = pg8::cvt_pk_bf16(a[6], a[7]);
            if (which == 0) { *(LAS u32x4*)(Qn + t * 136 + c8 * 8) = pk;
                u32x4 pd; pd.x = pg8::cvt_pk_bf16(a[0] * egc, a[1] * egc); pd.y = pg8::cvt_pk_bf16(a[2] * egc, a[3] * egc); pd.z = pg8::cvt_pk_bf16(a[4] * egc, a[5] * egc); pd.w = pg8::cvt_pk_bf16(a[6] * egc, a[7] * egc);
                *(u32x4*)(gQD + t * 128 + c8 * 8) = pd; }
            else { *(LAS u32x4*)(Kn + t * 136 + c8 * 8) = pk; const float bk = beta * egc;
                u32x4 p1, p2; unsigned* p1p = (unsigned*)&p1; unsigned* p2p = (unsigned*)&p2;
#pragma unroll
                for (int e = 0; e < 4; ++e) { p1p[e] = pg8::cvt_pk_bf16(a[2 * e] * bk, a[2 * e + 1] * bk); p2p[e] = pg8::cvt_pk_bf16(a[2 * e] * ekd, a[2 * e + 1] * ekd); }
                *(LAS u32x4*)(RK + t * 136 + c8 * 8) = p1; *(u32x4*)(gKD + t * 128 + c8 * 8) = p2; }
        } else {
            u32x4 p1; unsigned* p1p = (unsigned*)&p1;
#pragma unroll
            for (int e = 0; e < 4; ++e) p1p[e] = pg8::cvt_pk_bf16(a[2 * e] * beta, a[2 * e + 1] * beta);
            *(LAS u32x4*)(RV + t * 136 + c8 * 8) = p1;
        }
    }
    LDS_BARRIER();
    for (int idx = tid; idx < 64 * 65; idx += 512) Tf[idx] = 0.f;
    { const int jt = wave & 3, ih = wave >> 2;
      f32x4 akk[2], aqk[2];
#pragma unroll
      for (int i = 0; i < 2; ++i) { akk[i] = (f32x4){0.f, 0.f, 0.f, 0.f}; aqk[i] = (f32x4){0.f, 0.f, 0.f, 0.f}; }
#pragma unroll
      for (int ks = 0; ks < 4; ++ks) { const bf16x8 bK = ld_frag(Kn, 136, 16 * jt + r, 32 * ks + 8 * q), bQ = ld_frag(Qn, 136, 16 * jt + r, 32 * ks + 8 * q);
#pragma unroll
          for (int i = 0; i < 2; ++i) { const bf16x8 aK = ld_frag(Kn, 136, 16 * (2 * ih + i) + r, 32 * ks + 8 * q); akk[i] = MFMA16(aK, bK, akk[i]); aqk[i] = MFMA16(aK, bQ, aqk[i]); } }
      const int j = 16 * jt + r; const float gcj = fs[j];
#pragma unroll
      for (int i = 0; i < 2; ++i) { f32x4 qkv;
#pragma unroll
          for (int jj = 0; jj < 4; ++jj) { const int ii = 16 * (2 * ih + i) + 4 * q + jj; const float gci = fs[ii];
              float e1 = __expf(fminf(gci - gcj, 0.f)), e2 = __expf(fminf(gcj - gci, 0.f)); asm volatile("" : "+v"(e1), "+v"(e2));
              const float av = fs[64 + ii] * akk[i][jj] * e1, qv = aqk[i][jj] * e2;
              Am[ii * 65 + j] = (ii > j) ? av : 0.f;
              qkv[jj] = (ii <= j) ? qv : 0.f; }
          *(u32x2*)(gQK + j * 64 + 16 * (2 * ih + i) + 4 * q) = pack4(qkv); } }
    LDS_BARRIER();
    if (tid < 64) { const int b = tid >> 4, j = tid & 15; float x[16];
#pragma unroll
        for (int i = 0; i < 16; ++i) { float s = (i == j) ? 1.f : 0.f;
#pragma unroll
            for (int m = 0; m < i; ++m) s -= Am[(16 * b + i) * 65 + 16 * b + m] * x[m];
            x[i] = s; Tf[(16 * b + i) * 65 + 16 * b + j] = s; } }
    LDS_BARRIER();
    { const int pr = tid >> 8, i = (tid >> 4) & 15, j = tid & 15; const int hi = 2 * pr + 1, lo = 2 * pr; float s = 0.f;
#pragma unroll
      for (int m = 0; m < 16; ++m) s += Am[(16 * hi + i) * 65 + 16 * lo + m] * Tf[(16 * lo + m) * 65 + 16 * lo + j];
      Ys[pr * 16 * 17 + i * 17 + j] = s; }
    LDS_BARRIER();
    { const int pr = tid >> 8, i = (tid >> 4) & 15, j = tid & 15; const int hi = 2 * pr + 1, lo = 2 * pr; float s = 0.f;
#pragma unroll
      for (int m = 0; m < 16; ++m) s -= Tf[(16 * hi + i) * 65 + 16 * hi + m] * Ys[pr * 16 * 17 + m * 17 + j];
      Tf[(16 * hi + i) * 65 + 16 * lo + j] = s; }
    LDS_BARRIER();
    float y2[2];
#pragma unroll
    for (int e = 0; e < 2; ++e) { const int o = tid + 512 * e, i = o >> 5, j = o & 31; float s = 0.f;
#pragma unroll 8
        for (int m = 0; m < 32; ++m) s += Am[(32 + i) * 65 + m] * Tf[m * 65 + j];
        y2[e] = s; }
#pragma unroll
    for (int e = 0; e < 2; ++e) { const int o = tid + 512 * e; Ys[(o >> 5) * 33 + (o & 31)] = y2[e]; }
    LDS_BARRIER();
#pragma unroll
    for (int e = 0; e < 2; ++e) { const int o = tid + 512 * e, i = o >> 5, j = o & 31; float s = 0.f;
#pragma unroll 8
        for (int m = 0; m < 32; ++m) s -= Tf[(32 + i) * 65 + 32 + m] * Ys[m * 33 + j];
        Tf[(32 + i) * 65 + j] = s; }
    LDS_BARRIER();
    for (int idx = tid; idx < 64 * 32; idx += 512) { const int i = idx >> 5, j2 = (idx & 31) * 2; *(LAS unsigned*)(Tn + i * 72 + j2) = pg8::cvt_pk_bf16(Tf[i * 65 + j2], Tf[i * 65 + j2 + 1]); }
    LDS_BARRIER();
    { f32x4 aw[4], au[4];
#pragma unroll
      for (int i = 0; i < 4; ++i) { aw[i] = (f32x4){0.f, 0.f, 0.f, 0.f}; au[i] = (f32x4){0.f, 0.f, 0.f, 0.f}; }
#pragma unroll
      for (int ks = 0; ks < 2; ++ks) { const bf16x8 fK = ld_frag_tr(RK, 136, 16 * wave, 32 * ks + 8 * q, 32 * ks + 8 * q + 4, r), fV = ld_frag_tr(RV, 136, 16 * wave, 32 * ks + 8 * q, 32 * ks + 8 * q + 4, r);
#pragma unroll
          for (int tt = 0; tt < 4; ++tt) { const bf16x8 fT = ld_frag(Tn, 72, 16 * tt + r, 32 * ks + 8 * q); aw[tt] = MFMA16(fK, fT, aw[tt]); au[tt] = MFMA16(fT, fV, au[tt]); } }
#pragma unroll
      for (int tt = 0; tt < 4; ++tt) { *(u32x2*)(gW + (16 * tt + r) * 128 + 16 * wave + 4 * q) = pack4(aw[tt]);
          *(u32x2*)(gUT + (16 * wave + r) * 64 + 16 * tt + 4 * q) = pack4(au[tt]); } }
    }
#undef PREP_PREFETCH
}

__device__ __forceinline__ void gdn_scan_unit(const Ctx& C, const unsigned char* prep, const float* gtot, bf16_t* AO, int unit) {
    const int vs = unit & 1, h = (unit >> 1) & 7, bl = unit >> 4;
    LAS bf16_t* Wn = (LAS bf16_t*)C.lds;
    LAS bf16_t* Qd = Wn + 64 * 136;
    LAS bf16_t* Kd = Qd + 64 * 136;
    LAS bf16_t* QKn = Kd + 64 * 136;
    LAS bf16_t* UT = QKn + 64 * 72;
    LAS bf16_t* VNT = UT + 64 * 72;
    LAS bf16_t* ST = VNT + 64 * 72;
    const int tid = C.tid, lane = C.lane, wave = C.wave, q = lane >> 4, r = lane & 15;
    const int tt = wave & 3, vg = wave >> 2;
    f32x4 accS[4];
#pragma unroll
    for (int i = 0; i < 4; ++i) accS[i] = (f32x4){0.f, 0.f, 0.f, 0.f};
    LDS_BARRIER();
    for (int idx = tid; idx < 64 * 136 / 2; idx += 512) ((LAS unsigned*)ST)[idx] = 0u;
    u32x4 wreg[2], qreg[2], kreg[2], qkreg, ureg; float greg = 0.f;
#define GDN_PREFETCH(cc) do { const int pu_ = (bl * 32 + (cc)) * 8 + h; const bf16_t* gW_ = (const bf16_t*)(prep + (size_t)pu_ * PREP_UNIT_BYTES); \
        _Pragma("unroll") for (int it = 0; it < 2; ++it) { const int idx = tid + 512 * it, row = idx >> 4, ch = idx & 15; wreg[it] = *(const u32x4*)(gW_ + row * 128 + ch * 8); qreg[it] = *(const u32x4*)(gW_ + 8192 + row * 128 + ch * 8); kreg[it] = *(const u32x4*)(gW_ + 24576 + row * 128 + ch * 8); } \
        qkreg = *(const u32x4*)(gW_ + 32768 + (tid >> 3) * 64 + (tid & 7) * 8); ureg = *(const u32x4*)(gW_ + 16384 + vs * 64 * 64 + (tid >> 3) * 64 + (tid & 7) * 8); greg = gtot[pu_]; } while (0)
    GDN_PREFETCH(0);
    for (int c = 0; c < NCHUNK; ++c) {
        const size_t r0 = (size_t)bl * SEQ + (size_t)c * 64;
        LDS_BARRIER();
#pragma unroll
        for (int it = 0; it < 2; ++it) { const int idx = tid + 512 * it, row = idx >> 4, ch = idx & 15;
            *(LAS u32x4*)(Wn + row * 136 + ch * 8) = wreg[it]; *(LAS u32x4*)(Qd + row * 136 + ch * 8) = qreg[it]; *(LAS u32x4*)(Kd + row * 136 + ch * 8) = kreg[it]; }
        { const int row = tid >> 3, c8 = tid & 7; *(LAS u32x4*)(QKn + row * 72 + c8 * 8) = qkreg; *(LAS u32x4*)(UT + row * 72 + c8 * 8) = ureg; }
        const float g = greg;
        if (c + 1 < NCHUNK) GDN_PREFETCH(c + 1);
        LDS_BARRIER();
        { f32x4 d1[2];
#pragma unroll
          for (int i = 0; i < 2; ++i) d1[i] = (f32x4){0.f, 0.f, 0.f, 0.f};
#pragma unroll
          for (int ks = 0; ks < 4; ++ks) { const bf16x8 aW = ld_frag(Wn, 136, 16 * tt + r, 32 * ks + 8 * q);
#pragma unroll
              for (int i = 0; i < 2; ++i) d1[i] = MFMA16(aW, ld_frag(ST, 136, 16 * (2 * vg + i) + r, 32 * ks + 8 * q), d1[i]); }
#pragma unroll
          for (int i = 0; i < 2; ++i) { const int v = 16 * (2 * vg + i) + r; const u32x2 uu = *(const LAS u32x2*)(UT + v * 72 + 16 * tt + 4 * q);
              f32x4 vn; vn[0] = __uint_as_float(uu.x << 16) - d1[i][0]; vn[1] = __uint_as_float(uu.x & 0xffff0000u) - d1[i][1]; vn[2] = __uint_as_float(uu.y << 16) - d1[i][2]; vn[3] = __uint_as_float(uu.y & 0xffff0000u) - d1[i][3];
              *(LAS u32x2*)(VNT + v * 72 + 16 * tt + 4 * q) = pack4(vn); } }
        LDS_BARRIER();
        { f32x4 ao[2];
#pragma unroll
          for (int i = 0; i < 2; ++i) ao[i] = (f32x4){0.f, 0.f, 0.f, 0.f};
#pragma unroll
          for (int ks = 0; ks < 4; ++ks) { const bf16x8 bQ = ld_frag(Qd, 136, 16 * tt + r, 32 * ks + 8 * q);
#pragma unroll
              for (int i = 0; i < 2; ++i) ao[i] = MFMA16(ld_frag(ST, 136, 16 * (2 * vg + i) + r, 32 * ks + 8 * q), bQ, ao[i]); }
#pragma unroll
          for (int ks = 0; ks < 2; ++ks) { const bf16x8 bQK = ld_frag(QKn, 72, 16 * tt + r, 32 * ks + 8 * q);
#pragma unroll
              for (int i = 0; i < 2; ++i) ao[i] = MFMA16(ld_frag(VNT, 72, 16 * (2 * vg + i) + r, 32 * ks + 8 * q), bQK, ao[i]); }
#pragma unroll
          for (int i = 0; i < 2; ++i) *(u32x2*)(AO + (r0 + 16 * tt + r) * KO0 + 1024 + h * 128 + vs * 64 + 16 * (2 * vg + i) + 4 * q) = pack4(ao[i]); }
#pragma unroll
        for (int vt = 0; vt < 4; ++vt) accS[vt] = accS[vt] * g;
#pragma unroll
        for (int ks = 0; ks < 2; ++ks) { const bf16x8 aK = ld_frag_tr(Kd, 136, 16 * wave, 32 * ks + 8 * q, 32 * ks + 8 * q + 4, r);
#pragma unroll
            for (int vt = 0; vt < 4; ++vt) accS[vt] = MFMA16(aK, ld_frag(VNT, 72, 16 * vt + r, 32 * ks + 8 * q), accS[vt]); }
        LDS_BARRIER();
#pragma unroll
        for (int vt = 0; vt < 4; ++vt) *(LAS u32x2*)(ST + (16 * vt + r) * 136 + 16 * wave + 4 * q) = pack4(accS[vt]);
    }
#undef GDN_PREFETCH
}
constexpr int AW_KV = 16384, AW_T = 640;
__device__ __forceinline__ void attn_wave(const Ctx& C, const bf16_t* P, bf16_t* AO, int bl, int c, int head) {
    const int lane = C.lane;
    LAS unsigned char* Kb = C.lds + C.wave * AW_KV; LAS unsigned char* Vb = Kb + 8192;
    LAS float* Tb = (LAS float*)(C.lds + 8 * AW_KV) + C.wave * AW_T;
    const size_t r0 = (size_t)bl * SEQ + (size_t)c * 64;
    const int cb0 = c - 8 < 0 ? 0 : c - 8, nblk = c - cb0 + 1;
#define AW_BLK(n_) (c < 8 ? (n_) : c - ((c - (n_)) % 9))
#define AW_GK(cb_) ((const char*)(P + pj1((size_t)bl * SEQ + (size_t)(cb_) * 64, C_AK + head * 64)))
#define AW_GV(cb_) ((const char*)(P + pj1((size_t)bl * SEQ + (size_t)(cb_) * 64, C_AV + head * 64)))
#define AW_DMA_K(gb_) do { _Pragma("unroll") for (int i_ = 0; i_ < 8; ++i_) __builtin_amdgcn_global_load_lds((const unsigned*)((gb_) + (size_t)i_ * 1024 + (voK ^ ((i_ & 1) << 6))), (LAS unsigned*)(Kb + i_ * 1024), 16, 0, 0); } while (0)
#define AW_DMA_V(gb_) do { _Pragma("unroll") for (int i_ = 0; i_ < 8; ++i_) __builtin_amdgcn_global_load_lds((const unsigned*)((gb_) + (size_t)i_ * 1024 + voV), (LAS unsigned*)(Vb + i_ * 1024), 16, 0, 0); } while (0)
#define AW_LANE_CONSTS() int ln_ = lane; asm volatile("" : "+v"(ln_)); const int q = ln_ >> 4, r = ln_ & 15; \
    const unsigned voK = (unsigned)(((ln_ >> 3) * 64 + (((ln_ & 7) ^ (ln_ >> 4)) * 8)) * 2), voV = (unsigned)(((ln_ >> 3) * 64 + (((ln_ & 7) ^ (2 * (ln_ >> 4))) * 8)) * 2)
    asm volatile("s_waitcnt vmcnt(0)" ::: "memory");
    bf16x8 bQ[4][2];
    { AW_LANE_CONSTS(); const int cbf = AW_BLK(0); AW_DMA_K(AW_GK(cbf)); AW_DMA_V(AW_GV(cbf));
#pragma unroll
    for (int s = 0; s < 4; ++s)
#pragma unroll
        for (int ks = 0; ks < 2; ++ks) bQ[s][ks] = *(const bf16x8*)(P + pj1(r0 + 16 * s + r, C_AQ + head * 64 + 32 * ks + 8 * q)); }
#pragma unroll
    for (int i = 0; i < 10; ++i) { const int k = lane + 64 * i; int ri = 638 - k; ri = ri > 319 ? 319 : (ri < 0 ? 0 : ri); Tb[k] = C.in[15][head * 320 + ri] * 1.4426950408889634f; }
    f32x4 acco[4][4]; float m_run[4], l_run[4];
#pragma unroll
    for (int s = 0; s < 4; ++s) { m_run[s] = -1e30f; l_run[s] = 0.f;
#pragma unroll
        for (int md = 0; md < 4; ++md) acco[s][md] = (f32x4){0.f, 0.f, 0.f, 0.f}; }
#define XSH(v_, a_) __builtin_bit_cast(float, __builtin_amdgcn_ds_bpermute(a_, __builtin_bit_cast(int, v_)))
    asm volatile("s_waitcnt vmcnt(0)" ::: "memory");
    for (int n = 0; n < nblk; ++n) {
        const bool more = n + 1 < nblk; const int cb = AW_BLK(n), cbn = AW_BLK(n + 1);
        AW_LANE_CONSTS();
        const int kofs0 = r * 128 + ((q ^ (r >> 1)) * 16), kofs1 = kofs0 ^ 64;
        const int vsw = 2 * ((2 * q + (r >> 3)) & 3), vrow = (4 * q + (r >> 2)) * 128 + (r & 1) * 8, vc0 = (((r & 3) >> 1) ^ vsw) * 16;
        const int x16 = (ln_ ^ 16) * 4, x32 = (ln_ ^ 32) * 4;
        const int tb0 = 638 - 64 * (c - cb0) - 63 - (r - 4 * q) - 48;
        asm volatile("s_waitcnt vmcnt(8)" ::: "memory");
        const LAS float* tp = Tb + tb0 + 64 * (cb - cb0);
        bf16x8 pf[4][2]; f32x4 accs[4][4]; float mx[4];
#pragma unroll
        for (int s = 0; s < 4; ++s) {
#pragma unroll
            for (int mi = 0; mi < 4; ++mi) { const bf16x8 k0 = *(const LAS bf16x8*)(Kb + mi * 2048 + kofs0), k1 = *(const LAS bf16x8*)(Kb + mi * 2048 + kofs1);
                const LAS float* tq = tp + 16 * (mi - s + 3);
                accs[s][mi] = MFMA16(k0, bQ[s][0], ((f32x4){0.f, 0.f, 0.f, 0.f})); accs[s][mi] = MFMA16(k1, bQ[s][1], accs[s][mi]);
                accs[s][mi] = accs[s][mi] + (f32x4){tq[0], tq[1], tq[2], tq[3]}; }
            float m = -1e30f;
#pragma unroll
            for (int mi = 0; mi < 4; ++mi) m = fmaxf(fmaxf(m, fmaxf(accs[s][mi][0], accs[s][mi][1])), fmaxf(accs[s][mi][2], accs[s][mi][3]));
            m = fmaxf(m, XSH(m, x16)); mx[s] = fmaxf(m, XSH(m, x32));
        }
        asm volatile("s_waitcnt lgkmcnt(0)" ::: "memory");
        if (more) AW_DMA_K(AW_GK(cbn));
        const bool need = (mx[0] > m_run[0] + 8.f) | (mx[1] > m_run[1] + 8.f) | (mx[2] > m_run[2] + 8.f) | (mx[3] > m_run[3] + 8.f);
        if (__builtin_amdgcn_ballot_w64(need) != 0ull) {
#pragma unroll
            for (int s = 0; s < 4; ++s) { const float m_new = mx[s] > m_run[s] + 8.f ? mx[s] : m_run[s], al = __builtin_amdgcn_exp2f(m_run[s] - m_new); m_run[s] = m_new; l_run[s] *= al;
#pragma unroll
                for (int md = 0; md < 4; ++md) acco[s][md] = acco[s][md] * al; }
        }
#pragma unroll
        for (int s = 0; s < 4; ++s) { float ls = 0.f;
#pragma unroll
            for (int mi = 0; mi < 4; ++mi)
#pragma unroll
                for (int jj = 0; jj < 4; ++jj) { accs[s][mi][jj] = __builtin_amdgcn_exp2f(accs[s][mi][jj] - m_run[s]); ls += accs[s][mi][jj]; }
            l_run[s] += ls;
            pf[s][0] = pack_frag(accs[s][0], accs[s][1]); pf[s][1] = pack_frag(accs[s][2], accs[s][3]);
        }
        if (more) asm volatile("s_waitcnt vmcnt(8)" ::: "memory"); else asm volatile("s_waitcnt vmcnt(0)" ::: "memory");
        bf16x8 vf[4][2];
#pragma unroll
        for (int md = 0; md < 4; ++md)
#pragma unroll
            for (int ks2 = 0; ks2 < 2; ++ks2) { const LAS unsigned char* vp = Vb + vrow + ks2 * 4096 + (((2 * md) * 16) ^ vc0);
                const bf16x4 lo = __builtin_amdgcn_ds_read_tr16_b64_v4i16((LAS bf16x4*)(vp)), hi = __builtin_amdgcn_ds_read_tr16_b64_v4i16((LAS bf16x4*)(vp + 2048));
                vf[md][ks2] = __builtin_shufflevector(lo, hi, 0, 1, 2, 3, 4, 5, 6, 7); }
        asm volatile("s_waitcnt lgkmcnt(0)" ::: "memory");
        if (more) AW_DMA_V(AW_GV(cbn));
#pragma unroll
        for (int md = 0; md < 4; ++md)
#pragma unroll
            for (int ks2 = 0; ks2 < 2; ++ks2)
#pragma unroll
                for (int s = 0; s < 4; ++s) acco[s][md] = MFMA16(vf[md][ks2], pf[s][ks2], acco[s][md]);
    }
    AW_LANE_CONSTS(); const int x16 = (ln_ ^ 16) * 4, x32 = (ln_ ^ 32) * 4;
#pragma unroll
    for (int s = 0; s < 4; ++s) { float l = l_run[s]; l += XSH(l, x16); l += XSH(l, x32); const float inv = 1.f / l;
#pragma unroll
        for (int md = 0; md < 4; ++md) *(LAS u32x2*)(Kb + (16 * s + r) * 144 + (16 * md + 4 * q) * 2) = pack4(acco[s][md] * inv); }
#pragma unroll
    for (int k = 0; k < 8; ++k) { const u32x4 o = *(const LAS u32x4*)(Kb + ((ln_ >> 3) + 8 * k) * 144 + (ln_ & 7) * 16);
        pg8::st16_wt(AO + (r0 + (ln_ >> 3) + 8 * k) * KO1 + head * 64 + (ln_ & 7) * 8, o); }
#undef XSH
#undef AW_BLK
#undef AW_GK
#undef AW_GV
#undef AW_LANE_CONSTS
#undef AW_DMA_K
#undef AW_DMA_V
}
__device__ __forceinline__ void phase_attn(const Ctx& C, const bf16_t* P, bf16_t* AO) {
    LDS_BARRIER();
    for (int u = C.bid; u < 512; u += C.G) { const int x = u & 7, i = (u >> 3) & 31, second = u >> 8, seq = 2 * x + second, c = second ? 31 - i : i;
        attn_wave(C, P, AO, seq >> 1, c, 8 * (seq & 1) + C.wave); }
    asm volatile("s_waitcnt vmcnt(0)" ::: "memory");
}
#define PH_BEGIN if (ph >= lo && ph < hi) { { int t_ = C.wave0 * 64 + lane_id_(); asm volatile("" : "+v"(t_)); C.tid = t_; C.lane = t_ & 63; C.wave = __builtin_amdgcn_readfirstlane(t_ >> 6); }
#define PH_END   if (ph + 1 < hi) xcd_barrier(bar); } ++ph;

__device__ __forceinline__ void moe_block(Ctx& C, const XcdBarrier& bar, int& ph, const int lo, const int hi, const int layer) {
    PH_BEGIN phase_convert_moe(C, layer); __syncthreads(); phase_r1(C, layer); PH_END
    PH_BEGIN phase_r2(C, layer); PH_END
    PH_BEGIN {
        const int npan = *((const int*)(C.ws + WS_CNT) + 128 + layer);
        pg8::Gemm g{(const bf16_t*)(C.ws + WS_H2P), (const bf16_t*)(C.ws + WS_W1), NTOK, 32 * 512, 1024};
        pg8::MoeOrder S{(const int*)(C.ws + WS_PANEL) + layer * 320, npan * 2, C.G, C.bid, 1};
        pg8::EpiSwiGLU E{(bf16_t*)(C.ws + WS_ACT), (const float*)(C.ws + WS_WROW)};
        pg8::gemm_phase_g<pg8::EpiSwiGLU, pg8::MoeOrder, false>(C.lds, g, S, E, (const int*)(C.ws + WS_ROWTOK), nullptr, C.wave0);
    } PH_END
    PH_BEGIN {
        const int npan = *((const int*)(C.ws + WS_CNT) + 128 + layer);
        pg8::Gemm g{(const bf16_t*)(C.ws + WS_ACT), (const bf16_t*)(C.ws + WS_W2), MOE_MAXROWS, 32 * 1024, 256};
        pg8::MoeOrder S{(const int*)(C.ws + WS_PANEL) + layer * 320, npan * 4, C.G, C.bid, 2};
        pg8::EpiBf16P E{(bf16_t*)(C.ws + WS_YP), 1024, 3};
        pg8::gemm_phase<pg8::EpiBf16P, pg8::MoeOrder, false>(C.lds, g, S, E, nullptr, C.wave0);
    } PH_END
    PH_BEGIN { if (layer == 0) { phase_combine_norm(C, (const float*)(C.ws + WS_WSM1), C.in[1] + D, (bf16_t*)(C.ws + WS_HN1A), (float*)(C.ws + WS_SM1), (bf16_t*)(C.ws + WS_HN1B), (float*)(C.ws + WS_SM1 + 2 * MiB)); __syncthreads(); phase_convert(C, 1); }
               else phase_combine(C); } PH_END
}

__global__ void __launch_bounds__(512, 2) mega_fwd(Args args) {
    extern __shared__ __attribute__((aligned(16))) unsigned char lds_raw[];
    Ctx C; C.in = args.in; C.out = args.out; C.ws = args.ws; C.lds = (LAS unsigned char*)lds_raw;
    C.wave0 = __builtin_amdgcn_readfirstlane((int)threadIdx.x >> 6);
    C.lane = lane_id_(); C.tid = C.wave0 * 64 + C.lane; C.wave = C.wave0; C.G = gridDim.x; C.bid = blockIdx.x;
    if (C.tid < 4) ((LAS unsigned*)(C.lds + LDS_BAR_OFF))[C.tid] = 0u;
    __syncthreads();
    XcdBarrier bar = xcd_barrier_post((unsigned*)(C.ws + WS_BAR) + args.li * XCD_BAR_WORDS, (volatile LAS unsigned*)(C.lds + LDS_BAR_OFF), C.wave0);
    const int lo = args.ph_lo, hi = args.ph_hi; int ph = 0;
    bf16_t* HN = (bf16_t*)(C.ws + WS_HN); bf16_t* AO = (bf16_t*)(C.ws + WS_AOUT); bf16_t* PJ = (bf16_t*)(C.ws + WS_PROJ);
    const bf16_t* Win = (const bf16_t*)(C.ws + WS_WIN); const bf16_t* Wout = (const bf16_t*)(C.ws + WS_WOUT);

    PH_BEGIN phase_convert(C, 0); PH_END
    _Pragma("unroll") for (int g = 0; g < NGRP; ++g) {
        const size_t grow = (size_t)g * GTOK;
        if (g == 0) { PH_BEGIN phase_norm(C, (const float*)(C.ws + WS_WSM), C.in[0] + grow * D, C.in[1], HN, (float*)(C.ws + WS_SM0), GTOK, C.bid, C.G); PH_END }
        PH_BEGIN { pg8::Gemm gm{g == 0 ? HN : (const bf16_t*)(C.ws + WS_AOUT + 64 * MiB), Win, GTOK, NP0, D}; pg8::StaticOrder S; S.init(GTOK, NP0, C.G, C.bid); pg8::EpiBf16QKT<false> E{PJ, NP0 / 256, nullptr, C.lds + pg8::STAGE_BYTES + 512};
            pg8::gemm_phase<pg8::EpiBf16QKT<false>, pg8::StaticOrder, false>(C.lds, gm, S, E, nullptr, C.wave0); } PH_END
        PH_BEGIN { gdn_prep_phase(C, PJ, (const float*)(C.ws + WS_SM0 + (size_t)g * 2 * MiB), C.ws + WS_PREP, (float*)(C.ws + WS_GTOT)); } PH_END
        PH_BEGIN { const int nA = C.G >> 1;
            if (C.bid < nA) { for (int u = C.bid; u < 128; u += nA) gdn_scan_unit(C, C.ws + WS_PREP, (const float*)(C.ws + WS_GTOT), AO, u);
                if (g == 0) { __syncthreads(); phase_norm(C, (const float*)(C.ws + WS_WSM), C.in[0] + (size_t)GTOK * D, C.in[1], (bf16_t*)(C.ws + WS_AOUT + 64 * MiB), (float*)(C.ws + WS_SM0 + 2 * MiB), GTOK, C.bid, nA); } }
            else { for (int u = C.bid - nA; u < 128; u += C.G - nA) mlstm_unit(C, PJ, (const float*)(C.ws + WS_SM0 + (size_t)g * 2 * MiB), AO, u); } } PH_END
        PH_BEGIN phase_gate0(C, PJ, AO); PH_END
        PH_BEGIN { pg8::Gemm gm{AO, Wout, GTOK, D, KO0}; pg8::StaticOrder S; S.init(GTOK, D, C.G, C.bid); pg8::EpiResidB<false> E{C.in[0] + grow * D, (bf16_t*)C.out + grow * D, D};
            pg8::gemm_phase<pg8::EpiResidB<false>, pg8::StaticOrder, false>(C.lds, gm, S, E, nullptr, C.wave0); } PH_END
    }
    moe_block(C, bar, ph, lo, hi, 0);
    _Pragma("unroll") for (int g = 0; g < NGRP; ++g) {
        const size_t grow = (size_t)g * GTOK;
        PH_BEGIN { LAS float* gn = (LAS float*)(C.lds + pg8::STAGE_BYTES);
            if (C.tid < 128) gn[C.tid] = C.tid < 64 ? C.in[13][C.tid] * (0.125f * 1.4426950408889634f) : C.in[14][C.tid - 64];
            __syncthreads();
            pg8::Gemm gm{(const bf16_t*)(C.ws + (g == 0 ? WS_HN1A : WS_HN1B)), Win, GTOK, NP1, D}; pg8::StaticOrder S; S.init(GTOK, NP1, C.G, C.bid); pg8::EpiBf16QKT<true> E{PJ, NP1 / 256, gn, C.lds + pg8::STAGE_BYTES + 512};
            pg8::gemm_phase<pg8::EpiBf16QKT<true>, pg8::StaticOrder, false>(C.lds, gm, S, E, nullptr, C.wave0); } PH_END
        PH_BEGIN { phase_ssdconv(C, PJ, (bf16_t*)(C.ws + WS_XC)); } PH_END
        PH_BEGIN { for (int u = C.bid; u < 256; u += C.G) ssd_unit(C, (const float*)(C.ws + WS_SM1 + (size_t)g * 2 * MiB), (const bf16_t*)(C.ws + WS_XC), AO, u); phase_attn(C, PJ, AO); } PH_END
        PH_BEGIN phase_gate1(C, PJ, AO); PH_END
        PH_BEGIN { pg8::Gemm gm{AO, Wout, GTOK, D, KO1}; pg8::StaticOrder S; S.init(GTOK, D, C.G, C.bid); pg8::EpiResidB<true> E{(const bf16_t*)C.out + grow * D, (bf16_t*)C.out + grow * D, D};
            pg8::gemm_phase<pg8::EpiResidB<true>, pg8::StaticOrder, false>(C.lds, gm, S, E, nullptr, C.wave0); } PH_END
    }
    moe_block(C, bar, ph, lo, hi, 1);
}
constexpr int N_PHASES = 1 + (6 * NGRP + 5 - 1) + (5 * NGRP + 5);

#ifndef N_LAUNCHES
#define N_LAUNCHES 1
#endif
extern "C" void kernel_launch(void* const* d_in, const int* in_sizes, int n_in, void* d_out, int out_size, void* d_ws, size_t ws_size, hipStream_t stream) {
    static int grid = 0;
    if (grid == 0) {
        if (n_in != 30 || out_size != NTOK * D || ws_size < WS_END) { fprintf(stderr, "kernel_launch: unexpected shapes (n_in %d out %d ws %zu)\n", n_in, out_size, ws_size); grid = -1; return; }
        int dev = 0, cus = 0, per_cu = 0;
        if (hipGetDevice(&dev) != hipSuccess || hipDeviceGetAttribute(&cus, hipDeviceAttributeMultiprocessorCount, dev) != hipSuccess) { grid = -1; return; }
        if (hipFuncSetAttribute((const void*)mega_fwd, hipFuncAttributeMaxDynamicSharedMemorySize, LDS_BYTES) != hipSuccess) { fprintf(stderr, "kernel_launch: hipFuncSetAttribute failed\n"); grid = -1; return; }
        if (hipOccupancyMaxActiveBlocksPerMultiprocessor(&per_cu, (const void*)mega_fwd, 512, LDS_BYTES) != hipSuccess || per_cu < 1) fprintf(stderr, "kernel_launch: occupancy query says %d\n", per_cu);
        (void)hipGetLastError();
        grid = cus;
    }
    if (grid < 0) return;
    if (hipMemsetAsync(d_ws, 0, WS_ZERO_BYTES, stream) != hipSuccess) return;
    Args a{};
    for (int i = 0; i < 30; ++i) a.in[i] = (const float*)d_in[i];
    a.out = (float*)d_out; a.ws = (unsigned char*)d_ws; a.pad = 0;
    for (int li = 0; li < N_LAUNCHES; ++li) {
        a.ph_lo = (int)((long)N_PHASES * li / N_LAUNCHES); a.ph_hi = (int)((long)N_PHASES * (li + 1) / N_LAUNCHES); a.li = li;
        hipLaunchKernelGGL(mega_fwd, dim3(grid), dim3(512), LDS_BYTES, stream, a);
    }
}
```

```cpp
#include <hip/hip_runtime.h>
#include <cstdio>
#include <cstdint>
#define XB_TMO      128
#define XB_XCNT(j)  (256  + 64 * (j))
#define XB_XSUB(j)  (1280 + 64 * (j))
#define XB_XGEN(j)  (2304 + 64 * (j))
#define XB_TOP      3328
#define XB_TOPGEN   3392
#define XCD_BAR_WORDS 3456
#define XB_SPIN_CAP (1u << 22)
#define LAS __attribute__((address_space(3)))

__device__ __forceinline__ unsigned xb_ld(unsigned* p)              { return __hip_atomic_load(p, __ATOMIC_RELAXED, __HIP_MEMORY_SCOPE_AGENT); }
__device__ __forceinline__ unsigned xb_add(unsigned* p, unsigned v) { return __hip_atomic_fetch_add(p, v, __ATOMIC_RELAXED, __HIP_MEMORY_SCOPE_AGENT); }
__device__ __forceinline__ unsigned xb_xcc_id() { return (unsigned)__builtin_amdgcn_s_getreg((3 << 11) | 20) & 0xFu; }
#define XB_SPIN(cond, bar) do { unsigned _sp = 0; while (cond) { __builtin_amdgcn_s_sleep(1); \
    if ((++_sp & 255u) == 0u) { if (xb_ld(&(bar)[XB_TMO])) break; if (_sp > XB_SPIN_CAP) { atomicAdd(&(bar)[XB_TMO], 1u); break; } } } } while (0)

struct XcdBarrier {
    int w0;
    unsigned* bar; unsigned x;
    volatile LAS unsigned* st;
};

__device__ __forceinline__ int lane_id_() { int l; asm volatile("v_mbcnt_lo_u32_b32 %0, -1, 0\n\tv_mbcnt_hi_u32_b32 %0, -1, %0" : "=v"(l)); return l; }
__device__ __forceinline__ XcdBarrier xcd_barrier_post(unsigned* bar, volatile LAS unsigned* st, int w0) {
    XcdBarrier b; b.w0 = w0; b.bar = bar; b.x = xb_xcc_id(); b.st = st;
    if (w0 == 0 && lane_id_() == 0) (void)xb_add(&bar[XB_XCNT(b.x)], 1u);
    return b;
}
__device__ __forceinline__ void xcd_barrier_complete(unsigned* bar, unsigned x, unsigned& nloc, unsigned& nx) {
    const unsigned G = gridDim.x * gridDim.y * gridDim.z;
    unsigned sum, cnt, mine, sp = 0u;
    for (;;) {
        sum = 0u; cnt = 0u; mine = 0u;
#pragma unroll
        for (unsigned j = 0; j < 16; ++j) { const unsigned c = xb_ld(&bar[XB_XCNT(j)]); sum += c; cnt += (c > 0u) ? 1u : 0u; mine = (j == x) ? c : mine; }
        if (sum == G) break;
        __builtin_amdgcn_s_sleep(1);
        if ((++sp & 255u) == 0u) { if (xb_ld(&bar[XB_TMO])) break; if (sp > XB_SPIN_CAP) { atomicAdd(&bar[XB_TMO], 1u); break; } }
    }
    nloc = mine > 0u ? mine : 1u; nx = cnt > 0u ? cnt : 1u;
}

__device__ __forceinline__ void xcd_barrier(const XcdBarrier& b) {
    asm volatile("s_waitcnt vmcnt(0)" ::: "memory");
    __syncthreads();
    if (b.w0 == 0 && lane_id_() == 0) {
        unsigned* bar = b.bar;
        __builtin_amdgcn_s_waitcnt(0);
        unsigned nloc = b.st[0], nx = b.st[1];
        if (nloc == 0u) { xcd_barrier_complete(bar, b.x, nloc, nx); b.st[0] = nloc; b.st[1] = nx; }
        const unsigned old = xb_add(&bar[XB_XSUB(b.x)], 1u);
        const unsigned gen = old / nloc;
        if (old + 1u == (gen + 1u) * nloc) {
            __builtin_amdgcn_fence(__ATOMIC_RELEASE, "agent");
            asm volatile("s_waitcnt vmcnt(0)" ::: "memory");
            const unsigned og = xb_add(&bar[XB_TOP], 1u);
            const unsigned tg = og / nx;
            if (og + 1u == (tg + 1u) * nx) xb_add(&bar[XB_TOPGEN], 1u);
            else XB_SPIN(xb_ld(&bar[XB_TOPGEN]) == tg, bar);
            __builtin_amdgcn_fence(__ATOMIC_ACQUIRE, "agent");
            xb_add(&bar[XB_XGEN(b.x)], 1u);
            asm volatile("s_waitcnt vmcnt(0)" ::: "memory");
        } else {
            XB_SPIN(xb_ld(&bar[XB_XGEN(b.x)]) == gen, bar);
            __builtin_amdgcn_fence(__ATOMIC_ACQUIRE, "agent");
            asm volatile("s_waitcnt vmcnt(0)" ::: "memory");
        }
    }
    __syncthreads();
}
namespace pg8 {
#define PG8_LAS __attribute__((address_space(3)))
typedef unsigned short bf16_t;
typedef short bf16x8 __attribute__((ext_vector_type(8)));
typedef float f32x4 __attribute__((ext_vector_type(4)));
typedef unsigned u32x4 __attribute__((ext_vector_type(4)));
constexpr int BM = 256, BK = 64, HALF = 128, HTB = HALF * BK * 2  , STAGE_BYTES = 8 * HTB, NXCD = 8, WGM = 8;

__host__ __device__ __forceinline__ int lds_byte(int r, int c) { const int st = (r >> 4) * 2 + (c >> 5), rr = r & 15, cc = c & 31, ob = rr * 64 + cc * 2; return st * 1024 + (ob ^ (((ob >> 9) & 1) << 5)); }
__host__ __device__ __forceinline__ void stage_rc(int b, int& R, int& C) { const int st = b / 1024, sb = b % 1024, swz = sb ^ (((sb >> 9) & 1) << 5); R = (st >> 1) * 16 + swz / 64; C = (st & 1) * 32 + (swz % 64) / 2; }
__host__ __device__ __forceinline__ int perm32(int rho) { const int n = rho >> 4, i = rho & 15; return 8 * (i >> 2) + 4 * n + (i & 3); }

struct Unit { int pm, pn; };
struct Gemm { const bf16_t* A; const bf16_t* Bt; int M, N, K; };

struct StaticOrder {
    int nM, nN, nwg, G, c;
    __host__ __device__ void init(int M, int N, int G_, int c_) { nM = M / BM; nN = N / BM; nwg = nM * nN; G = G_; c = c_; }
    __host__ __device__ bool next(int i, Unit& u) const {
        const long L = (long)i * G + c; if (L >= nwg) return false;
        int wgid = (int)L; { const int q = nwg / NXCD, r = nwg % NXCD, xcd = wgid % NXCD, off = wgid / NXCD; wgid = (xcd < r ? xcd * (q + 1) : r * (q + 1) + (xcd - r) * q) + off; }
        const int nig = WGM * nN, gid = wgid / nig, fm = gid * WGM, gsz = (nM - fm) < WGM ? (nM - fm) : WGM;
        u.pm = fm + ((wgid % nig) % gsz); u.pn = (wgid % nig) / gsz; return true;
    }
    __device__ __forceinline__ void a_ready(const Unit&) const {}
    __device__ __forceinline__ void done(const Unit&) const {}
};

typedef float f32x2c __attribute__((ext_vector_type(2))); typedef __bf16 bf16x2c __attribute__((ext_vector_type(2)));
__device__ __forceinline__ unsigned cvt_pk_bf16(float lo, float hi) { const f32x2c v = {lo, hi}; return __builtin_bit_cast(unsigned, __builtin_convertvector(v, bf16x2c)); }
typedef float f32x2 __attribute__((ext_vector_type(2)));
template <class Epi, class Sched, bool STAMP = false>
__device__ __forceinline__ void gemm_phase(PG8_LAS unsigned char* lds, const Gemm g, const Sched& S, const Epi& E, unsigned long long* stamps, const int wave0) {
    int tid_l = wave0 * 64 + lane_id_(); asm volatile("" : "+v"(tid_l)); const int tid = tid_l, wid = __builtin_amdgcn_readfirstlane(tid >> 6), lane = tid & 63, wr = wid >> 2, wc = wid & 3, fr = lane & 15, fq = lane >> 4;
    const int K = g.K, nt = K / BK;
    int ts_lo = 0, ts_hi = 0, nts = 0; const unsigned long long rt_entry = STAMP ? (unsigned long long)wall_clock64() : 0ull;
#define PG8_STAMP() do { if (STAMP && wid == 0 && nts < 64) { const unsigned long long _c = (unsigned long long)clock64(); \
        ts_lo = (lane == nts) ? (int)(unsigned)_c : ts_lo; ts_hi = (lane == nts) ? (int)(unsigned)(_c >> 32) : ts_hi; ++nts; } } while (0)
    PG8_STAMP();
    unsigned voffA[2], voffB[2];
#pragma unroll
    for (int i = 0; i < 2; ++i) { int R, C; stage_rc(tid * 16 + i * 8192, R, C); const int Rb = Epi::PERM ? ((R & ~31) + perm32(R & 31)) : R;
        voffA[i] = (unsigned)(R * K + C) * 2u; voffB[i] = (unsigned)(Rb * K + C) * 2u; }
    const size_t kstep = (size_t)(BK * 2);
    const size_t hstep = (size_t)HALF * K * 2;
    const size_t tstep = 2 * hstep;
    const unsigned ldsw = (unsigned)wid * 1024u;
    const int aoff = lds_byte(wr * 64 + fr, fq * 8), boff = lds_byte(wc * 32 + fr, fq * 8);
#define PG8_SA(b, h) (((b) * 2 + (h)) * HTB)
#define PG8_SB(b, h) ((4 + (b) * 2 + (h)) * HTB)
#define PG8_STAGE(bufoff, gbase, voff) do { _Pragma("unroll") for (int _i = 0; _i < 2; ++_i) \
        __builtin_amdgcn_global_load_lds((const unsigned*)((const char*)(gbase) + (voff)[_i]), (PG8_LAS unsigned*)(lds + (bufoff) + ldsw + _i * 8192), 16, 0, 0); } while (0)
#define PG8_LDA(dst, b, h) do { _Pragma("unroll") for (int m = 0; m < 4; ++m) _Pragma("unroll") for (int k = 0; k < 2; ++k) dst[m][k] = *(const PG8_LAS bf16x8*)(lds + PG8_SA(b, h) + aoff + m * 2048 + k * 1024); } while (0)
#define PG8_LDB(dst, b, h) do { _Pragma("unroll") for (int n = 0; n < 2; ++n) _Pragma("unroll") for (int k = 0; k < 2; ++k) dst[n][k] = *(const PG8_LAS bf16x8*)(lds + PG8_SB(b, h) + boff + n * 2048 + k * 1024); } while (0)
#define PG8_MMA(ai, bj, At, Bt) do { __builtin_amdgcn_s_setprio(1); _Pragma("unroll") for (int m = 0; m < 4; ++m) _Pragma("unroll") for (int n = 0; n < 2; ++n) _Pragma("unroll") for (int k = 0; k < 2; ++k) \
        acc[ai][bj][m][n] = __builtin_amdgcn_mfma_f32_16x16x32_bf16(Bt[n][k], At[m][k], acc[ai][bj][m][n], 0, 0, 0); __builtin_amdgcn_s_setprio(0); } while (0)
#define PG8_WAIT_V(n) asm volatile("s_waitcnt vmcnt(" #n ")" ::: "memory")
#define PG8_WAIT_L(n) asm volatile("s_waitcnt lgkmcnt(" #n ")" ::: "memory")
#define PG8_BAR __builtin_amdgcn_s_barrier()
#define PG8_SCHED __builtin_amdgcn_sched_barrier(0)
    Unit cur, nxt; int ui = 0;
    if (!S.next(0, cur)) return;
    f32x4 acc[2][2][4][2];
#pragma unroll
    for (int a = 0; a < 2; ++a)
#pragma unroll
        for (int b = 0; b < 2; ++b)
#pragma unroll
            for (int m = 0; m < 4; ++m)
#pragma unroll
                for (int n = 0; n < 2; ++n) acc[a][b][m][n] = (f32x4){0.f, 0.f, 0.f, 0.f};
    bf16x8 At[4][2], B0[2][2], B1[2][2];
    const char* cA = (const char*)g.A + (size_t)cur.pm * tstep; const char* cB = (const char*)g.Bt + (size_t)cur.pn * tstep;
    S.a_ready(cur);
    PG8_STAGE(PG8_SB(0, 0), cB, voffB); PG8_STAGE(PG8_SA(0, 0), cA, voffA); PG8_STAGE(PG8_SB(0, 1), cB + hstep, voffB); PG8_STAGE(PG8_SA(0, 1), cA + hstep, voffA);
    if (wr == 1) PG8_BAR;
    PG8_WAIT_V(4); PG8_BAR;
    PG8_STAGE(PG8_SB(1, 0), cB + kstep, voffB); PG8_STAGE(PG8_SA(1, 0), cA + kstep, voffA); PG8_STAGE(PG8_SB(1, 1), cB + hstep + kstep, voffB);
    PG8_WAIT_V(6); PG8_BAR;
    PG8_STAMP();
    for (;;) {
        const bool has_next = S.next(ui + 1, nxt);
        const char* nA = has_next ? (const char*)g.A + (size_t)nxt.pm * tstep : cA; const char* nB = has_next ? (const char*)g.Bt + (size_t)nxt.pn * tstep : cB;
        for (int t = 0; t < nt; t += 2) {
            const bool last = (t == nt - 2);
            const char* a1 = cA + (size_t)(t + 1) * kstep;
            const char* a2 = last ? nA : cA + (size_t)(t + 2) * kstep; const char* b2 = last ? nB : cB + (size_t)(t + 2) * kstep;
            const char* a3 = a2 + kstep; const char* b3 = b2 + kstep;
            if (last && has_next) S.a_ready(nxt);
            PG8_LDB(B0, 0, 0); PG8_SCHED; PG8_LDA(At, 0, 0); PG8_STAGE(PG8_SA(1, 1), a1 + hstep, voffA);
            PG8_WAIT_L(8); PG8_BAR; PG8_WAIT_L(0); PG8_MMA(0, 0, At, B0); PG8_BAR; PG8_SCHED;
            PG8_LDB(B1, 0, 1); PG8_STAGE(PG8_SB(0, 0), b2, voffB);
            PG8_BAR; PG8_WAIT_L(0); PG8_MMA(0, 1, At, B1); PG8_BAR;
            PG8_LDA(At, 0, 1); PG8_STAGE(PG8_SA(0, 0), a2, voffA);
            PG8_BAR; PG8_WAIT_L(0); PG8_MMA(1, 0, At, B0); PG8_BAR; PG8_SCHED;
            PG8_STAGE(PG8_SB(0, 1), b2 + hstep, voffB);
            PG8_WAIT_V(6); PG8_BAR; PG8_MMA(1, 1, At, B1); PG8_BAR;
            PG8_LDB(B0, 1, 0); PG8_SCHED; PG8_LDA(At, 1, 0); PG8_STAGE(PG8_SA(0, 1), a2 + hstep, voffA);
            PG8_WAIT_L(8); PG8_BAR; PG8_WAIT_L(0); PG8_MMA(0, 0, At, B0); PG8_BAR; PG8_SCHED;
            PG8_LDB(B1, 1, 1); PG8_STAGE(PG8_SB(1, 0), b3, voffB);
            PG8_BAR; PG8_WAIT_L(0); PG8_MMA(0, 1, At, B1); PG8_BAR;
            PG8_LDA(At, 1, 1); PG8_STAGE(PG8_SA(1, 0), a3, voffA);
            PG8_BAR; PG8_WAIT_L(0); PG8_MMA(1, 0, At, B0); PG8_BAR; PG8_SCHED;
            PG8_STAGE(PG8_SB(1, 1), b3 + hstep, voffB);
            PG8_WAIT_V(6); PG8_BAR; PG8_MMA(1, 1, At, B1); PG8_BAR;
        }
        PG8_STAMP();
        if constexpr (!Epi::AFTER_DRAIN) { E(acc, cur, wr, wc, fr, fq); S.done(cur); }
        PG8_STAMP();
        if (!has_next) break;
#pragma unroll
        for (int a = 0; a < 2; ++a)
#pragma unroll
            for (int b = 0; b < 2; ++b)
#pragma unroll
                for (int m = 0; m < 4; ++m)
#pragma unroll
                    for (int n = 0; n < 2; ++n) acc[a][b][m][n] = (f32x4){0.f, 0.f, 0.f, 0.f};
        cur = nxt; cA = nA; cB = nB; ++ui;
    }
    PG8_WAIT_V(0);
    if (wr == 0) PG8_BAR;
    PG8_BAR;
    if constexpr (Epi::AFTER_DRAIN) { E.fused(acc, cur, wr, wc, fr, fq, lds, wid, lane); S.done(cur); }
    PG8_STAMP();
    if (STAMP && wid == 0) { stamps[lane] = lane < nts ? (((unsigned long long)(unsigned)ts_hi << 32) | (unsigned)ts_lo) : 0ull;
        if (lane == 62) stamps[62] = rt_entry; if (lane == 63) stamps[63] = (unsigned long long)wall_clock64(); }
#undef PG8_STAMP
#undef PG8_SA
#undef PG8_SB
#undef PG8_STAGE
#undef PG8_LDA
#undef PG8_LDB
#undef PG8_MMA
#undef PG8_WAIT_V
#undef PG8_WAIT_L
#undef PG8_BAR
#undef PG8_SCHED
}
template <class Epi, class Sched, bool STAMP = false>
__device__ __forceinline__ void gemm_phase_g(PG8_LAS unsigned char* lds, const Gemm g, const Sched& S, const Epi& E, const int* rowtok, unsigned long long* stamps, const int wave0) {
    int tid_l = wave0 * 64 + lane_id_(); asm volatile("" : "+v"(tid_l)); const int tid = tid_l, wid = __builtin_amdgcn_readfirstlane(tid >> 6), lane = tid & 63, wr = wid >> 2, wc = wid & 3, fr = lane & 15, fq = lane >> 4;
    const int K = g.K, nt = K / BK;
    int ts_lo = 0, ts_hi = 0, nts = 0; const unsigned long long rt_entry = STAMP ? (unsigned long long)wall_clock64() : 0ull;
#define PG8_STAMP() do { if (STAMP && wid == 0 && nts < 64) { const unsigned long long _c = (unsigned long long)clock64(); \
        ts_lo = (lane == nts) ? (int)(unsigned)_c : ts_lo; ts_hi = (lane == nts) ? (int)(unsigned)(_c >> 32) : ts_hi; ++nts; } } while (0)
    PG8_STAMP();
    unsigned voffA[2], voffB[2]; int rowA[2]; unsigned colA2[2];
#pragma unroll
    for (int i = 0; i < 2; ++i) { int R, C; stage_rc(tid * 16 + i * 8192, R, C); const int Rb = Epi::PERM ? ((R & ~31) + perm32(R & 31)) : R;
        voffA[i] = (unsigned)(R * K + C) * 2u; voffB[i] = (unsigned)(Rb * K + C) * 2u; rowA[i] = R; colA2[i] = (unsigned)C * 2u; }
    (void)voffA; const unsigned K2 = (unsigned)K * 2u; unsigned gc[2][2], gn[2][2];
    const size_t kstep = (size_t)(BK * 2);
    const size_t hstep = (size_t)HALF * K * 2;
    const size_t tstep = 2 * hstep;
    const unsigned ldsw = (unsigned)wid * 1024u;
    const int aoff = lds_byte(wr * 64 + fr, fq * 8), boff = lds_byte(wc * 32 + fr, fq * 8);
#define PG8_SA(b, h) (((b) * 2 + (h)) * HTB)
#define PG8_SB(b, h) ((4 + (b) * 2 + (h)) * HTB)
#define PG8_STAGE(bufoff, gbase, voff) do { _Pragma("unroll") for (int _i = 0; _i < 2; ++_i) \
        __builtin_amdgcn_global_load_lds((const unsigned*)((const char*)(gbase) + (voff)[_i]), (PG8_LAS unsigned*)(lds + (bufoff) + ldsw + _i * 8192), 16, 0, 0); } while (0)
#define PG8_LDA(dst, b, h) do { _Pragma("unroll") for (int m = 0; m < 4; ++m) _Pragma("unroll") for (int k = 0; k < 2; ++k) dst[m][k] = *(const PG8_LAS bf16x8*)(lds + PG8_SA(b, h) + aoff + m * 2048 + k * 1024); } while (0)
#define PG8_LDB(dst, b, h) do { _Pragma("unroll") for (int n = 0; n < 2; ++n) _Pragma("unroll") for (int k = 0; k < 2; ++k) dst[n][k] = *(const PG8_LAS bf16x8*)(lds + PG8_SB(b, h) + boff + n * 2048 + k * 1024); } while (0)
#define PG8_MMA(ai, bj, At, Bt) do { __builtin_amdgcn_s_setprio(1); _Pragma("unroll") for (int m = 0; m < 4; ++m) _Pragma("unroll") for (int n = 0; n < 2; ++n) _Pragma("unroll") for (int k = 0; k < 2; ++k) \
        acc[ai][bj][m][n] = __builtin_amdgcn_mfma_f32_16x16x32_bf16(Bt[n][k], At[m][k], acc[ai][bj][m][n], 0, 0, 0); __builtin_amdgcn_s_setprio(0); } while (0)
#define PG8_WAIT_V(n) asm volatile("s_waitcnt vmcnt(" #n ")" ::: "memory")
#define PG8_WAIT_L(n) asm volatile("s_waitcnt lgkmcnt(" #n ")" ::: "memory")
#define PG8_BAR __builtin_amdgcn_s_barrier()
#define PG8_SCHED __builtin_amdgcn_sched_barrier(0)
    Unit cur, nxt; int ui = 0;
    if (!S.next(0, cur)) return;
    f32x4 acc[2][2][4][2];
#pragma unroll
    for (int a = 0; a < 2; ++a)
#pragma unroll
        for (int b = 0; b < 2; ++b)
#pragma unroll
            for (int m = 0; m < 4; ++m)
#pragma unroll
                for (int n = 0; n < 2; ++n) acc[a][b][m][n] = (f32x4){0.f, 0.f, 0.f, 0.f};
    bf16x8 At[4][2], B0[2][2], B1[2][2];
    const char* const cA = (const char*)g.A; const char* cB = (const char*)g.Bt + (size_t)cur.pn * tstep;
#pragma unroll
    for (int h = 0; h < 2; ++h)
#pragma unroll
        for (int i = 0; i < 2; ++i) gc[h][i] = (unsigned)rowtok[cur.pm * BM + h * HALF + rowA[i]] * K2 + colA2[i];
    S.a_ready(cur);
    PG8_STAGE(PG8_SB(0, 0), cB, voffB); PG8_STAGE(PG8_SA(0, 0), cA, gc[0]); PG8_STAGE(PG8_SB(0, 1), cB + hstep, voffB); PG8_STAGE(PG8_SA(0, 1), cA, gc[1]);
    if (wr == 1) PG8_BAR;
    PG8_WAIT_V(4); PG8_BAR;
    PG8_STAGE(PG8_SB(1, 0), cB + kstep, voffB); PG8_STAGE(PG8_SA(1, 0), cA + kstep, gc[0]); PG8_STAGE(PG8_SB(1, 1), cB + hstep + kstep, voffB);
    PG8_WAIT_V(6); PG8_BAR;
    PG8_STAMP();
    for (;;) {
        const bool has_next = S.next(ui + 1, nxt);
        const char* nB = has_next ? (const char*)g.Bt + (size_t)nxt.pn * tstep : cB;
#pragma unroll
        for (int h = 0; h < 2; ++h)
#pragma unroll
            for (int i = 0; i < 2; ++i) gn[h][i] = has_next ? (unsigned)rowtok[nxt.pm * BM + h * HALF + rowA[i]] * K2 + colA2[i] : gc[h][i];
        for (int t = 0; t < nt; t += 2) {
            const bool last = (t == nt - 2);
            const char* a1 = cA + (size_t)(t + 1) * kstep;
            const char* a2 = last ? cA : cA + (size_t)(t + 2) * kstep; const char* b2 = last ? nB : cB + (size_t)(t + 2) * kstep;
            const unsigned o20[2] = {last ? gn[0][0] : gc[0][0], last ? gn[0][1] : gc[0][1]}, o21[2] = {last ? gn[1][0] : gc[1][0], last ? gn[1][1] : gc[1][1]};
            const char* a3 = a2 + kstep; const char* b3 = b2 + kstep;
            if (last && has_next) S.a_ready(nxt);
            PG8_LDB(B0, 0, 0); PG8_SCHED; PG8_LDA(At, 0, 0); PG8_STAGE(PG8_SA(1, 1), a1, gc[1]);
            PG8_WAIT_L(8); PG8_BAR; PG8_WAIT_L(0); PG8_MMA(0, 0, At, B0); PG8_BAR; PG8_SCHED;
            PG8_LDB(B1, 0, 1); PG8_STAGE(PG8_SB(0, 0), b2, voffB);
            PG8_BAR; PG8_WAIT_L(0); PG8_MMA(0, 1, At, B1); PG8_BAR;
            PG8_LDA(At, 0, 1); PG8_STAGE(PG8_SA(0, 0), a2, o20);
            PG8_BAR; PG8_WAIT_L(0); PG8_MMA(1, 0, At, B0); PG8_BAR; PG8_SCHED;
            PG8_STAGE(PG8_SB(0, 1), b2 + hstep, voffB);
            PG8_WAIT_V(6); PG8_BAR; PG8_MMA(1, 1, At, B1); PG8_BAR;
            PG8_LDB(B0, 1, 0); PG8_SCHED; PG8_LDA(At, 1, 0); PG8_STAGE(PG8_SA(0, 1), a2, o21);
            PG8_WAIT_L(8); PG8_BAR; PG8_WAIT_L(0); PG8_MMA(0, 0, At, B0); PG8_BAR; PG8_SCHED;
            PG8_LDB(B1, 1, 1); PG8_STAGE(PG8_SB(1, 0), b3, voffB);
            PG8_BAR; PG8_WAIT_L(0); PG8_MMA(0, 1, At, B1); PG8_BAR;
            PG8_LDA(At, 1, 1); PG8_STAGE(PG8_SA(1, 0), a3, o20);
            PG8_BAR; PG8_WAIT_L(0); PG8_MMA(1, 0, At, B0); PG8_BAR; PG8_SCHED;
            PG8_STAGE(PG8_SB(1, 1), b3 + hstep, voffB);
            PG8_WAIT_V(6); PG8_BAR; PG8_MMA(1, 1, At, B1); PG8_BAR;
        }
        PG8_STAMP();
        if constexpr (!Epi::AFTER_DRAIN) { E(acc, cur, wr, wc, fr, fq); S.done(cur); }
        PG8_STAMP();
        if (!has_next) break;
#pragma unroll
        for (int a = 0; a < 2; ++a)
#pragma unroll
            for (int b = 0; b < 2; ++b)
#pragma unroll
                for (int m = 0; m < 4; ++m)
#pragma unroll
                    for (int n = 0; n < 2; ++n) acc[a][b][m][n] = (f32x4){0.f, 0.f, 0.f, 0.f};
        cur = nxt; cB = nB; ++ui;
#pragma unroll
        for (int h = 0; h < 2; ++h)
#pragma unroll
            for (int i = 0; i < 2; ++i) gc[h][i] = gn[h][i];
    }
    PG8_WAIT_V(0);
    if (wr == 0) PG8_BAR;
    PG8_BAR;
    if constexpr (Epi::AFTER_DRAIN) { E.fused(acc, cur, wr, wc, fr, fq, lds, wid, lane); S.done(cur); }
    PG8_STAMP();
    if (STAMP && wid == 0) { stamps[lane] = lane < nts ? (((unsigned long long)(unsigned)ts_hi << 32) | (unsigned)ts_lo) : 0ull;
        if (lane == 62) stamps[62] = rt_entry; if (lane == 63) stamps[63] = (unsigned long long)wall_clock64(); }
#undef PG8_STAMP
#undef PG8_SA
#undef PG8_SB
#undef PG8_STAGE
#undef PG8_LDA
#undef PG8_LDB
#undef PG8_MMA
#undef PG8_WAIT_V
#undef PG8_WAIT_L
#undef PG8_BAR
#undef PG8_SCHED
}
}
typedef pg8::bf16_t bf16_t;
typedef pg8::f32x4 f32x4;
typedef pg8::u32x4 u32x4;
typedef unsigned u32x2 __attribute__((ext_vector_type(2)));

constexpr int D = 1024, NBATCH = 16, SEQ = 2048, NTOK = NBATCH * SEQ, NGRP = 2, GBATCH = NBATCH / NGRP, GTOK = GBATCH * SEQ, NCHUNK = SEQ / 64;
constexpr int NP0 = 7168, NP1 = 8192, KO0 = 2048, KO1 = 3072;
constexpr float EPS = 1e-6f;
constexpr int C_MQ = 0, C_MK = 512, C_MV = 1024, C_MO = 2048, C_GQ = 3072, C_GZ = 6144, C_SM0 = 7168;
constexpr int C_AQ = 0, C_AK = 1024, C_AV = 2048, C_Z = 3072, C_XBC = 5120, C_DT = 8192;
constexpr int MOE_MAXROWS = 73728;
__device__ __forceinline__ size_t pjt(size_t row, int col, int nt) { return (((row >> 8) * nt + (size_t)(col >> 8)) << 16) + (((row >> 6) & 3) << 14) + ((size_t)((col >> 6) & 3) << 12) + ((row & 63) << 6) + (size_t)(col & 63); }
__device__ __forceinline__ size_t pj0(size_t row, int col) { return pjt(row, col, 28); }
__device__ __forceinline__ size_t pj1(size_t row, int col) { return pjt(row, col, 32); }

constexpr size_t MiB = 1ull << 20;
constexpr size_t WS_BAR = 0;
constexpr size_t WS_CNT = 128 * 1024;
constexpr size_t WS_PANEL = 132 * 1024;
constexpr size_t WS_ZERO_BYTES = 160 * 1024;
constexpr size_t WS_ROWTOK = 2 * MiB + 512 * 1024;
constexpr size_t WS_RW = 3 * MiB + 640 * 1024;
constexpr size_t WS_WSM1 = 3 * MiB + 128 * 1024;
constexpr size_t WS_WSM = 3 * MiB + 512 * 1024, WS_SM0 = 348 * MiB, WS_SM1 = 380 * MiB;
constexpr size_t WS_ROUTE_E = 1 * MiB, WS_ROUTE_W = WS_ROUTE_E + 256 * 1024, WS_POS = WS_ROUTE_W + 256 * 1024, WS_WROW = 2 * MiB, WS_GTOT = 3 * MiB;
constexpr size_t WS_WIN = 4 * MiB, WS_WOUT = 21 * MiB;
constexpr size_t WS_XB3 = 92 * MiB;
constexpr size_t WS_XC = 384 * MiB, WS_HN1A = 384 * MiB, WS_HN1B = 480 * MiB;
constexpr size_t WS_AOUT = 28 * MiB, WS_PROJ = 124 * MiB, WS_HN = 388 * MiB, WS_PREP = 356 * MiB;
constexpr size_t WS_H2P = 28 * MiB, WS_ACT = 172 * MiB, WS_YP = 208 * MiB, WS_W1 = 352 * MiB, WS_W2 = 384 * MiB;
constexpr size_t WS_END = 512 * MiB;
constexpr int LDS_BYTES = 163840, LDS_BAR_OFF = LDS_BYTES - 16;

struct Args { const float* in[30]; float* out; unsigned char* ws; int ph_lo, ph_hi, li, pad; };

struct Ctx {
    const float* const* in; float* out; unsigned char* ws; LAS unsigned char* lds;
    int tid, lane, wave, G, bid, wave0;
};

__device__ __forceinline__ float bf2f(bf16_t b) { return __uint_as_float(((unsigned)b) << 16); }
__device__ __forceinline__ bf16_t f2bf(float f) { unsigned u = __float_as_uint(f); u += 0x7fffu + ((u >> 16) & 1u); return (bf16_t)(u >> 16); }
__device__ __forceinline__ unsigned pk2(float lo, float hi) { return (unsigned)f2bf(lo) | ((unsigned)f2bf(hi) << 16); }
template <int CTRL> __device__ __forceinline__ float dpp_(float v) { return __builtin_bit_cast(float, __builtin_amdgcn_update_dpp(0, __builtin_bit_cast(int, v), CTRL, 0xf, 0xf, true)); }
__device__ __forceinline__ float quad_sum(float v) { v += dpp_<0xB1>(v); v += dpp_<0x4E>(v); return v; }
__device__ __forceinline__ float row_sum16(float v) { v = quad_sum(v); v += dpp_<0x124>(v); v += dpp_<0x128>(v); return v; }
__device__ __forceinline__ float rdl_(float v, int l) { return __builtin_bit_cast(float, __builtin_amdgcn_readlane(__builtin_bit_cast(int, v), l)); }
__device__ __forceinline__ float wave_sum(float v) { v = row_sum16(v); return (rdl_(v, 0) + rdl_(v, 16)) + (rdl_(v, 32) + rdl_(v, 48)); }
__device__ __forceinline__ float half_sum(float v, int lane) {
    v = row_sum16(v); const float lo = rdl_(v, 0) + rdl_(v, 16), hi = rdl_(v, 32) + rdl_(v, 48); return (lane & 32) ? hi : lo;
}
__device__ __forceinline__ float frcp_(float x) { return __builtin_amdgcn_rcpf(x); }
__device__ __forceinline__ float sigmoidf_(float x) { return frcp_(1.f + __expf(-x)); }
__device__ __forceinline__ float siluf_(float x) { return x * frcp_(1.f + __expf(-x)); }
__device__ __forceinline__ float softplusf_(float x) { return x > 20.f ? x : log1pf(expf(x)); }
__device__ __forceinline__ int lds_inc(LAS int* p) { return __hip_atomic_fetch_add(p, 1, __ATOMIC_RELAXED, __HIP_MEMORY_SCOPE_WORKGROUP); }
#define LDS_WAIT() asm volatile("s_waitcnt lgkmcnt(0)" ::: "memory")

__device__ __forceinline__ void st8_wt(void* p, u32x2 v) { __hip_atomic_store((unsigned long long*)p, __builtin_bit_cast(unsigned long long, v), __ATOMIC_RELAXED, __HIP_MEMORY_SCOPE_AGENT); }
namespace pg8 {
__device__ __forceinline__ void st16_wt(void* p, u32x4 v) { asm volatile("global_store_dwordx4 %0, %1, off sc1\n\ts_nop 1" :: "v"(p), "v"(v) : "memory"); }
struct EpiBf16P {
    static constexpr bool PERM = true, AFTER_DRAIN = false;
    bf16_t* O; int ldc; int pn_mask;
    __device__ __forceinline__ void operator()(const f32x4 (&acc)[2][2][4][2], const Unit& u, int wr, int wc, int fr, int fq) const {
        const int row0 = u.pm * BM + wr * 64 + fr; const int col0 = (u.pn & pn_mask) * BM + wc * 32 + 8 * fq;
#pragma unroll
        for (int ai = 0; ai < 2; ++ai)
#pragma unroll
            for (int m = 0; m < 4; ++m) { bf16_t* rowp = O + (size_t)(row0 + ai * HALF + m * 16) * ldc + col0;
#pragma unroll
                for (int bj = 0; bj < 2; ++bj) { const f32x4 v0 = acc[ai][bj][m][0], v1 = acc[ai][bj][m][1];
                    u32x4 w; w.x = cvt_pk_bf16(v0[0], v0[1]); w.y = cvt_pk_bf16(v0[2], v0[3]); w.z = cvt_pk_bf16(v1[0], v1[1]); w.w = cvt_pk_bf16(v1[2], v1[3]);
                    *(u32x4*)(rowp + bj * HALF) = w; } }
    }
};
struct EpiBf16QK {
    static constexpr bool PERM = true, AFTER_DRAIN = false;
    bf16_t* O; int ldc; const PG8_LAS float* gn;
    __device__ __forceinline__ void operator()(const f32x4 (&acc)[2][2][4][2], const Unit& u, int wr, int wc, int fr, int fq) const {
        const int row0 = u.pm * BM + wr * 64 + fr;
        if (u.pn < 8) {
            const PG8_LAS float* gp = gn + (u.pn >= 4 ? 64 : 0) + 8 * fq;
            f32x4 gq[2][2];
#pragma unroll
            for (int bj = 0; bj < 2; ++bj)
#pragma unroll
                for (int n = 0; n < 2; ++n) gq[bj][n] = *(const PG8_LAS f32x4*)(gp + bj * 32 + n * 4);
            const int col0 = u.pn * BM + wc * 64 + 8 * fq;
#pragma unroll
            for (int ai = 0; ai < 2; ++ai)
#pragma unroll
                for (int m = 0; m < 4; ++m) { bf16_t* rowp = O + (size_t)(row0 + ai * HALF + m * 16) * ldc + col0;
                    float ss = 0.f;
#pragma unroll
                    for (int bj = 0; bj < 2; ++bj)
#pragma unroll
                        for (int n = 0; n < 2; ++n) { const f32x4 v = acc[ai][bj][m][n]; ss += v[0] * v[0] + v[1] * v[1] + v[2] * v[2] + v[3] * v[3]; }
                    ss += __shfl_xor(ss, 16); ss += __shfl_xor(ss, 32);
                    const float rs = __builtin_amdgcn_rsqf(ss * (1.f / 64.f) + 1e-6f);
#pragma unroll
                    for (int bj = 0; bj < 2; ++bj) { const f32x4 v0 = acc[ai][bj][m][0] * gq[bj][0] * rs, v1 = acc[ai][bj][m][1] * gq[bj][1] * rs;
                        u32x4 w; w.x = cvt_pk_bf16(v0[0], v0[1]); w.y = cvt_pk_bf16(v0[2], v0[3]); w.z = cvt_pk_bf16(v1[0], v1[1]); w.w = cvt_pk_bf16(v1[2], v1[3]);
                        *(u32x4*)(rowp + bj * 32) = w; } }
        } else {
            const int col0 = u.pn * BM + wc * 32 + 8 * fq;
#pragma unroll
            for (int ai = 0; ai < 2; ++ai)
#pragma unroll
                for (int m = 0; m < 4; ++m) { bf16_t* rowp = O + (size_t)(row0 + ai * HALF + m * 16) * ldc + col0;
#pragma unroll
                    for (int bj = 0; bj < 2; ++bj) { const f32x4 v0 = acc[ai][bj][m][0], v1 = acc[ai][bj][m][1];
                        u32x4 w; w.x = cvt_pk_bf16(v0[0], v0[1]); w.y = cvt_pk_bf16(v0[2], v0[3]); w.z = cvt_pk_bf16(v1[0], v1[1]); w.w = cvt_pk_bf16(v1[2], v1[3]);
                        *(u32x4*)(rowp + bj * HALF) = w; } }
        }
    }
};
template <bool QKN> struct EpiBf16QKT {
    static constexpr bool PERM = true, AFTER_DRAIN = false;
    bf16_t* O; int ldc; const PG8_LAS float* gn; PG8_LAS unsigned char* scr;
    __device__ __forceinline__ void operator()(const f32x4 (&acc)[2][2][4][2], const Unit& u, int wr, int wc, int fr, int fq) const {
        PG8_LAS unsigned char* sw = scr + (wr * 4 + wc) * 2304;
        PG8_LAS unsigned char* swr = sw + fr * 144 + fq * 16;
        const int lane = fq * 16 + fr; const PG8_LAS unsigned char* srd = sw + (lane >> 3) * 144 + (lane & 7) * 16;
        bf16_t* orow = O + (((size_t)u.pm * ldc + u.pn) << 16) + (wr * 4 + wc) * 4096 + (lane >> 3) * 64 + (lane & 7) * 8;
        const bool qk = QKN && u.pn < 8;
        f32x4 gq[2][2];
        if (qk) { const PG8_LAS float* gp = gn + (u.pn >= 4 ? 64 : 0) + 8 * fq;
#pragma unroll
            for (int bj = 0; bj < 2; ++bj)
#pragma unroll
                for (int n = 0; n < 2; ++n) gq[bj][n] = *(const PG8_LAS f32x4*)(gp + bj * 32 + n * 4); }
        u32x4 po0, po1;
#pragma unroll
        for (int pc = 0; pc < 8; ++pc) { const int ai = pc >> 2, m = pc & 3;
                float rs = 1.f;
                if (qk) { float ss = 0.f;
#pragma unroll
                    for (int bj = 0; bj < 2; ++bj)
#pragma unroll
                        for (int n = 0; n < 2; ++n) { const f32x4 v = acc[ai][bj][m][n]; ss += v[0] * v[0] + v[1] * v[1] + v[2] * v[2] + v[3] * v[3]; }
                    ss += __shfl_xor(ss, 16); ss += __shfl_xor(ss, 32);
                    rs = __builtin_amdgcn_rsqf(ss * (1.f / 64.f) + 1e-6f); }
#pragma unroll
                for (int bj = 0; bj < 2; ++bj) { f32x4 v0 = acc[ai][bj][m][0], v1 = acc[ai][bj][m][1];
                    if (qk) { v0 = v0 * gq[bj][0] * rs; v1 = v1 * gq[bj][1] * rs; }
                    u32x4 w; w.x = cvt_pk_bf16(v0[0], v0[1]); w.y = cvt_pk_bf16(v0[2], v0[3]); w.z = cvt_pk_bf16(v1[0], v1[1]); w.w = cvt_pk_bf16(v1[2], v1[3]);
                    *(PG8_LAS u32x4*)(swr + bj * 64) = w; }
                const u32x4 o0 = *(const PG8_LAS u32x4*)(srd), o1 = *(const PG8_LAS u32x4*)(srd + 8 * 144);
                if (pc > 0) { const int pa = (pc - 1) >> 2, pm_ = (pc - 1) & 3; st16_wt(orow + pa * 32768 + (pm_ * 16) * 64, po0); st16_wt(orow + pa * 32768 + (pm_ * 16 + 8) * 64, po1); }
                po0 = o0; po1 = o1;
        }
        st16_wt(orow + 32768 + (3 * 16) * 64, po0); st16_wt(orow + 32768 + (3 * 16 + 8) * 64, po1);
    }
};
struct EpiResid {
    static constexpr bool PERM = false, AFTER_DRAIN = false;
    const float* xin; float* out; int ldc;
    __device__ __forceinline__ void operator()(const f32x4 (&acc)[2][2][4][2], const Unit& u, int wr, int wc, int fr, int fq) const {
        const int row0 = u.pm * BM + wr * 64 + fr, col0 = u.pn * BM + wc * 32 + 4 * fq;
#pragma unroll
        for (int ai = 0; ai < 2; ++ai)
#pragma unroll
            for (int m = 0; m < 4; ++m) { const size_t ro = (size_t)(row0 + ai * HALF + m * 16) * ldc + col0;
#pragma unroll
                for (int bj = 0; bj < 2; ++bj)
#pragma unroll
                    for (int n = 0; n < 2; ++n) { const f32x4 r = *(const f32x4*)(xin + ro + bj * HALF + n * 16); *(f32x4*)(out + ro + bj * HALF + n * 16) = r + acc[ai][bj][m][n]; } }
    }
};
template <bool IN_BF16> struct EpiResidB {
    static constexpr bool PERM = true, AFTER_DRAIN = false;
    const void* xin; bf16_t* out; int ldc;
    __device__ __forceinline__ void operator()(const f32x4 (&acc)[2][2][4][2], const Unit& u, int wr, int wc, int fr, int fq) const {
        const int row0 = u.pm * BM + wr * 64 + fr, col0 = u.pn * BM + wc * 32 + 8 * fq;
#pragma unroll
        for (int ai = 0; ai < 2; ++ai)
#pragma unroll
            for (int m = 0; m < 4; ++m) { const size_t ro = (size_t)(row0 + ai * HALF + m * 16) * ldc + col0;
#pragma unroll
                for (int bj = 0; bj < 2; ++bj) { f32x4 r0, r1;
                    if (IN_BF16) { const u32x4 raw = *(const u32x4*)((const bf16_t*)xin + ro + bj * HALF);
                        r0 = (f32x4){__uint_as_float(raw.x << 16), __uint_as_float(raw.x & 0xffff0000u), __uint_as_float(raw.y << 16), __uint_as_float(raw.y & 0xffff0000u)};
                        r1 = (f32x4){__uint_as_float(raw.z << 16), __uint_as_float(raw.z & 0xffff0000u), __uint_as_float(raw.w << 16), __uint_as_float(raw.w & 0xffff0000u)}; }
                    else { r0 = *(const f32x4*)((const float*)xin + ro + bj * HALF); r1 = *(const f32x4*)((const float*)xin + ro + bj * HALF + 4); }
                    r0 = r0 + acc[ai][bj][m][0]; r1 = r1 + acc[ai][bj][m][1];
                    u32x4 w; w.x = cvt_pk_bf16(r0[0], r0[1]); w.y = cvt_pk_bf16(r0[2], r0[3]); w.z = cvt_pk_bf16(r1[0], r1[1]); w.w = cvt_pk_bf16(r1[2], r1[3]);
                    *(u32x4*)(out + ro + bj * HALF) = w; } }
    }
};
struct EpiSwiGLU {
    static constexpr bool PERM = true, AFTER_DRAIN = false;
    bf16_t* O; const float* wrow;
    __device__ __forceinline__ void operator()(const f32x4 (&acc)[2][2][4][2], const Unit& u, int wr, int wc, int fr, int fq) const {
        const int row0 = u.pm * BM + wr * 64 + fr; const int col0 = (u.pn & 1) * HALF + wc * 32 + 8 * fq;
#pragma unroll
        for (int ai = 0; ai < 2; ++ai)
#pragma unroll
            for (int m = 0; m < 4; ++m) { const int row = row0 + ai * HALF + m * 16; const float w = wrow[row];
                float o[8];
#pragma unroll
                for (int n = 0; n < 2; ++n)
#pragma unroll
                    for (int e = 0; e < 4; ++e) { const float g = acc[ai][0][m][n][e], up = acc[ai][1][m][n][e]; o[4 * n + e] = g * __builtin_amdgcn_rcpf(1.f + __expf(-g)) * up * w; }
                u32x4 pk; pk.x = cvt_pk_bf16(o[0], o[1]); pk.y = cvt_pk_bf16(o[2], o[3]); pk.z = cvt_pk_bf16(o[4], o[5]); pk.w = cvt_pk_bf16(o[6], o[7]);
                *(u32x4*)(O + (size_t)row * 256 + col0) = pk; }
    }
};
struct MoeOrder {
    const int* panel_expert; int nunits, G, c, shift;
    __device__ __forceinline__ bool next(int i, Unit& u) const {
        const long L = (long)i * G + c; if (L >= nunits) return false;
        const int p = (int)(L >> shift); const int e = panel_expert[p]; u.pm = p; u.pn = (e << shift) + (int)(L & ((1 << shift) - 1)); return true;
    }
    __device__ __forceinline__ void a_ready(const Unit&) const {}
    __device__ __forceinline__ void done(const Unit&) const {}
};
}

__device__ __forceinline__ void tr_item(const float* __restrict__ W, int ldw, int col0, int K, bf16_t* WT, int drow0, LAS float* scr, int kb, int nb, int lane) {
    const int k0 = 64 * kb, n0 = col0 + 32 * nb;
#pragma unroll
    for (int i = 0; i < 8; ++i) { const int idx = lane + 64 * i; const int kk = idx >> 3, n4 = (idx & 7) * 4;
        const f32x4 v = *(const f32x4*)(W + (size_t)(k0 + kk) * ldw + n0 + n4); LAS float* d = scr + kk * 33 + n4; d[0] = v[0]; d[1] = v[1]; d[2] = v[2]; d[3] = v[3]; }
    LDS_WAIT();
    const int c = lane & 7;
#pragma unroll
    for (int j = 0; j < 4; ++j) { const int n = (lane >> 3) + 8 * j; const LAS float* s = scr + (8 * c) * 33 + n;
        u32x4 o; o.x = pg8::cvt_pk_bf16(s[0 * 33], s[1 * 33]); o.y = pg8::cvt_pk_bf16(s[2 * 33], s[3 * 33]); o.z = pg8::cvt_pk_bf16(s[4 * 33], s[5 * 33]); o.w = pg8::cvt_pk_bf16(s[6 * 33], s[7 * 33]);
        *(u32x4*)(WT + (size_t)(drow0 + n) * K + k0 + 8 * c) = o; }
    LDS_WAIT();
}
__device__ __forceinline__ bool tr_seg(int& r, const float* W, int ldw, int col0, int ncols, int K, bf16_t* WT, int drow0, LAS float* scr, int lane, int qkblocks = 0) {
    const int nblk = ncols / 32, items = (K / 64) * nblk;
    if (r < items) { const int kb = r / nblk, nb = r % nblk;
        int nbd = nb; if (nb < qkblocks) { const int lb = nb & 7; nbd = (nb & ~7) + (lb & 1) * 4 + (lb >> 1); }
        tr_item(W, ldw, col0, K, WT, drow0 + 32 * nbd, scr, kb, nb, lane); return true; }
    r -= items; return false;
}
__device__ __forceinline__ void phase_convert(const Ctx& C, int layer, int rank, int nwork) {
    LAS float* scr = (LAS float*)(C.lds + C.wave * 8448);
    const int gw = rank * 8 + C.wave, NGW = nwork * 8;
    bf16_t* Win = (bf16_t*)(C.ws + WS_WIN); bf16_t* Wout = (bf16_t*)(C.ws + WS_WOUT);
    const int IT_IN = (layer == 0) ? (16 * 96 + 16 * 128) : (16 * 256);
    const int IT_OUT = (layer == 0) ? (32 * 32) : (48 * 32);
    const int NITEMS = IT_IN + IT_OUT;
    for (int it = gw; it < NITEMS; it += NGW) {
        int r = it;
        if (layer == 0) {
            if (tr_seg(r, C.in[3], 7192, 0, 3072, 1024, Win, 0, scr, C.lane, 96)) continue;
            if (tr_seg(r, C.in[3], 7192, 3080, 4096, 1024, Win, 3072, scr, C.lane, 128)) continue;
            if (tr_seg(r, C.in[11], 1024, 0, 1024, 2048, Wout, 0, scr, C.lane)) continue;
        } else {
            if (tr_seg(r, C.in[12], 8224, 0, 8192, 1024, Win, 0, scr, C.lane, 256)) continue;
            if (tr_seg(r, C.in[22], 1024, 0, 1024, 3072, Wout, 0, scr, C.lane)) continue;
        }
    }
    if (layer == 0) { float* RW = (float*)(C.ws + WS_RW);
        for (size_t idx = (size_t)C.bid * 512 + C.tid; idx < 2 * 36 * 1024; idx += (size_t)C.G * 512) { const int l = (int)(idx / (36 * 1024)), rem = (int)(idx % (36 * 1024)), cc = rem >> 10, k = rem & 1023;
            RW[idx] = cc < 4 ? C.in[23][(size_t)l * 4096 + k * 4 + cc] : C.in[25][(size_t)l * 32768 + k * 32 + (cc - 4)]; } }
    if (layer == 0) {
        float* WSM0 = (float*)(C.ws + WS_WSM); float* WSM1 = (float*)(C.ws + WS_WSM1);
        const size_t gt = (size_t)C.bid * 512 + C.tid, GT = (size_t)C.G * 512;
        for (size_t idx = gt; idx < 2 * 32 * 1024; idx += GT) {
            const int l = (int)(idx >> 15), rr = (int)((idx >> 10) & 31), k = (int)(idx & 1023); float v = 0.f;
            if (l == 0) { const int sc = rr < 8 ? 3072 + rr : (rr < 24 ? 7176 + (rr - 8) : -1); if (sc >= 0) v = C.in[3][(size_t)k * 7192 + sc]; WSM0[idx & 32767] = v; }
            else { v = C.in[12][(size_t)k * 8224 + 8192 + rr]; WSM1[idx & 32767] = v; }
        }
    }
}
struct TrJob { const float* src; int ldw, K; bf16_t* dst; };
__device__ __forceinline__ TrJob moe_job(int it, const float* wg, const float* wu, const float* wd, bf16_t* W1, bf16_t* W2) {
    const int IT_MOE = 32 * 128; TrJob j; int r = it;
    if (r < 2 * IT_MOE) { const bool up = r >= IT_MOE; if (up) r -= IT_MOE; const int e = r >> 7, q = r & 127, kb = q >> 3, nb = q & 7;
        j.src = (up ? wu : wg) + (size_t)e * 1024 * 256 + (size_t)(64 * kb) * 256 + 32 * nb; j.ldw = 256; j.K = 1024;
        j.dst = W1 + (size_t)(e * 512 + (up ? 128 : 0) + (nb < 4 ? 32 * nb : 256 + 32 * (nb - 4))) * 1024 + 64 * kb; return j; }
    r -= 2 * IT_MOE; { const int e = r >> 7, q = r & 127, kb = q >> 5, nb = q & 31;
        j.src = wd + (size_t)e * 256 * 1024 + (size_t)(64 * kb) * 1024 + 32 * nb; j.ldw = 1024; j.K = 256; j.dst = W2 + (size_t)(e * 1024 + 32 * nb) * 256 + 64 * kb; return j; }
}
__device__ __forceinline__ void phase_convert_moe(const Ctx& C, int layer) {
    LAS float* scr = (LAS float*)(C.lds + C.wave * 8448);
    const int gw = C.bid * 8 + C.wave, NGW = C.G * 8; const int lane = C.lane;
    bf16_t* W1 = (bf16_t*)(C.ws + WS_W1); bf16_t* W2 = (bf16_t*)(C.ws + WS_W2);
    const float* wg = C.in[27] + (size_t)layer * 32 * 1024 * 256; const float* wu = C.in[28] + (size_t)layer * 32 * 1024 * 256; const float* wd = C.in[29] + (size_t)layer * 32 * 256 * 1024;
    const int NIT = 3 * 32 * 128;
    f32x4 nx[8];
#define TR_LOAD(job) do { _Pragma("unroll") for (int i = 0; i < 8; ++i) { const int idx = lane + 64 * i; nx[i] = *(const f32x4*)((job).src + (size_t)(idx >> 3) * (job).ldw + (idx & 7) * 4); } } while (0)
    if (gw < NIT) { const TrJob j0 = moe_job(gw, wg, wu, wd, W1, W2); TR_LOAD(j0); }
    for (int it = gw; it < NIT; it += NGW) {
        const TrJob cur = moe_job(it, wg, wu, wd, W1, W2);
#pragma unroll
        for (int i = 0; i < 8; ++i) { const int idx = lane + 64 * i; LAS float* d = scr + (idx >> 3) * 33 + (idx & 7) * 4; d[0] = nx[i][0]; d[1] = nx[i][1]; d[2] = nx[i][2]; d[3] = nx[i][3]; }
        if (it + NGW < NIT) { const TrJob nj = moe_job(it + NGW, wg, wu, wd, W1, W2); TR_LOAD(nj); }
        LDS_WAIT();
        const int c = lane & 7;
#pragma unroll
        for (int j = 0; j < 4; ++j) { const int n = (lane >> 3) + 8 * j; const LAS float* s = scr + (8 * c) * 33 + n;
            u32x4 o; o.x = pg8::cvt_pk_bf16(s[0 * 33], s[1 * 33]); o.y = pg8::cvt_pk_bf16(s[2 * 33], s[3 * 33]); o.z = pg8::cvt_pk_bf16(s[4 * 33], s[5 * 33]); o.w = pg8::cvt_pk_bf16(s[6 * 33], s[7 * 33]);
            *(u32x4*)(cur.dst + (size_t)n * cur.K + 8 * c) = o; }
        LDS_WAIT();
    }
#undef TR_LOAD
}

constexpr int SP_RS = 2064, SP_IMG = 16 * SP_RS;
struct SmallProjW { pg8::bf16x8 wh[4][2], wl[4][2]; };
__device__ __forceinline__ void smallproj_load(SmallProjW& W, const float* WSM, int wave, int lane) {
#pragma unroll
    for (int kb = 0; kb < 4; ++kb)
#pragma unroll
        for (int nt = 0; nt < 2; ++nt) { const int n = nt * 16 + (lane & 15), k = (4 * wave + kb) * 32 + 8 * (lane >> 4);
            const f32x4 a = *(const f32x4*)(WSM + (size_t)n * 1024 + k), b = *(const f32x4*)(WSM + (size_t)n * 1024 + k + 4);
            u32x4 h, l;
            h.x = pg8::cvt_pk_bf16(a[0], a[1]); h.y = pg8::cvt_pk_bf16(a[2], a[3]); h.z = pg8::cvt_pk_bf16(b[0], b[1]); h.w = pg8::cvt_pk_bf16(b[2], b[3]);
            l.x = pg8::cvt_pk_bf16(a[0] - __uint_as_float(h.x << 16), a[1] - __uint_as_float(h.x & 0xffff0000u)); l.y = pg8::cvt_pk_bf16(a[2] - __uint_as_float(h.y << 16), a[3] - __uint_as_float(h.y & 0xffff0000u));
            l.z = pg8::cvt_pk_bf16(b[0] - __uint_as_float(h.z << 16), b[1] - __uint_as_float(h.z & 0xffff0000u)); l.w = pg8::cvt_pk_bf16(b[2] - __uint_as_float(h.w << 16), b[3] - __uint_as_float(h.w & 0xffff0000u));
            W.wh[kb][nt] = __builtin_bit_cast(pg8::bf16x8, h); W.wl[kb][nt] = __builtin_bit_cast(pg8::bf16x8, l); }
}
__device__ __forceinline__ u32x2 smallproj_put(LAS unsigned char* img, int irow, int lane, int j, const f32x4 v) {
    u32x2 h, l; h.x = pg8::cvt_pk_bf16(v[0], v[1]); h.y = pg8::cvt_pk_bf16(v[2], v[3]);
    l.x = pg8::cvt_pk_bf16(v[0] - __uint_as_float(h.x << 16), v[1] - __uint_as_float(h.x & 0xffff0000u)); l.y = pg8::cvt_pk_bf16(v[2] - __uint_as_float(h.y << 16), v[3] - __uint_as_float(h.y & 0xffff0000u));
    const int ob = irow * SP_RS + (4 * lane + 256 * j) * 2;
    *(LAS u32x2*)(img + ob) = h; *(LAS u32x2*)(img + SP_IMG + ob) = l; return h;
}
__device__ __forceinline__ void smallproj_tile(const SmallProjW& W, LAS unsigned char* img, LAS float* part, float* smt, int wave, int lane, int tid) {
    f32x4 acc[2];
#pragma unroll
    for (int nt = 0; nt < 2; ++nt) acc[nt] = (f32x4){0.f, 0.f, 0.f, 0.f};
#pragma unroll
    for (int kb = 0; kb < 4; ++kb) { const int ob = (lane & 15) * SP_RS + ((4 * wave + kb) * 32 + 8 * (lane >> 4)) * 2;
        const pg8::bf16x8 ah = *(const LAS pg8::bf16x8*)(img + ob), al = *(const LAS pg8::bf16x8*)(img + SP_IMG + ob);
#pragma unroll
        for (int nt = 0; nt < 2; ++nt) { acc[nt] = __builtin_amdgcn_mfma_f32_16x16x32_bf16(ah, W.wh[kb][nt], acc[nt], 0, 0, 0);
            acc[nt] = __builtin_amdgcn_mfma_f32_16x16x32_bf16(al, W.wh[kb][nt], acc[nt], 0, 0, 0); acc[nt] = __builtin_amdgcn_mfma_f32_16x16x32_bf16(ah, W.wl[kb][nt], acc[nt], 0, 0, 0); } }
#pragma unroll
    for (int nt = 0; nt < 2; ++nt)
#pragma unroll
        for (int j = 0; j < 4; ++j) part[(wave * 2 + nt) * 256 + j * 64 + lane] = acc[nt][j];
    __syncthreads();
    { float s = 0.f;
#pragma unroll
      for (int w = 0; w < 8; ++w) s += part[w * 512 + tid];
      const int nt = tid >> 8, j = (tid >> 6) & 3, l = tid & 63; smt[(4 * (l >> 4) + j) * 32 + nt * 16 + (l & 15)] = s; }
}
__device__ __forceinline__ void phase_norm(const Ctx& C, const float* WSM, const float* x, const float* gain, bf16_t* out, float* sm, int nrows, int vb, int nb) {
    LAS unsigned char* img = C.lds; LAS float* part = (LAS float*)(C.lds + 2 * SP_IMG);
    __syncthreads();
    SmallProjW W; smallproj_load(W, WSM, C.wave, C.lane);
    const int lane = C.lane, w2 = 2 * C.wave;
    f32x4 g[4];
#pragma unroll
    for (int j = 0; j < 4; ++j) g[j] = *(const f32x4*)(gain + 4 * lane + 256 * j);
    f32x4 nx[2][4];
    if (vb < nrows / 16) {
#pragma unroll
        for (int i = 0; i < 2; ++i)
#pragma unroll
            for (int j = 0; j < 4; ++j) nx[i][j] = *(const f32x4*)(x + (size_t)(vb * 16 + w2 + i) * D + 4 * lane + 256 * j); }
    for (int tile = vb; tile < nrows / 16; tile += nb) {
        f32x4 cx[2][4];
#pragma unroll
        for (int i = 0; i < 2; ++i)
#pragma unroll
            for (int j = 0; j < 4; ++j) cx[i][j] = nx[i][j];
        if (tile + nb < nrows / 16) {
#pragma unroll
            for (int i = 0; i < 2; ++i)
#pragma unroll
                for (int j = 0; j < 4; ++j) nx[i][j] = *(const f32x4*)(x + (size_t)((tile + nb) * 16 + w2 + i) * D + 4 * lane + 256 * j); }
#pragma unroll
        for (int i = 0; i < 2; ++i) { const size_t r = (size_t)tile * 16 + w2 + i; float ss = 0.f;
#pragma unroll
            for (int j = 0; j < 4; ++j) ss += cx[i][j][0] * cx[i][j][0] + cx[i][j][1] * cx[i][j][1] + cx[i][j][2] * cx[i][j][2] + cx[i][j][3] * cx[i][j][3];
            const float rs = rsqrtf(wave_sum(ss) * (1.f / D) + EPS);
#pragma unroll
            for (int j = 0; j < 4; ++j) { const u32x2 h = smallproj_put(img, w2 + i, lane, j, cx[i][j] * rs * g[j]); st8_wt(out + r * D + 4 * lane + 256 * j, h); } }
        __syncthreads();
        smallproj_tile(W, img, part, sm + (size_t)tile * 16 * 32, C.wave, lane, C.tid);
        __syncthreads();
    }
}

__device__ __forceinline__ float fsig_(float x) { return frcp_(1.f + __expf(-x)); }
__device__ __forceinline__ void phase_gate0(const Ctx& C, const bf16_t* P, bf16_t* AO) {
    const int gw = C.bid * 8 + C.wave, NGW = C.G * 8; const int lane = C.lane;
    f32x4 mn[4]; const f32x4 gn = *(const f32x4*)(C.in[10] + ((4 * lane) & 127));
#pragma unroll
    for (int j = 0; j < 4; ++j) mn[j] = *(const f32x4*)(C.in[6] + 4 * lane + 256 * j);
    u32x2 nr[8], nz[8];
#define G0_LOAD(row) do { const bf16_t* ar_ = AO + (size_t)(row) * KO0 + 4 * lane; const bf16_t* pm_ = P + pj0((size_t)(row), C_MO + 4 * lane); const bf16_t* pg_ = P + pj0((size_t)(row), C_GZ + 4 * lane); \
        _Pragma("unroll") for (int j = 0; j < 4; ++j) { nr[j] = *(const u32x2*)(ar_ + 256 * j); nz[j] = *(const u32x2*)(pm_ + 65536 * j); nr[4 + j] = *(const u32x2*)(ar_ + 1024 + 256 * j); nz[4 + j] = *(const u32x2*)(pg_ + 65536 * j); } } while (0)
    if (gw < GTOK) G0_LOAD(gw);
    for (int r = gw; r < GTOK; r += NGW) {
        u32x2 cr[8], cz[8];
#pragma unroll
        for (int j = 0; j < 8; ++j) { cr[j] = nr[j]; cz[j] = nz[j]; }
        if (r + NGW < GTOK) G0_LOAD(r + NGW);
        bf16_t* ar = AO + (size_t)r * KO0 + 4 * lane;
#pragma unroll
        for (int j = 0; j < 8; ++j) {
            const float v[4] = {__uint_as_float(cr[j].x << 16), __uint_as_float(cr[j].x & 0xffff0000u), __uint_as_float(cr[j].y << 16), __uint_as_float(cr[j].y & 0xffff0000u)};
            const float z[4] = {__uint_as_float(cz[j].x << 16), __uint_as_float(cz[j].x & 0xffff0000u), __uint_as_float(cz[j].y << 16), __uint_as_float(cz[j].y & 0xffff0000u)};
            const float sq = v[0] * v[0] + v[1] * v[1] + v[2] * v[2] + v[3] * v[3];
            float o[4];
            if (j < 4) { const float rstd = rsqrtf(wave_sum(sq) * (1.f / 256.f) + EPS);
#pragma unroll
                for (int e = 0; e < 4; ++e) o[e] = v[e] * rstd * mn[j][e] * fsig_(z[e]); }
            else { const float rstd = rsqrtf(half_sum(sq, C.lane) * (1.f / 128.f) + EPS);
#pragma unroll
                for (int e = 0; e < 4; ++e) o[e] = v[e] * rstd * gn[e] * z[e] * fsig_(z[e]); }
            u32x2 w; w.x = pg8::cvt_pk_bf16(o[0], o[1]); w.y = pg8::cvt_pk_bf16(o[2], o[3]); st8_wt(ar + 256 * j, w); }
    }
#undef G0_LOAD
}
__device__ __forceinline__ void phase_gate1(const Ctx& C, const bf16_t* P, bf16_t* AO) {
    const int gw = C.bid * 8 + C.wave, NGW = C.G * 8; const int lane = C.lane;
    f32x4 sn[8];
#pragma unroll
    for (int j = 0; j < 8; ++j) sn[j] = *(const f32x4*)(C.in[21] + 4 * lane + 256 * j);
    u32x2 nr[8], nz[8];
#define G1_LOAD(row) do { const bf16_t* ar_ = AO + (size_t)(row) * KO1 + 1024 + 4 * lane; const bf16_t* pr_ = P + pj1((size_t)(row), C_Z + 4 * lane); \
        _Pragma("unroll") for (int j = 0; j < 8; ++j) { nr[j] = *(const u32x2*)(ar_ + 256 * j); nz[j] = *(const u32x2*)(pr_ + 65536 * j); } } while (0)
    if (gw < GTOK) G1_LOAD(gw);
    for (int r = gw; r < GTOK; r += NGW) {
        u32x2 cr[8], cz[8];
#pragma unroll
        for (int j = 0; j < 8; ++j) { cr[j] = nr[j]; cz[j] = nz[j]; }
        if (r + NGW < GTOK) G1_LOAD(r + NGW);
        bf16_t* ar = AO + (size_t)r * KO1 + 1024 + 4 * lane;
#pragma unroll
        for (int gq = 0; gq < 4; ++gq) { float y[8]; float ss = 0.f;
#pragma unroll
            for (int jj = 0; jj < 2; ++jj) { const int j = 2 * gq + jj;
                const float v[4] = {__uint_as_float(cr[j].x << 16), __uint_as_float(cr[j].x & 0xffff0000u), __uint_as_float(cr[j].y << 16), __uint_as_float(cr[j].y & 0xffff0000u)};
                const float z[4] = {__uint_as_float(cz[j].x << 16), __uint_as_float(cz[j].x & 0xffff0000u), __uint_as_float(cz[j].y << 16), __uint_as_float(cz[j].y & 0xffff0000u)};
#pragma unroll
                for (int e = 0; e < 4; ++e) { y[4 * jj + e] = v[e] * z[e] * fsig_(z[e]); ss += y[4 * jj + e] * y[4 * jj + e]; } }
            const float rstd = rsqrtf(wave_sum(ss) * (1.f / 512.f) + EPS);
#pragma unroll
            for (int jj = 0; jj < 2; ++jj) { const int j = 2 * gq + jj; u32x2 w;
                w.x = pg8::cvt_pk_bf16(y[4 * jj] * rstd * sn[j][0], y[4 * jj + 1] * rstd * sn[j][1]); w.y = pg8::cvt_pk_bf16(y[4 * jj + 2] * rstd * sn[j][2], y[4 * jj + 3] * rstd * sn[j][3]); st8_wt(ar + 256 * j, w); } }
    }
#undef G1_LOAD
}
__device__ __forceinline__ void phase_r1(const Ctx& C, int layer) {
    constexpr int RS = 2064, IMG = 16 * RS, NTILE = NTOK / 16;
    typedef pg8::bf16x8 bf16x8;
    LAS unsigned char* imgH = C.lds; LAS unsigned char* imgL = C.lds + IMG;
    LAS float* part = (LAS float*)(C.lds + 2 * IMG); LAS float* lg = part + 8 * 768; LAS int* hist = (LAS int*)(lg + 16 * 48);
    const float* bg = C.in[24] + layer * 4; const float* be = C.in[26] + layer * 32; const float* gain = C.in[2] + layer * D;
    __syncthreads();
    if (C.tid < 32) hist[C.tid] = 0;
    bf16x8 wh[4][3], wl[4][3];
    { const float* RW = (const float*)(C.ws + WS_RW) + (size_t)layer * 36 * 1024;
#pragma unroll
        for (int kb = 0; kb < 4; ++kb)
#pragma unroll
            for (int nt = 0; nt < 3; ++nt) { const int n = nt * 16 + (C.lane & 15), k = (4 * C.wave + kb) * 32 + 8 * (C.lane >> 4);
                f32x4 a = {0.f, 0.f, 0.f, 0.f}, b = a; if (n < 36) { a = *(const f32x4*)(RW + (size_t)n * 1024 + k); b = *(const f32x4*)(RW + (size_t)n * 1024 + k + 4); }
                u32x4 h, l;
                h.x = pg8::cvt_pk_bf16(a[0], a[1]); h.y = pg8::cvt_pk_bf16(a[2], a[3]); h.z = pg8::cvt_pk_bf16(b[0], b[1]); h.w = pg8::cvt_pk_bf16(b[2], b[3]);
                l.x = pg8::cvt_pk_bf16(a[0] - __uint_as_float(h.x << 16), a[1] - __uint_as_float(h.x & 0xffff0000u)); l.y = pg8::cvt_pk_bf16(a[2] - __uint_as_float(h.y << 16), a[3] - __uint_as_float(h.y & 0xffff0000u));
                l.z = pg8::cvt_pk_bf16(b[0] - __uint_as_float(h.z << 16), b[1] - __uint_as_float(h.z & 0xffff0000u)); l.w = pg8::cvt_pk_bf16(b[2] - __uint_as_float(h.w << 16), b[3] - __uint_as_float(h.w & 0xffff0000u));
                wh[kb][nt] = __builtin_bit_cast(bf16x8, h); wl[kb][nt] = __builtin_bit_cast(bf16x8, l); } }
    int* route_e = (int*)(C.ws + WS_ROUTE_E); float* route_w = (float*)(C.ws + WS_ROUTE_W); bf16_t* HN2 = (bf16_t*)(C.ws + WS_H2P);
    { int* ROWTOK = (int*)(C.ws + WS_ROWTOK); for (int idx = C.bid * 512 + C.tid; idx < MOE_MAXROWS; idx += C.G * 512) ROWTOK[idx] = 0; }
    f32x4 g[4];
#pragma unroll
    for (int j = 0; j < 4; ++j) g[j] = *(const f32x4*)(gain + 4 * C.lane + 256 * j);
    const bf16_t* XB = (const bf16_t*)C.out; bf16_t* XB3 = (bf16_t*)(C.ws + WS_XB3);
    const int w2 = 2 * C.wave;
    float rb[2];
#pragma unroll
    for (int q = 0; q < 2; ++q) { const int idx = C.tid + 512 * q, col = (idx >> 8) * 16 + (idx & 15); rb[q] = (idx < 768 && col < 36) ? (col < 4 ? bg[col] : be[col - 4]) : 0.f; }
    u32x2 nx[2][4];
    if (C.bid < NTILE) {
#pragma unroll
        for (int i = 0; i < 2; ++i)
#pragma unroll
            for (int j = 0; j < 4; ++j) nx[i][j] = *(const u32x2*)(XB + (size_t)(C.bid * 16 + w2 + i) * D + 4 * C.lane + 256 * j); }
    for (int tile = C.bid; tile < NTILE; tile += C.G) {
        const int r0 = tile * 16 + w2;
        u32x2 cx[2][4];
#pragma unroll
        for (int i = 0; i < 2; ++i)
#pragma unroll
            for (int j = 0; j < 4; ++j) cx[i][j] = nx[i][j];
        if (tile + C.G < NTILE) {
#pragma unroll
            for (int i = 0; i < 2; ++i)
#pragma unroll
                for (int j = 0; j < 4; ++j) nx[i][j] = *(const u32x2*)(XB + (size_t)((tile + C.G) * 16 + w2 + i) * D + 4 * C.lane + 256 * j); }
#pragma unroll
        for (int i = 0; i < 2; ++i) { const int r = r0 + i;
            f32x4 v[4]; float ss = 0.f;
#pragma unroll
            for (int j = 0; j < 4; ++j) { v[j] = (f32x4){__uint_as_float(cx[i][j].x << 16), __uint_as_float(cx[i][j].x & 0xffff0000u), __uint_as_float(cx[i][j].y << 16), __uint_as_float(cx[i][j].y & 0xffff0000u)};
                if (layer == 1) st8_wt(XB3 + (size_t)r * D + 4 * C.lane + 256 * j, cx[i][j]);
                ss += v[j][0] * v[j][0] + v[j][1] * v[j][1] + v[j][2] * v[j][2] + v[j][3] * v[j][3]; }
            const float rstd = rsqrtf(wave_sum(ss) * (1.f / D) + EPS);
#pragma unroll
            for (int j = 0; j < 4; ++j) { v[j] = v[j] * rstd * g[j];
                u32x2 h, l; h.x = pg8::cvt_pk_bf16(v[j][0], v[j][1]); h.y = pg8::cvt_pk_bf16(v[j][2], v[j][3]);
                st8_wt(HN2 + (size_t)r * D + 4 * C.lane + 256 * j, h);
                l.x = pg8::cvt_pk_bf16(v[j][0] - __uint_as_float(h.x << 16), v[j][1] - __uint_as_float(h.x & 0xffff0000u)); l.y = pg8::cvt_pk_bf16(v[j][2] - __uint_as_float(h.y << 16), v[j][3] - __uint_as_float(h.y & 0xffff0000u));
                const int ob = (w2 + i) * RS + (4 * C.lane + 256 * j) * 2;
                *(LAS u32x2*)(imgH + ob) = h; *(LAS u32x2*)(imgL + ob) = l; } }
        __syncthreads();
        f32x4 acc[3];
#pragma unroll
        for (int nt = 0; nt < 3; ++nt) acc[nt] = (f32x4){0.f, 0.f, 0.f, 0.f};
#pragma unroll
        for (int kb = 0; kb < 4; ++kb) { const int ob = (C.lane & 15) * RS + ((4 * C.wave + kb) * 32 + 8 * (C.lane >> 4)) * 2;
            const bf16x8 ah = *(const LAS bf16x8*)(imgH + ob), al = *(const LAS bf16x8*)(imgL + ob);
#pragma unroll
            for (int nt = 0; nt < 3; ++nt) { acc[nt] = __builtin_amdgcn_mfma_f32_16x16x32_bf16(ah, wh[kb][nt], acc[nt], 0, 0, 0);
                acc[nt] = __builtin_amdgcn_mfma_f32_16x16x32_bf16(al, wh[kb][nt], acc[nt], 0, 0, 0); acc[nt] = __builtin_amdgcn_mfma_f32_16x16x32_bf16(ah, wl[kb][nt], acc[nt], 0, 0, 0); } }
#pragma unroll
        for (int nt = 0; nt < 3; ++nt)
#pragma unroll
            for (int j = 0; j < 4; ++j) part[(C.wave * 3 + nt) * 256 + j * 64 + C.lane] = acc[nt][j];
        __syncthreads();
#pragma unroll
        for (int q = 0; q < 2; ++q) { const int idx = C.tid + 512 * q; if (idx >= 768) break; float s = rb[q];
#pragma unroll
            for (int w = 0; w < 8; ++w) s += part[w * 768 + idx];
            const int nt = idx >> 8, j = (idx >> 6) & 3, l = idx & 63; lg[(4 * (l >> 4) + j) * 48 + nt * 16 + (l & 15)] = s; }
        __syncthreads();
        if (C.lane < 2) { const int r = r0 + C.lane; const LAS float* L = lg + (w2 + C.lane) * 48;
            float gl[4];
#pragma unroll
            for (int cc = 0; cc < 4; ++cc) gl[cc] = L[cc];
            int gi = 0; float gm = gl[0];
#pragma unroll
            for (int cc = 1; cc < 4; ++cc) if (gl[cc] > gm) { gm = gl[cc]; gi = cc; }
            float gsum = 0.f;
#pragma unroll
            for (int cc = 0; cc < 4; ++cc) gsum += expf(gl[cc] - gm);
            const float gwt = 1.f / gsum;
            float el[8];
#pragma unroll
            for (int i = 0; i < 8; ++i) el[i] = L[4 + gi * 8 + i];
            int i0 = 0; float v0 = el[0];
#pragma unroll
            for (int i = 1; i < 8; ++i) if (el[i] > v0) { v0 = el[i]; i0 = i; }
            int i1 = -1; float v1 = -3.0e38f;
#pragma unroll
            for (int i = 0; i < 8; ++i) if (i != i0 && el[i] > v1) { v1 = el[i]; i1 = i; }
            if (i1 < 0) i1 = (i0 + 1) & 7;
            const float e1 = expf(v1 - v0), w0 = 1.f / (1.f + e1), w1 = e1 / (1.f + e1);
            const int ea = gi * 8 + i0, eb = gi * 8 + i1; route_e[2 * r] = ea; route_e[2 * r + 1] = eb; route_w[2 * r] = gwt * w0; route_w[2 * r + 1] = gwt * w1;
            lds_inc(&hist[ea]); lds_inc(&hist[eb]); }
    }
    __syncthreads();
    if (C.tid < 32 && hist[C.tid]) atomicAdd((int*)(C.ws + WS_CNT) + layer * 32 + C.tid, hist[C.tid]);
}
__device__ __forceinline__ void phase_r2(const Ctx& C, int layer) {
    LAS int* seg = (LAS int*)C.lds; LAS int* hist = seg + 40; LAS int* basee = hist + 32;
    const int* counts = (const int*)(C.ws + WS_CNT) + layer * 32; int* cursor = (int*)(C.ws + WS_CNT) + 64 + layer * 32; int* npan = (int*)(C.ws + WS_CNT) + 128 + layer;
    int* panel_expert = (int*)(C.ws + WS_PANEL) + layer * 320;
    const int* route_e = (const int*)(C.ws + WS_ROUTE_E); const float* route_w = (const float*)(C.ws + WS_ROUTE_W); int* POS = (int*)(C.ws + WS_POS); float* WROW = (float*)(C.ws + WS_WROW); int* ROWTOK = (int*)(C.ws + WS_ROWTOK);
    __syncthreads();
    if (C.tid == 0) { int run = 0; for (int e = 0; e < 32; ++e) { seg[e] = run; const int np = (counts[e] + 255) >> 8;
            if (C.bid == 0) for (int p = 0; p < np; ++p) panel_expert[(run >> 8) + p] = e;
            run += np << 8; }
        seg[32] = run; if (C.bid == 0) *npan = run >> 8; }
    for (int base = C.bid * 256; base < NTOK; base += C.G * 256) {
        __syncthreads();
        if (C.tid < 32) hist[C.tid] = 0;
        __syncthreads();
        const int e = route_e[2 * base + C.tid]; const int rank = lds_inc(&hist[e]);
        __syncthreads();
        if (C.tid < 32) basee[C.tid] = hist[C.tid] ? atomicAdd(&cursor[C.tid], hist[C.tid]) : 0;
        __syncthreads();
        const int pos = seg[e] + basee[e] + rank; POS[2 * base + C.tid] = pos; WROW[pos] = route_w[2 * base + C.tid]; ROWTOK[pos] = base + (C.tid >> 1);
    }
}
__device__ __forceinline__ void phase_combine(const Ctx& C) {
    const int* POS = (const int*)(C.ws + WS_POS); const bf16_t* YP = (const bf16_t*)(C.ws + WS_YP); const bf16_t* XB3 = (const bf16_t*)(C.ws + WS_XB3);
    const int gw = C.bid * 8 + C.wave, NGW = C.G * 8; const int lane = C.lane;
    for (int r = gw; r < NTOK; r += 2 * NGW) {
        const int r2 = r + NGW; const bool has2 = r2 < NTOK; const int rb = has2 ? r2 : r;
        const int pa0 = POS[2 * r], pa1 = POS[2 * r + 1], pb0 = POS[2 * rb], pb1 = POS[2 * rb + 1];
        float* xa = C.out + (size_t)r * D + 4 * lane; float* xb = C.out + (size_t)rb * D + 4 * lane;
        u32x2 va[4], vb[4], a0[4], a1[4], b0[4], b1[4];
#pragma unroll
        for (int j = 0; j < 4; ++j) { va[j] = *(const u32x2*)(XB3 + (size_t)r * D + 4 * lane + 256 * j); a0[j] = *(const u32x2*)(YP + (size_t)pa0 * D + 4 * lane + 256 * j); a1[j] = *(const u32x2*)(YP + (size_t)pa1 * D + 4 * lane + 256 * j);
            vb[j] = *(const u32x2*)(XB3 + (size_t)rb * D + 4 * lane + 256 * j); b0[j] = *(const u32x2*)(YP + (size_t)pb0 * D + 4 * lane + 256 * j); b1[j] = *(const u32x2*)(YP + (size_t)pb1 * D + 4 * lane + 256 * j); }
#pragma unroll
        for (int j = 0; j < 4; ++j) { f32x4 v;
            v[0] = __uint_as_float(va[j].x << 16) + __uint_as_float(a0[j].x << 16) + __uint_as_float(a1[j].x << 16); v[1] = __uint_as_float(va[j].x & 0xffff0000u) + __uint_as_float(a0[j].x & 0xffff0000u) + __uint_as_float(a1[j].x & 0xffff0000u);
            v[2] = __uint_as_float(va[j].y << 16) + __uint_as_float(a0[j].y << 16) + __uint_as_float(a1[j].y << 16); v[3] = __uint_as_float(va[j].y & 0xffff0000u) + __uint_as_float(a0[j].y & 0xffff0000u) + __uint_as_float(a1[j].y & 0xffff0000u);
            *(f32x4*)(xa + 256 * j) = v; }
        if (has2) {
#pragma unroll
            for (int j = 0; j < 4; ++j) { f32x4 v;
                v[0] = __uint_as_float(vb[j].x << 16) + __uint_as_float(b0[j].x << 16) + __uint_as_float(b1[j].x << 16); v[1] = __uint_as_float(vb[j].x & 0xffff0000u) + __uint_as_float(b0[j].x & 0xffff0000u) + __uint_as_float(b1[j].x & 0xffff0000u);
                v[2] = __uint_as_float(vb[j].y << 16) + __uint_as_float(b0[j].y << 16) + __uint_as_float(b1[j].y << 16); v[3] = __uint_as_float(vb[j].y & 0xffff0000u) + __uint_as_float(b0[j].y & 0xffff0000u) + __uint_as_float(b1[j].y & 0xffff0000u);
                *(f32x4*)(xb + 256 * j) = v; } }
    }
}

__device__ __forceinline__ void phase_combine_norm(const Ctx& C, const float* WSM, const float* gain, bf16_t* hn0, float* sm0, bf16_t* hn1, float* sm1) {
    LAS unsigned char* img = C.lds; LAS float* part = (LAS float*)(C.lds + 2 * SP_IMG);
    __syncthreads();
    SmallProjW W; smallproj_load(W, WSM, C.wave, C.lane);
    const int* POS = (const int*)(C.ws + WS_POS); const bf16_t* YP = (const bf16_t*)(C.ws + WS_YP);
    const int lane = C.lane, w2 = 2 * C.wave;
    f32x4 g[4];
#pragma unroll
    for (int j = 0; j < 4; ++j) g[j] = *(const f32x4*)(gain + 4 * lane + 256 * j);
    int np[4];
    if (C.bid < NTOK / 16) {
#pragma unroll
        for (int i = 0; i < 4; ++i) np[i] = POS[2 * (C.bid * 16 + w2) + i]; }
    for (int tile = C.bid; tile < NTOK / 16; tile += C.G) {
        int cp[4];
#pragma unroll
        for (int i = 0; i < 4; ++i) cp[i] = np[i];
        if (tile + C.G < NTOK / 16) {
#pragma unroll
            for (int i = 0; i < 4; ++i) np[i] = POS[2 * ((tile + C.G) * 16 + w2) + i]; }
        u32x2 xr[2][4], y0[2][4], y1[2][4];
#pragma unroll
        for (int i = 0; i < 2; ++i) { const size_t r = (size_t)tile * 16 + w2 + i;
#pragma unroll
            for (int j = 0; j < 4; ++j) { xr[i][j] = *(const u32x2*)((const bf16_t*)C.out + r * D + 4 * lane + 256 * j);
                y0[i][j] = *(const u32x2*)(YP + (size_t)cp[2 * i] * D + 4 * lane + 256 * j); y1[i][j] = *(const u32x2*)(YP + (size_t)cp[2 * i + 1] * D + 4 * lane + 256 * j); } }
#pragma unroll
        for (int i = 0; i < 2; ++i) { const size_t r = (size_t)tile * 16 + w2 + i; bf16_t* xo = (bf16_t*)C.out + r * D + 4 * lane;
            f32x4 v[4]; float ss = 0.f;
#pragma unroll
            for (int j = 0; j < 4; ++j) {
                v[j][0] = __uint_as_float(xr[i][j].x << 16) + (__uint_as_float(y0[i][j].x << 16) + __uint_as_float(y1[i][j].x << 16));
                v[j][1] = __uint_as_float(xr[i][j].x & 0xffff0000u) + (__uint_as_float(y0[i][j].x & 0xffff0000u) + __uint_as_float(y1[i][j].x & 0xffff0000u));
                v[j][2] = __uint_as_float(xr[i][j].y << 16) + (__uint_as_float(y0[i][j].y << 16) + __uint_as_float(y1[i][j].y << 16));
                v[j][3] = __uint_as_float(xr[i][j].y & 0xffff0000u) + (__uint_as_float(y0[i][j].y & 0xffff0000u) + __uint_as_float(y1[i][j].y & 0xffff0000u));
                u32x2 w_; w_.x = pg8::cvt_pk_bf16(v[j][0], v[j][1]); w_.y = pg8::cvt_pk_bf16(v[j][2], v[j][3]); st8_wt(xo + 256 * j, w_);
                ss += v[j][0] * v[j][0] + v[j][1] * v[j][1] + v[j][2] * v[j][2] + v[j][3] * v[j][3]; }
            const float rs = rsqrtf(wave_sum(ss) * (1.f / D) + EPS);
            bf16_t* ho = (r < (size_t)GTOK) ? hn0 + r * D : hn1 + (r - GTOK) * D;
#pragma unroll
            for (int j = 0; j < 4; ++j) { const u32x2 h = smallproj_put(img, w2 + i, lane, j, v[j] * rs * g[j]); st8_wt(ho + 4 * lane + 256 * j, h); } }
        __syncthreads();
        { const size_t r0 = (size_t)tile * 16; smallproj_tile(W, img, part, (r0 < (size_t)GTOK) ? sm0 + r0 * 32 : sm1 + (r0 - GTOK) * 32, C.wave, lane, C.tid); }
        __syncthreads();
    }
}
typedef pg8::bf16x8 bf16x8;
typedef short bf16x4 __attribute__((ext_vector_type(4)));
#define MFMA16(a, b, c) __builtin_amdgcn_mfma_f32_16x16x32_bf16(a, b, c, 0, 0, 0)
__device__ __forceinline__ bf16x8 ld_frag(const LAS bf16_t* base, int stride, int row, int kofs) { return *(const LAS bf16x8*)(base + row * stride + kofs); }
__device__ __forceinline__ bf16x8 ld_frag_perm(const LAS bf16_t* base, int stride, int row, int k0, int q) {
    const bf16x4 lo = *(const LAS bf16x4*)(base + row * stride + k0 + 4 * q), hi = *(const LAS bf16x4*)(base + row * stride + k0 + 16 + 4 * q);
    return __builtin_shufflevector(lo, hi, 0, 1, 2, 3, 4, 5, 6, 7);
}
__device__ __forceinline__ bf16x8 pack_frag(const f32x4 lo, const f32x4 hi) {
    u32x4 w; w.x = pg8::cvt_pk_bf16(lo[0], lo[1]); w.y = pg8::cvt_pk_bf16(lo[2], lo[3]); w.z = pg8::cvt_pk_bf16(hi[0], hi[1]); w.w = pg8::cvt_pk_bf16(hi[2], hi[3]);
    return __builtin_bit_cast(bf16x8, w);
}
__device__ __forceinline__ u32x2 pack4(const f32x4 v) { u32x2 w; w.x = pg8::cvt_pk_bf16(v[0], v[1]); w.y = pg8::cvt_pk_bf16(v[2], v[3]); return w; }
__device__ __forceinline__ float wave_incl_sum(float v, int lane) {
#pragma unroll
    for (int o = 1; o < 64; o <<= 1) { const float u = __shfl_up(v, o); if (lane >= o) v += u; }
    return v;
}
__device__ __forceinline__ float wave_incl_max(float v, int lane) {
#pragma unroll
    for (int o = 1; o < 64; o <<= 1) { const float u = __shfl_up(v, o); if (lane >= o) v = fmaxf(v, u); }
    return v;
}
__device__ __forceinline__ float wave_max(float v) {
#pragma unroll
    for (int o = 1; o < 64; o <<= 1) v = fmaxf(v, __shfl_xor(v, o));
    return v;
}
__device__ __forceinline__ bf16x8 ld_frag_tr(const LAS bf16_t* base, int stride, int c0, int k_lo, int k_hi, int r) {
    const LAS bf16_t* p = base + (r >> 2) * stride + c0 + 4 * (r & 3);
    const bf16x4 lo = __builtin_amdgcn_ds_read_tr16_b64_v4i16((LAS bf16x4*)(p + k_lo * stride)), hi = __builtin_amdgcn_ds_read_tr16_b64_v4i16((LAS bf16x4*)(p + k_hi * stride));
    return __builtin_shufflevector(lo, hi, 0, 1, 2, 3, 4, 5, 6, 7);
}
#define LDS_BARRIER() do { asm volatile("s_waitcnt lgkmcnt(0)" ::: "memory"); __builtin_amdgcn_s_barrier(); asm volatile("" ::: "memory"); } while (0)
__device__ __forceinline__ void phase_ssdconv(const Ctx& C, const bf16_t* P, bf16_t* XC) {
    const int gw = C.bid * 8 + C.wave, NGW = C.G * 8; const int lane = C.lane;
    const float* cw = C.in[16]; const float* cb = C.in[17];
    for (int u = gw; u < GBATCH * NCHUNK * 6 * 4; u += NGW) {
        const int slab = u % 6, qq = (u / 6) & 3, cc = (u / 24) & 31, bl = u / (24 * 32); const int ch = slab * 512 + lane * 8;
        float w[4][8], bb[8];
#pragma unroll
        for (int j = 0; j < 4; ++j) { const f32x4 a = *(const f32x4*)(cw + j * 3072 + ch), b = *(const f32x4*)(cw + j * 3072 + ch + 4);
            w[j][0] = a[0]; w[j][1] = a[1]; w[j][2] = a[2]; w[j][3] = a[3]; w[j][4] = b[0]; w[j][5] = b[1]; w[j][6] = b[2]; w[j][7] = b[3]; }
        { const f32x4 a = *(const f32x4*)(cb + ch), b = *(const f32x4*)(cb + ch + 4); bb[0] = a[0]; bb[1] = a[1]; bb[2] = a[2]; bb[3] = a[3]; bb[4] = b[0]; bb[5] = b[1]; bb[6] = b[2]; bb[7] = b[3]; }
        const size_t r0 = (size_t)bl * SEQ + (size_t)cc * 64 + (size_t)qq * 16;
        u32x4 h0 = (u32x4){0u, 0u, 0u, 0u}, h1 = h0, h2 = h0;
        if (cc > 0 || qq > 0) { h0 = *(const u32x4*)(P + pj1(r0 - 3, C_XBC + ch)); h1 = *(const u32x4*)(P + pj1(r0 - 2, C_XBC + ch)); h2 = *(const u32x4*)(P + pj1(r0 - 1, C_XBC + ch)); }
#pragma unroll
        for (int t = 0; t < 16; ++t) { const u32x4 h3 = *(const u32x4*)(P + pj1(r0 + t, C_XBC + ch));
            const unsigned x0[4] = {h0.x, h0.y, h0.z, h0.w}, x1[4] = {h1.x, h1.y, h1.z, h1.w}, x2[4] = {h2.x, h2.y, h2.z, h2.w}, x3[4] = {h3.x, h3.y, h3.z, h3.w};
            float o[8];
#pragma unroll
            for (int i = 0; i < 4; ++i) {
                float a0 = bb[2 * i] + w[0][2 * i] * __uint_as_float(x0[i] << 16) + w[1][2 * i] * __uint_as_float(x1[i] << 16) + w[2][2 * i] * __uint_as_float(x2[i] << 16) + w[3][2 * i] * __uint_as_float(x3[i] << 16);
                float a1 = bb[2 * i + 1] + w[0][2 * i + 1] * __uint_as_float(x0[i] & 0xffff0000u) + w[1][2 * i + 1] * __uint_as_float(x1[i] & 0xffff0000u) + w[2][2 * i + 1] * __uint_as_float(x2[i] & 0xffff0000u) + w[3][2 * i + 1] * __uint_as_float(x3[i] & 0xffff0000u);
                o[2 * i] = a0 * frcp_(1.f + __expf(-a0)); o[2 * i + 1] = a1 * frcp_(1.f + __expf(-a1)); }
            u32x4 pk; pk.x = pg8::cvt_pk_bf16(o[0], o[1]); pk.y = pg8::cvt_pk_bf16(o[2], o[3]); pk.z = pg8::cvt_pk_bf16(o[4], o[5]); pk.w = pg8::cvt_pk_bf16(o[6], o[7]);
            pg8::st16_wt(XC + (r0 + t) * 3072 + ch, pk);
            h0 = h1; h1 = h2; h2 = h3; }
    }
}
__device__ __forceinline__ void ssd_unit(const Ctx& C, const float* SM, const bf16_t* XC, bf16_t* AO, int unit) {
    const int head = unit & 31, bl = unit >> 5, grp = head >> 3;
    LAS bf16_t* Bn = (LAS bf16_t*)C.lds;
    LAS bf16_t* Cn = Bn + 64 * 136;
    LAS bf16_t* Xd = Cn + 64 * 136;
    LAS bf16_t* Xw = Xd + 64 * 72;
    LAS bf16_t* ST = Xw + 64 * 72;
    LAS float* dtL = (LAS float*)(ST + 64 * 136);
    LAS float* acL = dtL + 32 * 64;
    const int tid = C.tid, lane = C.lane, wave = C.wave, q = lane >> 4, r = lane & 15;
    const float A = -expf(C.in[18][head]), dtb = C.in[19][head], Dk = C.in[20][head];
    const int tt = wave & 3, pp = wave >> 2;
    f32x4 accst[4];
#pragma unroll
    for (int i = 0; i < 4; ++i) accst[i] = (f32x4){0.f, 0.f, 0.f, 0.f};
    LDS_BARRIER();
    for (int idx = tid; idx < 64 * 136 / 2; idx += 512) ((LAS unsigned*)ST)[idx] = 0u;
    for (int cc = wave; cc < NCHUNK; cc += 8) { const float dtv = softplusf_(SM[((size_t)bl * SEQ + (size_t)cc * 64 + lane) * 32 + head] + dtb); dtL[cc * 64 + lane] = dtv; acL[cc * 64 + lane] = wave_incl_sum(dtv * A, lane); }
    u32x4 xr, br[2], cr[2];
#define SSD_PREFETCH(cc) do { const size_t rr0 = (size_t)bl * SEQ + (size_t)(cc) * 64; \
        xr = *(const u32x4*)(XC + (rr0 + (tid >> 3)) * 3072 + head * 64 + (tid & 7) * 8); \
        _Pragma("unroll") for (int i = 0; i < 2; ++i) { const int idx = tid + 512 * i; const bf16_t* pr = XC + (rr0 + (idx >> 4)) * 3072 + 2048 + grp * 128 + (idx & 15) * 8; br[i] = *(const u32x4*)pr; cr[i] = *(const u32x4*)(pr + 512); } } while (0)
    SSD_PREFETCH(0);
#pragma unroll 1
    for (int c = 0; c < NCHUNK; ++c) {
        const size_t r0 = (size_t)bl * SEQ + (size_t)c * 64;
        LDS_BARRIER();
#pragma unroll
        for (int i = 0; i < 2; ++i) { const int idx = tid + 512 * i; *(LAS u32x4*)(Bn + (idx >> 4) * 136 + (idx & 15) * 8) = br[i]; *(LAS u32x4*)(Cn + (idx >> 4) * 136 + (idx & 15) * 8) = cr[i]; }
        const u32x4 xcur = xr;
        if (c + 1 < NCHUNK) SSD_PREFETCH(c + 1);
        const LAS float* dtc = dtL + c * 64; const LAS float* acc_ = acL + c * 64;
        { const int s = tid >> 3, c8 = tid & 7; const float dtv = dtc[s], de = __expf(acc_[63] - acc_[s]); const unsigned xx[4] = {xcur.x, xcur.y, xcur.z, xcur.w};
          u32x4 pd, pw; unsigned* pdp = (unsigned*)&pd; unsigned* pwp = (unsigned*)&pw;
#pragma unroll
          for (int i = 0; i < 4; ++i) { const float a = __uint_as_float(xx[i] << 16) * dtv, b = __uint_as_float(xx[i] & 0xffff0000u) * dtv; pdp[i] = pg8::cvt_pk_bf16(a, b); pwp[i] = pg8::cvt_pk_bf16(a * de, b * de); }
          *(LAS u32x4*)(Xd + s * 72 + c8 * 8) = pd; *(LAS u32x4*)(Xw + s * 72 + c8 * 8) = pw; }
        LDS_BARRIER();
        const int t = 16 * tt + r;
        f32x4 accy[2], accs[4];
#pragma unroll
        for (int i = 0; i < 2; ++i) accy[i] = (f32x4){0.f, 0.f, 0.f, 0.f};
#pragma unroll
        for (int i = 0; i < 4; ++i) accs[i] = (f32x4){0.f, 0.f, 0.f, 0.f};
#pragma unroll
        for (int kh = 0; kh < 2; ++kh) { bf16x8 fC[2], fS[2][2], fB[4][2];
#pragma unroll
          for (int k2 = 0; k2 < 2; ++k2) { const int ks = 2 * kh + k2; fC[k2] = ld_frag(Cn, 136, t, 32 * ks + 8 * q);
#pragma unroll
              for (int i = 0; i < 2; ++i) fS[i][k2] = ld_frag(ST, 136, 16 * (2 * pp + i) + r, 32 * ks + 8 * q);
#pragma unroll
              for (int mi = 0; mi < 4; ++mi) fB[mi][k2] = ld_frag(Bn, 136, 16 * mi + r, 32 * ks + 8 * q); }
          __builtin_amdgcn_sched_barrier(0);
#pragma unroll
          for (int k2 = 0; k2 < 2; ++k2) {
#pragma unroll
              for (int i = 0; i < 2; ++i) accy[i] = MFMA16(fS[i][k2], fC[k2], accy[i]);
#pragma unroll
              for (int mi = 0; mi < 4; ++mi) accs[mi] = MFMA16(fB[mi][k2], fC[k2], accs[mi]); } }
        const float ac_t = acc_[t], ea_t = __expf(ac_t), dinv_t = Dk * frcp_(dtc[t]);
#pragma unroll
        for (int i = 0; i < 2; ++i) accy[i] = accy[i] * ea_t;
#pragma unroll
        for (int mi = 0; mi < 4; ++mi) { const f32x4 acs = *(const LAS f32x4*)(acc_ + 16 * mi + 4 * q);
#pragma unroll
            for (int jj = 0; jj < 4; ++jj) { const int s = 16 * mi + 4 * q + jj; float dec = __expf(fminf(ac_t - acs[jj], 0.f)); asm volatile("" : "+v"(dec));
                float m = accs[mi][jj] * dec; m = (s <= t) ? m : 0.f; m = (s == t) ? m + dinv_t : m; accs[mi][jj] = m; } }
        bf16x8 fX[2][2], fBT[2], fXW[4][2];
#pragma unroll
        for (int ks2 = 0; ks2 < 2; ++ks2) {
#pragma unroll
            for (int i = 0; i < 2; ++i) fX[i][ks2] = ld_frag_tr(Xd, 72, 16 * (2 * pp + i), 32 * ks2 + 4 * q, 32 * ks2 + 16 + 4 * q, r);
            fBT[ks2] = ld_frag_tr(Bn, 136, 16 * wave, 32 * ks2 + 8 * q, 32 * ks2 + 8 * q + 4, r);
#pragma unroll
            for (int pt = 0; pt < 4; ++pt) fXW[pt][ks2] = ld_frag_tr(Xw, 72, 16 * pt, 32 * ks2 + 8 * q, 32 * ks2 + 8 * q + 4, r); }
        __builtin_amdgcn_sched_barrier(0);
#pragma unroll
        for (int ks2 = 0; ks2 < 2; ++ks2) { const bf16x8 bM = pack_frag(accs[2 * ks2], accs[2 * ks2 + 1]);
#pragma unroll
            for (int i = 0; i < 2; ++i) accy[i] = MFMA16(fX[i][ks2], bM, accy[i]); }
#pragma unroll
        for (int i = 0; i < 2; ++i) *(u32x2*)(AO + (r0 + t) * KO1 + 1024 + head * 64 + 16 * (2 * pp + i) + 4 * q) = pack4(accy[i]);
        const float gdec = __expf(acc_[63]);
#pragma unroll
        for (int pt = 0; pt < 4; ++pt) accst[pt] = accst[pt] * gdec;
#pragma unroll
        for (int ks = 0; ks < 2; ++ks) {
#pragma unroll
            for (int pt = 0; pt < 4; ++pt) accst[pt] = MFMA16(fBT[ks], fXW[pt][ks], accst[pt]); }
        LDS_BARRIER();
#pragma unroll
        for (int pt = 0; pt < 4; ++pt) *(LAS u32x2*)(ST + (16 * pt + r) * 136 + 16 * wave + 4 * q) = pack4(accst[pt]);
    }
#undef SSD_PREFETCH
}
__device__ __forceinline__ float logsigmoidf_(float x) { return fminf(x, 0.f) - log1pf(__expf(-fabsf(x))); }
__device__ __forceinline__ void mlstm_unit(const Ctx& C, const bf16_t* P, const float* SM, bf16_t* AO, int unit) {
    const int vs = unit & 3, h = (unit >> 2) & 3, bl = unit >> 4;
    LAS bf16_t* Qn = (LAS bf16_t*)C.lds;
    LAS bf16_t* Kn = Qn + 64 * 136;
    LAS bf16_t* Vn = Kn + 64 * 136;
    LAS bf16_t* VW = Vn + 64 * 88;
    LAS bf16_t* CT = VW + 64 * 88;
    LAS float* bcL = (LAS float*)(CT + 80 * 136);
    LAS float* lbL = bcL + 2048; LAS float* dmL = lbL + 2048; LAS float* weL = dmL + 2048;
    LAS float* scL = weL + 2048;
    const int tid = C.tid, lane = C.lane, wave = C.wave, q = lane >> 4, r = lane & 15;
    const float ib = C.in[4][h], fb = C.in[5][h]; const float scale = 0.08838834764831845f;
    const int tt = wave & 3, vg = wave >> 2;
    f32x4 accc[5];
#pragma unroll
    for (int i = 0; i < 5; ++i) accc[i] = (f32x4){0.f, 0.f, 0.f, 0.f};
    LDS_BARRIER();
    for (int idx = tid; idx < 80 * 136 / 2; idx += 512) ((LAS unsigned*)CT)[idx] = 0u;
    for (int idx = tid; idx < 64 * 8; idx += 512) { const int s_ = idx >> 3, cc = idx & 7; *(LAS unsigned*)(Vn + s_ * 88 + 64 + 2 * cc) = cc == 0 ? 0x00003f80u : 0u; *(LAS unsigned*)(VW + s_ * 88 + 64 + 2 * cc) = 0u; }
    for (int cc = wave; cc < NCHUNK; cc += 8) { const float* pr = SM + ((size_t)bl * SEQ + (size_t)cc * 64 + lane) * 32; const float li = pr[h] + ib, lf = logsigmoidf_(pr[4 + h] + fb);
        const float bcum = wave_incl_sum(lf, lane), b_end = __shfl(bcum, 63), g_end = b_end - bcum + li, m_loc = wave_max(g_end), lb = li - bcum;
        bcL[cc * 64 + lane] = bcum; lbL[cc * 64 + lane] = lb; dmL[cc * 64 + lane] = wave_incl_max(lb, lane); weL[cc * 64 + lane] = __expf(g_end - m_loc);
        if (lane == 0) { scL[cc] = b_end; scL[32 + cc] = m_loc; } }
    LDS_BARRIER();
    if (tid == 0) { float m_st = 0.f; for (int cc = 0; cc < NCHUNK; ++cc) { const float be = scL[cc], ml = scL[32 + cc], m_new = fmaxf(be + m_st, ml);
            scL[64 + cc] = m_st; scL[96 + cc] = __expf(be + m_st - m_new); scL[128 + cc] = __expf(ml - m_new); m_st = m_new; } }
    u32x4 vreg, qreg[2], kreg[2];
#define MLSTM_PREFETCH(cc) do { const size_t rr0 = (size_t)bl * SEQ + (size_t)(cc) * 64; \
        vreg = *(const u32x4*)(P + pj0(rr0 + (tid >> 3), C_MV + h * 256 + vs * 64 + (tid & 7) * 8)); \
        _Pragma("unroll") for (int it = 0; it < 2; ++it) { const int idx = tid + 512 * it; const size_t rw = rr0 + (idx >> 4); const int cq = h * 128 + (idx & 15) * 8; qreg[it] = *(const u32x4*)(P + pj0(rw, C_MQ + cq)); kreg[it] = *(const u32x4*)(P + pj0(rw, C_MK + cq)); } } while (0)
    MLSTM_PREFETCH(0);
    for (int c = 0; c < NCHUNK; ++c) {
        const size_t r0 = (size_t)bl * SEQ + (size_t)c * 64;
        LDS_BARRIER();
#pragma unroll
        for (int it = 0; it < 2; ++it) { const int idx = tid + 512 * it; *(LAS u32x4*)(Qn + (idx >> 4) * 136 + (idx & 15) * 8) = qreg[it]; *(LAS u32x4*)(Kn + (idx >> 4) * 136 + (idx & 15) * 8) = kreg[it]; }
        const u32x4 vv = vreg;
        *(LAS u32x4*)(Vn + (tid >> 3) * 88 + (tid & 7) * 8) = vv;
        if (c + 1 < NCHUNK) MLSTM_PREFETCH(c + 1);
        const float s_upd = scL[128 + c], s_old = scL[96 + c], m_prev = scL[64 + c];
        { const int s_ = tid >> 3; const float w = weL[c * 64 + s_] * s_upd; const unsigned w4[4] = {vv.x, vv.y, vv.z, vv.w}; u32x4 pw; unsigned* pwp = (unsigned*)&pw;
#pragma unroll
          for (int i = 0; i < 4; ++i) pwp[i] = pg8::cvt_pk_bf16(__uint_as_float(w4[i] << 16) * w, __uint_as_float(w4[i] & 0xffff0000u) * w);
          *(LAS u32x4*)(VW + s_ * 88 + (tid & 7) * 8) = pw;
          if (tid < 64) VW[tid * 88 + 64] = f2bf(weL[c * 64 + tid] * s_upd); }
        LDS_BARRIER();
        const int t = 16 * tt + r;
        f32x4 accn[3], accs[4];
#pragma unroll
        for (int i = 0; i < 3; ++i) accn[i] = (f32x4){0.f, 0.f, 0.f, 0.f};
#pragma unroll
        for (int i = 0; i < 4; ++i) accs[i] = (f32x4){0.f, 0.f, 0.f, 0.f};
#pragma unroll
        for (int ks = 0; ks < 4; ++ks) { const bf16x8 bQ = ld_frag(Qn, 136, t, 32 * ks + 8 * q);
#pragma unroll
            for (int i = 0; i < 3; ++i) accn[i] = MFMA16(ld_frag(CT, 136, 16 * (i < 2 ? 2 * vg + i : 4) + r, 32 * ks + 8 * q), bQ, accn[i]);
#pragma unroll
            for (int mi = 0; mi < 4; ++mi) accs[mi] = MFMA16(ld_frag(Kn, 136, 16 * mi + r, 32 * ks + 8 * q), bQ, accs[mi]); }
        const float bc_t = bcL[c * 64 + t], m_t = bc_t + fmaxf(m_prev, dmL[c * 64 + t]), winter = __expf(bc_t + m_prev - m_t) * scale, bt = bc_t - m_t;
#pragma unroll
        for (int i = 0; i < 3; ++i) accn[i] = accn[i] * winter;
#pragma unroll
        for (int mi = 0; mi < 4; ++mi) { const f32x4 lbs = *(const LAS f32x4*)(lbL + c * 64 + 16 * mi + 4 * q);
#pragma unroll
            for (int jj = 0; jj < 4; ++jj) { const int s = 16 * mi + 4 * q + jj; float wgt = __expf(fminf(bt + lbs[jj], 0.f)) * scale; asm volatile("" : "+v"(wgt)); const float m = accs[mi][jj] * wgt; accs[mi][jj] = (s <= t) ? m : 0.f; } }
#pragma unroll
        for (int ks2 = 0; ks2 < 2; ++ks2) { const bf16x8 bP = pack_frag(accs[2 * ks2], accs[2 * ks2 + 1]);
#pragma unroll
            for (int i = 0; i < 3; ++i) accn[i] = MFMA16(ld_frag_tr(Vn, 88, 16 * (i < 2 ? 2 * vg + i : 4), 32 * ks2 + 4 * q, 32 * ks2 + 16 + 4 * q, r), bP, accn[i]); }
        const float den = __shfl(accn[2][0], r); const float inv = frcp_(fmaxf(fabsf(den), __expf(-m_t)));
#pragma unroll
        for (int i = 0; i < 2; ++i) *(u32x2*)(AO + (r0 + t) * KO0 + h * 256 + vs * 64 + 16 * (2 * vg + i) + 4 * q) = pack4(accn[i] * inv);
#pragma unroll
        for (int vt = 0; vt < 5; ++vt) accc[vt] = accc[vt] * s_old;
#pragma unroll
        for (int ks = 0; ks < 2; ++ks) { const bf16x8 aK = ld_frag_tr(Kn, 136, 16 * wave, 32 * ks + 8 * q, 32 * ks + 8 * q + 4, r);
#pragma unroll
            for (int vt = 0; vt < 5; ++vt) accc[vt] = MFMA16(aK, ld_frag_tr(VW, 88, 16 * vt, 32 * ks + 8 * q, 32 * ks + 8 * q + 4, r), accc[vt]); }
        LDS_BARRIER();
#pragma unroll
        for (int vt = 0; vt < 5; ++vt) *(LAS u32x2*)(CT + (16 * vt + r) * 136 + 16 * wave + 4 * q) = pack4(accc[vt]);
    }
#undef MLSTM_PREFETCH
}
constexpr size_t PREP_UNIT_BYTES = 73728;
__device__ __forceinline__ void gdn_prep_phase(const Ctx& C, const bf16_t* P, const float* SM, unsigned char* prep, float* gtot) {
    LAS bf16_t* RAW = (LAS bf16_t*)C.lds;
    LAS float* Am = (LAS float*)C.lds;
    LAS float* Tf = Am + 64 * 65;
    LAS bf16_t* Tn = (LAS bf16_t*)(Tf + 64 * 65);
    LAS float* Ys = (LAS float*)(Tn + 64 * 72);
    LAS bf16_t* Kn = (LAS bf16_t*)(C.lds + 51456);
    LAS bf16_t* Qn = Kn + 64 * 136;
    LAS bf16_t* RK = Qn + 64 * 136;
    LAS bf16_t* RV = RK + 64 * 136;
    LAS float* fs = (LAS float*)(RV + 64 * 136);
    LAS float* cwl = fs + 256;
    const int tid = C.tid, lane = C.lane, wave = C.wave, q = lane >> 4, r = lane & 15;
    const float* cw = C.in[7];
    u32x4 rawreg[7]; float gareg = 0.f, gbreg = 0.f;
#define PREP_PREFETCH(uu) do { const int h_ = (uu) & 7, c_ = ((uu) >> 3) & 31, bl_ = (uu) >> 8; const size_t rr0 = (size_t)bl_ * SEQ + (size_t)c_ * 64; \
        _Pragma("unroll") for (int i = 0; i < 7; ++i) { const int idx = tid + 512 * i; const int rr = idx / 48, vv = idx - rr * 48; const int ts = c_ * 64 + rr - 3; \
            const int col = C_GQ + (vv >> 4) * 1024 + h_ * 128 + (vv & 15) * 8; rawreg[i] = (u32x4){0u, 0u, 0u, 0u}; \
            if (idx < 67 * 48 && ts >= 0) rawreg[i] = *(const u32x4*)(P + pj0(rr0 + rr - 3, col)); } \
        if (tid < 64) { const float* pr = SM + (rr0 + tid) * 32; gareg = pr[8 + h_]; gbreg = pr[16 + h_]; } } while (0)
    int h_loaded = -1;
    if (C.bid < 2048) PREP_PREFETCH(C.bid);
    for (int pu = C.bid; pu < 2048; pu += C.G) {
    const int h = pu & 7, c = (pu >> 3) & 31, bl = pu >> 8;
    const float na = -expf(C.in[8][h]), dtb = C.in[9][h];
    const size_t r0 = (size_t)bl * SEQ + (size_t)c * 64;
    bf16_t* gW = (bf16_t*)(prep + (size_t)pu * PREP_UNIT_BYTES); bf16_t* gQD = gW + 8192; bf16_t* gUT = gW + 16384; bf16_t* gKD = gW + 24576; bf16_t* gQK = gW + 32768;
    LDS_BARRIER();
#pragma unroll
    for (int i = 0; i < 7; ++i) { const int idx = tid + 512 * i; if (idx < 67 * 48) *(LAS u32x4*)(RAW + idx * 8) = rawreg[i]; }
    if (tid < 64) { const float g = na * softplusf_(gareg + dtb); const float gc = wave_incl_sum(g, lane), gl = __shfl(gc, 63);
        fs[tid] = gc; fs[64 + tid] = sigmoidf_(gbreg); fs[128 + tid] = __expf(gc); fs[192 + tid] = __expf(gl - gc);
        if (tid == 63) gtot[pu] = __expf(gc); }
    if (h != h_loaded) { for (int idx = tid; idx < 4 * 384; idx += 512) { const int j = idx / 384, cc = idx - j * 384; cwl[idx] = cw[j * 3072 + (cc >> 7) * 1024 + h * 128 + (cc & 127)]; } h_loaded = h; }
    if (pu + C.G < 2048) PREP_PREFETCH(pu + C.G);
    LDS_BARRIER();
#pragma unroll 2
    for (int it = 0; it < 6; ++it) { const int which = it >> 1; const int item = (tid + 512 * it) & 1023; const int t = item >> 4, c8 = item & 15;
        float a[8];
#pragma unroll
        for (int e = 0; e < 8; ++e) a[e] = 0.f;
#pragma unroll
        for (int j = 0; j < 4; ++j) { const u32x4 rv = *(const LAS u32x4*)(RAW + (t + j) * 384 + which * 128 + c8 * 8);
            const f32x4 w0 = *(const LAS f32x4*)(cwl + j * 384 + which * 128 + c8 * 8), w1 = *(const LAS f32x4*)(cwl + j * 384 + which * 128 + c8 * 8 + 4);
            a[0] += w0[0] * __uint_as_float(rv.x << 16); a[1] += w0[1] * __uint_as_float(rv.x & 0xffff0000u); a[2] += w0[2] * __uint_as_float(rv.y << 16); a[3] += w0[3] * __uint_as_float(rv.y & 0xffff0000u);
            a[4] += w1[0] * __uint_as_float(rv.z << 16); a[5] += w1[1] * __uint_as_float(rv.z & 0xffff0000u); a[6] += w1[2] * __uint_as_float(rv.w << 16); a[7] += w1[3] * __uint_as_float(rv.w & 0xffff0000u); }
        float ss = 0.f;
#pragma unroll
        for (int e = 0; e < 8; ++e) { a[e] = a[e] * frcp_(1.f + __expf(-a[e])); ss += a[e] * a[e]; }
        const float beta = fs[64 + t], egc = fs[128 + t], ekd = fs[192 + t];
        if (which < 2) {
            ss = row_sum16(ss);
            const float rs = rsqrtf(ss + EPS) * (which == 0 ? 0.08838834764831845f : 1.f);
#pragma unroll
            for (int e = 0; e < 8; ++e) a[e] *= rs;
            u32x4 pk; pk.x = pg8::cvt_pk_bf16(a[0], a[1]); pk.y = pg8::cvt_pk_bf16(a[2], a[3]); pk.z = pg8::cvt_pk_bf16(a[4], a[5]); pk.w = pg8::cvt_pk_bf16(a[6], a[7]);
            if (which == 0) { *(LAS u32x4*)(Qn + t * 136 + c8 * 8) = pk;
                u32x4 pd; pd.x = pg8::cvt_pk_bf16(a[0] * egc, a[1] * egc); pd.y = pg8::cvt_pk_bf16(a[2] * egc, a[3] * egc); pd.z = pg8::cvt_pk_bf16(a[4] * egc, a[5] * egc); pd.w = pg8::cvt_pk_bf16(a[6] * egc, a[7] * egc);
                *(u32x4*)(gQD + t * 128 + c8 * 8) = pd; }
            else { *(LAS u32x4*)(Kn + t * 136 + c8 * 8) = pk; const float bk = beta * egc;
                u32x4 p1, p2; unsigned* p1p = (unsigned*)&p1; unsigned* p2p = (unsigned*)&p2;
#pragma unroll
                for (int e = 0; e < 4; ++e) { p1p[e] = pg8::cvt_pk_bf16(a[2 * e] * bk, a[2 * e + 1] * bk); p2p[e] = pg8::cvt_pk_bf16(a[2 * e] * ekd, a[2 * e + 1] * ekd); }
                *(LAS u32x4*)(RK + t * 136 + c8 * 8) = p1; *(u32x4*)(gKD + t * 128 + c8 * 8) = p2; }
        } else {
            u32x4 p1; unsigned* p1p = (unsigned*)&p1;
#pragma unroll
            for (int e = 0; e < 4; ++e) p1p[e] = pg8::cvt_pk_bf16(a[2 * e] * beta, a[2 * e + 1] * beta);
            *(LAS u32x4*)(RV + t * 136 + c8 * 8) = p1;
        }
    }
    LDS_BARRIER();
    for (int idx = tid; idx < 64 * 65; idx += 512) Tf[idx] = 0.f;
    { const int jt = wave & 3, ih = wave >> 2;
      f32x4 akk[2], aqk[2];
#pragma unroll
      for (int i = 0; i < 2; ++i) { akk[i] = (f32x4){0.f, 0.f, 0.f, 0.f}; aqk[i] = (f32x4){0.f, 0.f, 0.f, 0.f}; }
#pragma unroll
      for (int ks = 0; ks < 4; ++ks) { const bf16x8 bK = ld_frag(Kn, 136, 16 * jt + r, 32 * ks + 8 * q), bQ = ld_frag(Qn, 136, 16 * jt + r, 32 * ks + 8 * q);
#pragma unroll
          for (int i = 0; i < 2; ++i) { const bf16x8 aK = ld_frag(Kn, 136, 16 * (2 * ih + i) + r, 32 * ks + 8 * q); akk[i] = MFMA16(aK, bK, akk[i]); aqk[i] = MFMA16(aK, bQ, aqk[i]); } }
      const int j = 16 * jt + r; const float gcj = fs[j];
#pragma unroll
      for (int i = 0; i < 2; ++i) { f32x4 qkv;
#pragma unroll
          for (int jj = 0; jj < 4; ++jj) { const int ii = 16 * (2 * ih + i) + 4 * q + jj; const float gci = fs[ii];
              float e1 = __expf(fminf(gci - gcj, 0.f)), e2 = __expf(fminf(gcj - gci, 0.f)); asm volatile("" : "+v"(e1), "+v"(e2));
              const float av = fs[64 + ii] * akk[i][jj] * e1, qv = aqk[i][jj] * e2;
              Am[ii * 65 + j] = (ii > j) ? av : 0.f;
              qkv[jj] = (ii <= j) ? qv : 0.f; }
          *(u32x2*)(gQK + j * 64 + 16 * (2 * ih + i) + 4 * q) = pack4(qkv); } }
    LDS_BARRIER();
    if (tid < 64) { const int b = tid >> 4, j = tid & 15; float x[16];
#pragma unroll
        for (int i = 0; i < 16; ++i) { float s = (i == j) ? 1.f : 0.f;
#pragma unroll
            for (int m = 0; m < i; ++m) s -= Am[(16 * b + i) * 65 + 16 * b + m] * x[m];
            x[i] = s; Tf[(16 * b + i) * 65 + 16 * b + j] = s; } }
    LDS_BARRIER();
    if (wave < 2) {
        const int hi = 2 * wave + 1, lo = 2 * wave; f32x4 y = (f32x4){0.f, 0.f, 0.f, 0.f};
#pragma unroll
        for (int ks = 0; ks < 4; ++ks) y = __builtin_amdgcn_mfma_f32_16x16x4f32(Am[(16 * hi + r) * 65 + 16 * lo + 4 * ks + q], Tf[(16 * lo + 4 * ks + q) * 65 + 16 * lo + r], y, 0, 0, 0);
#pragma unroll
        for (int jj = 0; jj < 4; ++jj) Ys[wave * 16 * 17 + (4 * q + jj) * 17 + r] = y[jj];
        LDS_WAIT();
        f32x4 z = (f32x4){0.f, 0.f, 0.f, 0.f};
#pragma unroll
        for (int ks = 0; ks < 4; ++ks) z = __builtin_amdgcn_mfma_f32_16x16x4f32(Tf[(16 * hi + r) * 65 + 16 * hi + 4 * ks + q], Ys[wave * 16 * 17 + (4 * ks + q) * 17 + r], z, 0, 0, 0);
#pragma unroll
        for (int jj = 0; jj < 4; ++jj) Tf[(16 * hi + 4 * q + jj) * 65 + 16 * lo + r] = -z[jj];
    }
    LDS_BARRIER();
    if (wave < 4) {
        const int ti = wave >> 1, tj = wave & 1; f32x4 y = (f32x4){0.f, 0.f, 0.f, 0.f};
#pragma unroll
        for (int ks = 0; ks < 8; ++ks) y = __builtin_amdgcn_mfma_f32_16x16x4f32(Am[(32 + 16 * ti + r) * 65 + 4 * ks + q], Tf[(4 * ks + q) * 65 + 16 * tj + r], y, 0, 0, 0);
#pragma unroll
        for (int jj = 0; jj < 4; ++jj) Ys[(16 * ti + 4 * q + jj) * 33 + 16 * tj + r] = y[jj];
    }
    LDS_BARRIER();
    if (wave < 4) {
        const int ti = wave >> 1, tj = wave & 1; f32x4 z = (f32x4){0.f, 0.f, 0.f, 0.f};
#pragma unroll
        for (int ks = 0; ks < 8; ++ks) z = __builtin_amdgcn_mfma_f32_16x16x4f32(Tf[(32 + 16 * ti + r) * 65 + 32 + 4 * ks + q], Ys[(4 * ks + q) * 33 + 16 * tj + r], z, 0, 0, 0);
#pragma unroll
        for (int jj = 0; jj < 4; ++jj) Tf[(32 + 16 * ti + 4 * q + jj) * 65 + 16 * tj + r] = -z[jj];
    }
    LDS_BARRIER();
    for (int idx = tid; idx < 64 * 32; idx += 512) { const int i = idx >> 5, j2 = (idx & 31) * 2; *(LAS unsigned*)(Tn + i * 72 + j2) = pg8::cvt_pk_bf16(Tf[i * 65 + j2], Tf[i * 65 + j2 + 1]); }
    LDS_BARRIER();
    { f32x4 aw[4], au[4];
#pragma unroll
      for (int i = 0; i < 4; ++i) { aw[i] = (f32x4){0.f, 0.f, 0.f, 0.f}; au[i] = (f32x4){0.f, 0.f, 0.f, 0.f}; }
#pragma unroll
      for (int ks = 0; ks < 2; ++ks) { const bf16x8 fK = ld_frag_tr(RK, 136, 16 * wave, 32 * ks + 8 * q, 32 * ks + 8 * q + 4, r), fV = ld_frag_tr(RV, 136, 16 * wave, 32 * ks + 8 * q, 32 * ks + 8 * q + 4, r);
#pragma unroll
          for (int tt = 0; tt < 4; ++tt) { const bf16x8 fT = ld_frag(Tn, 72, 16 * tt + r, 32 * ks + 8 * q); aw[tt] = MFMA16(fK, fT, aw[tt]); au[tt] = MFMA16(fT, fV, au[tt]); } }
#pragma unroll
      for (int tt = 0; tt < 4; ++tt) { *(u32x2*)(gW + (16 * tt + r) * 128 + 16 * wave + 4 * q) = pack4(aw[tt]);
          *(u32x2*)(gUT + (16 * wave + r) * 64 + 16 * tt + 4 * q) = pack4(au[tt]); } }
    }
#undef PREP_PREFETCH
}

__device__ __forceinline__ void gdn_scan_unit(const Ctx& C, const unsigned char* prep, const float* gtot, bf16_t* AO, int unit) {
    const int vs = unit & 1, h = (unit >> 1) & 7, bl = unit >> 4;
    LAS bf16_t* Wn = (LAS bf16_t*)C.lds;
    LAS bf16_t* Qd = Wn + 64 * 136;
    LAS bf16_t* Kd = Qd + 64 * 136;
    LAS bf16_t* QKn = Kd + 64 * 136;
    LAS bf16_t* UT = QKn + 64 * 72;
    LAS bf16_t* VNT = UT + 64 * 72;
    LAS bf16_t* ST = VNT + 64 * 72;
    const int tid = C.tid, lane = C.lane, wave = C.wave, q = lane >> 4, r = lane & 15;
    const int tt = wave & 3, vg = wave >> 2;
    f32x4 accS[4];
#pragma unroll
    for (int i = 0; i < 4; ++i) accS[i] = (f32x4){0.f, 0.f, 0.f, 0.f};
    LDS_BARRIER();
    for (int idx = tid; idx < 64 * 136 / 2; idx += 512) ((LAS unsigned*)ST)[idx] = 0u;
    u32x4 wreg[2], qreg[2], kreg[2], qkreg, ureg; float greg = 0.f;
#define GDN_PREFETCH(cc) do { const int pu_ = (bl * 32 + (cc)) * 8 + h; const bf16_t* gW_ = (const bf16_t*)(prep + (size_t)pu_ * PREP_UNIT_BYTES); \
        _Pragma("unroll") for (int it = 0; it < 2; ++it) { const int idx = tid + 512 * it, row = idx >> 4, ch = idx & 15; wreg[it] = *(const u32x4*)(gW_ + row * 128 + ch * 8); qreg[it] = *(const u32x4*)(gW_ + 8192 + row * 128 + ch * 8); kreg[it] = *(const u32x4*)(gW_ + 24576 + row * 128 + ch * 8); } \
        qkreg = *(const u32x4*)(gW_ + 32768 + (tid >> 3) * 64 + (tid & 7) * 8); ureg = *(const u32x4*)(gW_ + 16384 + vs * 64 * 64 + (tid >> 3) * 64 + (tid & 7) * 8); greg = gtot[pu_]; } while (0)
    GDN_PREFETCH(0);
    for (int c = 0; c < NCHUNK; ++c) {
        const size_t r0 = (size_t)bl * SEQ + (size_t)c * 64;
        LDS_BARRIER();
#pragma unroll
        for (int it = 0; it < 2; ++it) { const int idx = tid + 512 * it, row = idx >> 4, ch = idx & 15;
            *(LAS u32x4*)(Wn + row * 136 + ch * 8) = wreg[it]; *(LAS u32x4*)(Qd + row * 136 + ch * 8) = qreg[it]; *(LAS u32x4*)(Kd + row * 136 + ch * 8) = kreg[it]; }
        { const int row = tid >> 3, c8 = tid & 7; *(LAS u32x4*)(QKn + row * 72 + c8 * 8) = qkreg; *(LAS u32x4*)(UT + row * 72 + c8 * 8) = ureg; }
        const float g = greg;
        if (c + 1 < NCHUNK) GDN_PREFETCH(c + 1);
        LDS_BARRIER();
        { f32x4 d1[2];
#pragma unroll
          for (int i = 0; i < 2; ++i) d1[i] = (f32x4){0.f, 0.f, 0.f, 0.f};
#pragma unroll
          for (int ks = 0; ks < 4; ++ks) { const bf16x8 aW = ld_frag(Wn, 136, 16 * tt + r, 32 * ks + 8 * q);
#pragma unroll
              for (int i = 0; i < 2; ++i) d1[i] = MFMA16(aW, ld_frag(ST, 136, 16 * (2 * vg + i) + r, 32 * ks + 8 * q), d1[i]); }
#pragma unroll
          for (int i = 0; i < 2; ++i) { const int v = 16 * (2 * vg + i) + r; const u32x2 uu = *(const LAS u32x2*)(UT + v * 72 + 16 * tt + 4 * q);
              f32x4 vn; vn[0] = __uint_as_float(uu.x << 16) - d1[i][0]; vn[1] = __uint_as_float(uu.x & 0xffff0000u) - d1[i][1]; vn[2] = __uint_as_float(uu.y << 16) - d1[i][2]; vn[3] = __uint_as_float(uu.y & 0xffff0000u) - d1[i][3];
              *(LAS u32x2*)(VNT + v * 72 + 16 * tt + 4 * q) = pack4(vn); } }
        LDS_BARRIER();
        { f32x4 ao[2];
#pragma unroll
          for (int i = 0; i < 2; ++i) ao[i] = (f32x4){0.f, 0.f, 0.f, 0.f};
#pragma unroll
          for (int ks = 0; ks < 4; ++ks) { const bf16x8 bQ = ld_frag(Qd, 136, 16 * tt + r, 32 * ks + 8 * q);
#pragma unroll
              for (int i = 0; i < 2; ++i) ao[i] = MFMA16(ld_frag(ST, 136, 16 * (2 * vg + i) + r, 32 * ks + 8 * q), bQ, ao[i]); }
#pragma unroll
          for (int ks = 0; ks < 2; ++ks) { const bf16x8 bQK = ld_frag(QKn, 72, 16 * tt + r, 32 * ks + 8 * q);
#pragma unroll
              for (int i = 0; i < 2; ++i) ao[i] = MFMA16(ld_frag(VNT, 72, 16 * (2 * vg + i) + r, 32 * ks + 8 * q), bQK, ao[i]); }
#pragma unroll
          for (int i = 0; i < 2; ++i) *(u32x2*)(AO + (r0 + 16 * tt + r) * KO0 + 1024 + h * 128 + vs * 64 + 16 * (2 * vg + i) + 4 * q) = pack4(ao[i]); }
#pragma unroll
        for (int vt = 0; vt < 4; ++vt) accS[vt] = accS[vt] * g;
#pragma unroll
        for (int ks = 0; ks < 2; ++ks) { const bf16x8 aK = ld_frag_tr(Kd, 136, 16 * wave, 32 * ks + 8 * q, 32 * ks + 8 * q + 4, r);
#pragma unroll
            for (int vt = 0; vt < 4; ++vt) accS[vt] = MFMA16(aK, ld_frag(VNT, 72, 16 * vt + r, 32 * ks + 8 * q), accS[vt]); }
        LDS_BARRIER();
#pragma unroll
        for (int vt = 0; vt < 4; ++vt) *(LAS u32x2*)(ST + (16 * vt + r) * 136 + 16 * wave + 4 * q) = pack4(accS[vt]);
    }
#undef GDN_PREFETCH
}
constexpr int AW_KV = 16384, AW_T = 640;
__device__ __forceinline__ void attn_wave(const Ctx& C, const bf16_t* P, bf16_t* AO, int bl, int c, int head) {
    const int lane = C.lane;
    LAS unsigned char* Kb = C.lds + C.wave * AW_KV; LAS unsigned char* Vb = Kb + 8192;
    LAS float* Tb = (LAS float*)(C.lds + 8 * AW_KV) + C.wave * AW_T;
    const size_t r0 = (size_t)bl * SEQ + (size_t)c * 64;
    const int cb0 = c - 8 < 0 ? 0 : c - 8, nblk = c - cb0 + 1;
#define AW_BLK(n_) (c < 8 ? (n_) : c - ((c - (n_)) % 9))
#define AW_GK(cb_) ((const char*)(P + pj1((size_t)bl * SEQ + (size_t)(cb_) * 64, C_AK + head * 64)))
#define AW_GV(cb_) ((const char*)(P + pj1((size_t)bl * SEQ + (size_t)(cb_) * 64, C_AV + head * 64)))
#define AW_DMA_K(gb_) do { _Pragma("unroll") for (int i_ = 0; i_ < 8; ++i_) __builtin_amdgcn_global_load_lds((const unsigned*)((gb_) + (size_t)i_ * 1024 + (voK ^ ((i_ & 1) << 6))), (LAS unsigned*)(Kb + i_ * 1024), 16, 0, 0); } while (0)
#define AW_DMA_V(gb_) do { _Pragma("unroll") for (int i_ = 0; i_ < 8; ++i_) __builtin_amdgcn_global_load_lds((const unsigned*)((gb_) + (size_t)i_ * 1024 + voV), (LAS unsigned*)(Vb + i_ * 1024), 16, 0, 0); } while (0)
#define AW_LANE_CONSTS() int ln_ = lane; asm volatile("" : "+v"(ln_)); const int q = ln_ >> 4, r = ln_ & 15; \
    const unsigned voK = (unsigned)(((ln_ >> 3) * 64 + (((ln_ & 7) ^ (ln_ >> 4)) * 8)) * 2), voV = (unsigned)(((ln_ >> 3) * 64 + (((ln_ & 7) ^ (2 * (ln_ >> 4))) * 8)) * 2)
    asm volatile("s_waitcnt vmcnt(0)" ::: "memory");
    bf16x8 bQ[4][2];
    { AW_LANE_CONSTS(); const int cbf = AW_BLK(0); AW_DMA_K(AW_GK(cbf)); AW_DMA_V(AW_GV(cbf));
#pragma unroll
    for (int s = 0; s < 4; ++s)
#pragma unroll
        for (int ks = 0; ks < 2; ++ks) bQ[s][ks] = *(const bf16x8*)(P + pj1(r0 + 16 * s + r, C_AQ + head * 64 + 32 * ks + 8 * q)); }
#pragma unroll
    for (int i = 0; i < 10; ++i) { const int k = lane + 64 * i; int ri = 638 - k; ri = ri > 319 ? 319 : (ri < 0 ? 0 : ri); Tb[k] = C.in[15][head * 320 + ri] * 1.4426950408889634f; }
    f32x4 acco[4][4]; float m_run[4], l_run[4];
#pragma unroll
    for (int s = 0; s < 4; ++s) { m_run[s] = -1e30f; l_run[s] = 0.f;
#pragma unroll
        for (int md = 0; md < 4; ++md) acco[s][md] = (f32x4){0.f, 0.f, 0.f, 0.f}; }
#define XSH(v_, a_) __builtin_bit_cast(float, __builtin_amdgcn_ds_bpermute(a_, __builtin_bit_cast(int, v_)))
    asm volatile("s_waitcnt vmcnt(0)" ::: "memory");
    for (int n = 0; n < nblk; ++n) {
        const bool more = n + 1 < nblk; const int cb = AW_BLK(n), cbn = AW_BLK(n + 1);
        AW_LANE_CONSTS();
        const int kofs0 = r * 128 + ((q ^ (r >> 1)) * 16), kofs1 = kofs0 ^ 64;
        const int vsw = 2 * ((2 * q + (r >> 3)) & 3), vrow = (4 * q + (r >> 2)) * 128 + (r & 1) * 8, vc0 = (((r & 3) >> 1) ^ vsw) * 16;
        const int x16 = (ln_ ^ 16) * 4, x32 = (ln_ ^ 32) * 4;
        const int tb0 = 638 - 64 * (c - cb0) - 63 - (r - 4 * q) - 48;
        asm volatile("s_waitcnt vmcnt(8)" ::: "memory");
        const LAS float* tp = Tb + tb0 + 64 * (cb - cb0);
        bf16x8 pf[4][2]; f32x4 accs[4][4]; float mx[4];
#pragma unroll
        for (int s = 0; s < 4; ++s) {
#pragma unroll
            for (int mi = 0; mi < 4; ++mi) { const bf16x8 k0 = *(const LAS bf16x8*)(Kb + mi * 2048 + kofs0), k1 = *(const LAS bf16x8*)(Kb + mi * 2048 + kofs1);
                const LAS float* tq = tp + 16 * (mi - s + 3);
                accs[s][mi] = MFMA16(k0, bQ[s][0], ((f32x4){0.f, 0.f, 0.f, 0.f})); accs[s][mi] = MFMA16(k1, bQ[s][1], accs[s][mi]);
                accs[s][mi] = accs[s][mi] + (f32x4){tq[0], tq[1], tq[2], tq[3]}; }
            float m = -1e30f;
#pragma unroll
            for (int mi = 0; mi < 4; ++mi) m = fmaxf(fmaxf(m, fmaxf(accs[s][mi][0], accs[s][mi][1])), fmaxf(accs[s][mi][2], accs[s][mi][3]));
            m = fmaxf(m, XSH(m, x16)); mx[s] = fmaxf(m, XSH(m, x32));
        }
        asm volatile("s_waitcnt lgkmcnt(0)" ::: "memory");
        if (more) AW_DMA_K(AW_GK(cbn));
        const bool need = (mx[0] > m_run[0] + 8.f) | (mx[1] > m_run[1] + 8.f) | (mx[2] > m_run[2] + 8.f) | (mx[3] > m_run[3] + 8.f);
        if (__builtin_amdgcn_ballot_w64(need) != 0ull) {
#pragma unroll
            for (int s = 0; s < 4; ++s) { const float m_new = mx[s] > m_run[s] + 8.f ? mx[s] : m_run[s], al = __builtin_amdgcn_exp2f(m_run[s] - m_new); m_run[s] = m_new; l_run[s] *= al;
#pragma unroll
                for (int md = 0; md < 4; ++md) acco[s][md] = acco[s][md] * al; }
        }
#pragma unroll
        for (int s = 0; s < 4; ++s) { float ls = 0.f;
#pragma unroll
            for (int mi = 0; mi < 4; ++mi)
#pragma unroll
                for (int jj = 0; jj < 4; ++jj) { accs[s][mi][jj] = __builtin_amdgcn_exp2f(accs[s][mi][jj] - m_run[s]); ls += accs[s][mi][jj]; }
            l_run[s] += ls;
            pf[s][0] = pack_frag(accs[s][0], accs[s][1]); pf[s][1] = pack_frag(accs[s][2], accs[s][3]);
        }
        if (more) asm volatile("s_waitcnt vmcnt(8)" ::: "memory"); else asm volatile("s_waitcnt vmcnt(0)" ::: "memory");
        bf16x8 vf[4][2];
#pragma unroll
        for (int md = 0; md < 4; ++md)
#pragma unroll
            for (int ks2 = 0; ks2 < 2; ++ks2) { const LAS unsigned char* vp = Vb + vrow + ks2 * 4096 + (((2 * md) * 16) ^ vc0);
                const bf16x4 lo = __builtin_amdgcn_ds_read_tr16_b64_v4i16((LAS bf16x4*)(vp)), hi = __builtin_amdgcn_ds_read_tr16_b64_v4i16((LAS bf16x4*)(vp + 2048));
                vf[md][ks2] = __builtin_shufflevector(lo, hi, 0, 1, 2, 3, 4, 5, 6, 7); }
        asm volatile("s_waitcnt lgkmcnt(0)" ::: "memory");
        if (more) AW_DMA_V(AW_GV(cbn));
#pragma unroll
        for (int md = 0; md < 4; ++md)
#pragma unroll
            for (int ks2 = 0; ks2 < 2; ++ks2)
#pragma unroll
                for (int s = 0; s < 4; ++s) acco[s][md] = MFMA16(vf[md][ks2], pf[s][ks2], acco[s][md]);
    }
    AW_LANE_CONSTS(); const int x16 = (ln_ ^ 16) * 4, x32 = (ln_ ^ 32) * 4;
#pragma unroll
    for (int s = 0; s < 4; ++s) { float l = l_run[s]; l += XSH(l, x16); l += XSH(l, x32); const float inv = 1.f / l;
#pragma unroll
        for (int md = 0; md < 4; ++md) *(LAS u32x2*)(Kb + (16 * s + r) * 144 + (16 * md + 4 * q) * 2) = pack4(acco[s][md] * inv); }
#pragma unroll
    for (int k = 0; k < 8; ++k) { const u32x4 o = *(const LAS u32x4*)(Kb + ((ln_ >> 3) + 8 * k) * 144 + (ln_ & 7) * 16);
        pg8::st16_wt(AO + (r0 + (ln_ >> 3) + 8 * k) * KO1 + head * 64 + (ln_ & 7) * 8, o); }
#undef XSH
#undef AW_BLK
#undef AW_GK
#undef AW_GV
#undef AW_LANE_CONSTS
#undef AW_DMA_K
#undef AW_DMA_V
}
__device__ __forceinline__ void phase_attn(const Ctx& C, const bf16_t* P, bf16_t* AO) {
    LDS_BARRIER();
    for (int u = C.bid; u < 512; u += C.G) { const int x = u & 7, i = (u >> 3) & 31, second = u >> 8, seq = 2 * x + second, c = second ? 31 - i : i;
        attn_wave(C, P, AO, seq >> 1, c, 8 * (seq & 1) + C.wave); }
    asm volatile("s_waitcnt vmcnt(0)" ::: "memory");
}
#define PH_BEGIN if (ph >= lo && ph < hi) { { int t_ = C.wave0 * 64 + lane_id_(); asm volatile("" : "+v"(t_)); C.tid = t_; C.lane = t_ & 63; C.wave = __builtin_amdgcn_readfirstlane(t_ >> 6); }
#define PH_END   if (ph + 1 < hi) xcd_barrier(bar); } ++ph;

__device__ __forceinline__ void moe_block(Ctx& C, const XcdBarrier& bar, int& ph, const int lo, const int hi, const int layer) {
    PH_BEGIN phase_convert_moe(C, layer); __syncthreads(); phase_r1(C, layer); PH_END
    PH_BEGIN phase_r2(C, layer); PH_END
    PH_BEGIN {
        const int npan = *((const int*)(C.ws + WS_CNT) + 128 + layer);
        pg8::Gemm g{(const bf16_t*)(C.ws + WS_H2P), (const bf16_t*)(C.ws + WS_W1), NTOK, 32 * 512, 1024};
        pg8::MoeOrder S{(const int*)(C.ws + WS_PANEL) + layer * 320, npan * 2, C.G, C.bid, 1};
        pg8::EpiSwiGLU E{(bf16_t*)(C.ws + WS_ACT), (const float*)(C.ws + WS_WROW)};
        pg8::gemm_phase_g<pg8::EpiSwiGLU, pg8::MoeOrder, false>(C.lds, g, S, E, (const int*)(C.ws + WS_ROWTOK), nullptr, C.wave0);
        if (layer == 0) {
            const int nun = npan * 2, full = nun - ((nun - 1) / C.G) * C.G;
            const bool tail = (C.G - full) * 2 >= C.G;
            __syncthreads();
            if (!tail) phase_convert(C, 1, C.bid, C.G);
            else if (C.bid >= full) phase_convert(C, 1, C.bid - full, C.G - full);
        }
    } PH_END
    PH_BEGIN {
        const int npan = *((const int*)(C.ws + WS_CNT) + 128 + layer);
        pg8::Gemm g{(const bf16_t*)(C.ws + WS_ACT), (const bf16_t*)(C.ws + WS_W2), MOE_MAXROWS, 32 * 1024, 256};
        pg8::MoeOrder S{(const int*)(C.ws + WS_PANEL) + layer * 320, npan * 4, C.G, C.bid, 2};
        pg8::EpiBf16P E{(bf16_t*)(C.ws + WS_YP), 1024, 3};
        pg8::gemm_phase<pg8::EpiBf16P, pg8::MoeOrder, false>(C.lds, g, S, E, nullptr, C.wave0);
    } PH_END
    PH_BEGIN { if (layer == 0) { phase_combine_norm(C, (const float*)(C.ws + WS_WSM1), C.in[1] + D, (bf16_t*)(C.ws + WS_HN1A), (float*)(C.ws + WS_SM1), (bf16_t*)(C.ws + WS_HN1B), (float*)(C.ws + WS_SM1 + 2 * MiB)); }
               else phase_combine(C); } PH_END
}

__global__ void __launch_bounds__(512, 2) mega_fwd(Args args) {
    extern __shared__ __attribute__((aligned(16))) unsigned char lds_raw[];
    Ctx C; C.in = args.in; C.out = args.out; C.ws = args.ws; C.lds = (LAS unsigned char*)lds_raw;
    C.wave0 = __builtin_amdgcn_readfirstlane((int)threadIdx.x >> 6);
    C.lane = lane_id_(); C.tid = C.wave0 * 64 + C.lane; C.wave = C.wave0; C.G = gridDim.x; C.bid = blockIdx.x;
    if (C.tid < 4) ((LAS unsigned*)(C.lds + LDS_BAR_OFF))[C.tid] = 0u;
    __syncthreads();
    XcdBarrier bar = xcd_barrier_post((unsigned*)(C.ws + WS_BAR) + args.li * XCD_BAR_WORDS, (volatile LAS unsigned*)(C.lds + LDS_BAR_OFF), C.wave0);
    const int lo = args.ph_lo, hi = args.ph_hi; int ph = 0;
    bf16_t* HN = (bf16_t*)(C.ws + WS_HN); bf16_t* AO = (bf16_t*)(C.ws + WS_AOUT); bf16_t* PJ = (bf16_t*)(C.ws + WS_PROJ);
    const bf16_t* Win = (const bf16_t*)(C.ws + WS_WIN); const bf16_t* Wout = (const bf16_t*)(C.ws + WS_WOUT);

    PH_BEGIN phase_convert(C, 0, C.bid, C.G); PH_END
    _Pragma("unroll") for (int g = 0; g < NGRP; ++g) {
        const size_t grow = (size_t)g * GTOK;
        if (g == 0) { PH_BEGIN phase_norm(C, (const float*)(C.ws + WS_WSM), C.in[0] + grow * D, C.in[1], HN, (float*)(C.ws + WS_SM0), GTOK, C.bid, C.G); PH_END }
        PH_BEGIN { pg8::Gemm gm{g == 0 ? HN : (const bf16_t*)(C.ws + WS_AOUT + 64 * MiB), Win, GTOK, NP0, D}; pg8::StaticOrder S; S.init(GTOK, NP0, C.G, C.bid); pg8::EpiBf16QKT<false> E{PJ, NP0 / 256, nullptr, C.lds + pg8::STAGE_BYTES + 512};
            pg8::gemm_phase<pg8::EpiBf16QKT<false>, pg8::StaticOrder, false>(C.lds, gm, S, E, nullptr, C.wave0); } PH_END
        PH_BEGIN { gdn_prep_phase(C, PJ, (const float*)(C.ws + WS_SM0 + (size_t)g * 2 * MiB), C.ws + WS_PREP, (float*)(C.ws + WS_GTOT)); } PH_END
        PH_BEGIN { const int nA = C.G >> 1;
            if (C.bid < nA) { for (int u = C.bid; u < 128; u += nA) gdn_scan_unit(C, C.ws + WS_PREP, (const float*)(C.ws + WS_GTOT), AO, u);
                if (g == 0) { __syncthreads(); phase_norm(C, (const float*)(C.ws + WS_WSM), C.in[0] + (size_t)GTOK * D, C.in[1], (bf16_t*)(C.ws + WS_AOUT + 64 * MiB), (float*)(C.ws + WS_SM0 + 2 * MiB), GTOK, C.bid, nA); } }
            else { for (int u = C.bid - nA; u < 128; u += C.G - nA) mlstm_unit(C, PJ, (const float*)(C.ws + WS_SM0 + (size_t)g * 2 * MiB), AO, u); } } PH_END
        PH_BEGIN phase_gate0(C, PJ, AO); PH_END
        PH_BEGIN { pg8::Gemm gm{AO, Wout, GTOK, D, KO0}; pg8::StaticOrder S; S.init(GTOK, D, C.G, C.bid); pg8::EpiResidB<false> E{C.in[0] + grow * D, (bf16_t*)C.out + grow * D, D};
            pg8::gemm_phase<pg8::EpiResidB<false>, pg8::StaticOrder, false>(C.lds, gm, S, E, nullptr, C.wave0); } PH_END
    }
    moe_block(C, bar, ph, lo, hi, 0);
    _Pragma("unroll") for (int g = 0; g < NGRP; ++g) {
        const size_t grow = (size_t)g * GTOK;
        PH_BEGIN { LAS float* gn = (LAS float*)(C.lds + pg8::STAGE_BYTES);
            if (C.tid < 128) gn[C.tid] = C.tid < 64 ? C.in[13][C.tid] * (0.125f * 1.4426950408889634f) : C.in[14][C.tid - 64];
            __syncthreads();
            pg8::Gemm gm{(const bf16_t*)(C.ws + (g == 0 ? WS_HN1A : WS_HN1B)), Win, GTOK, NP1, D}; pg8::StaticOrder S; S.init(GTOK, NP1, C.G, C.bid); pg8::EpiBf16QKT<true> E{PJ, NP1 / 256, gn, C.lds + pg8::STAGE_BYTES + 512};
            pg8::gemm_phase<pg8::EpiBf16QKT<true>, pg8::StaticOrder, false>(C.lds, gm, S, E, nullptr, C.wave0); } PH_END
        PH_BEGIN { phase_ssdconv(C, PJ, (bf16_t*)(C.ws + WS_XC)); } PH_END
        PH_BEGIN { for (int u = C.bid; u < 256; u += C.G) ssd_unit(C, (const float*)(C.ws + WS_SM1 + (size_t)g * 2 * MiB), (const bf16_t*)(C.ws + WS_XC), AO, u); phase_attn(C, PJ, AO); } PH_END
        PH_BEGIN phase_gate1(C, PJ, AO); PH_END
        PH_BEGIN { pg8::Gemm gm{AO, Wout, GTOK, D, KO1}; pg8::StaticOrder S; S.init(GTOK, D, C.G, C.bid); pg8::EpiResidB<true> E{(const bf16_t*)C.out + grow * D, (bf16_t*)C.out + grow * D, D};
            pg8::gemm_phase<pg8::EpiResidB<true>, pg8::StaticOrder, false>(C.lds, gm, S, E, nullptr, C.wave0); } PH_END
    }
    moe_block(C, bar, ph, lo, hi, 1);
}
constexpr int N_PHASES = 1 + (6 * NGRP + 5 - 1) + (5 * NGRP + 5);

#ifndef N_LAUNCHES
#define N_LAUNCHES 1
#endif
extern "C" void kernel_launch(void* const* d_in, const int* in_sizes, int n_in, void* d_out, int out_size, void* d_ws, size_t ws_size, hipStream_t stream) {
    static int grid = 0;
    if (grid == 0) {
        if (n_in != 30 || out_size != NTOK * D || ws_size < WS_END) { fprintf(stderr, "kernel_launch: unexpected shapes (n_in %d out %d ws %zu)\n", n_in, out_size, ws_size); grid = -1; return; }
        int dev = 0, cus = 0, per_cu = 0;
        if (hipGetDevice(&dev) != hipSuccess || hipDeviceGetAttribute(&cus, hipDeviceAttributeMultiprocessorCount, dev) != hipSuccess) { grid = -1; return; }
        if (hipFuncSetAttribute((const void*)mega_fwd, hipFuncAttributeMaxDynamicSharedMemorySize, LDS_BYTES) != hipSuccess) { fprintf(stderr, "kernel_launch: hipFuncSetAttribute failed\n"); grid = -1; return; }
        if (hipOccupancyMaxActiveBlocksPerMultiprocessor(&per_cu, (const void*)mega_fwd, 512, LDS_BYTES) != hipSuccess || per_cu < 1) fprintf(stderr, "kernel_launch: occupancy query says %d\n", per_cu);
        (void)hipGetLastError();
        grid = cus;
    }
    if (grid < 0) return;
    if (hipMemsetAsync(d_ws, 0, WS_ZERO_BYTES, stream) != hipSuccess) return;
    Args a{};
    for (int i = 0; i < 30; ++i) a.in[i] = (const float*)d_in[i];
    a.out = (float*)d_out; a.ws = (unsigned char*)d_ws; a.pad = 0;
    for (int li = 0; li < N_LAUNCHES; ++li) {
        a.ph_lo = (int)((long)N_PHASES * li / N_LAUNCHES); a.ph_hi = (int)((long)N_PHASES * (li + 1) / N_LAUNCHES); a.li = li;
        hipLaunchKernelGGL(mega_fwd, dim3(grid), dim3(512), LDS_BYTES, stream, a);
    }
}
```
